# Optimizing an MI355X kernel written in HIP

```python
import jax, jax.numpy as jnp
from jax import lax
import numpy as np

D_MODEL = 1024
BATCH = 2
SEQ = 16384
DEPTH = 4

CHUNK = 64
N_A = DEPTH // 2
N_B = DEPTH - N_A
RET_HEADS = 4
RET_QK_DIM = D_MODEL // RET_HEADS
RET_V_DIM = 2 * D_MODEL // RET_HEADS
ROPE_BASE = 10000.0
FOX_HEADS = 16
FOX_HEAD_DIM = D_MODEL // FOX_HEADS
Q_BLOCK = 128
FORGET_BIAS = 3.0
D_FF = 2816
N_EXPERTS = 8
TOP_K = 2
D_FF_EXPERT = 3584
N_DENSE = (DEPTH + 1) // 2
N_MOE = DEPTH // 2
EPS = 1e-6

kernel_name = "yoco_retention_fox_moe_trunk"


def rmsnorm(x, g):
    xf = x.astype(jnp.float32)
    y = xf * lax.rsqrt(jnp.mean(xf * xf, axis=-1, keepdims=True) + EPS)
    return (y * g.astype(jnp.float32)).astype(x.dtype)


def modulate(h, shift, scale):
    return h * (1.0 + scale[:, None, :]) + shift[:, None, :]


def rotary(x, pos):
    d = x.shape[-1]
    inv = 1.0 / (ROPE_BASE ** (jnp.arange(0, d, 2, dtype=jnp.float32) / d))
    ang = pos.astype(jnp.float32)[:, None] * inv[None, :]
    cos = jnp.cos(ang)[None, :, None, :]
    sin = jnp.sin(ang)[None, :, None, :]
    x1 = x[..., : d // 2].astype(jnp.float32)
    x2 = x[..., d // 2:].astype(jnp.float32)
    return jnp.concatenate([x1 * cos - x2 * sin, x2 * cos + x1 * sin], axis=-1).astype(x.dtype)


def retention(h, w_in, w_o):
    B, S, D = h.shape
    nc = S // CHUNK
    proj = h @ w_in
    q, k, v, g = jnp.split(proj, [D, 2 * D, 4 * D], axis=-1)
    pos = jnp.arange(S)
    q = rotary(q.reshape(B, S, RET_HEADS, RET_QK_DIM), pos)
    k = rotary(k.reshape(B, S, RET_HEADS, RET_QK_DIM), pos) * (RET_QK_DIM ** -0.5)
    v = v.reshape(B, S, RET_HEADS, RET_V_DIM)

    def to_chunks(t):
        return t.reshape(B, nc, CHUNK, RET_HEADS, -1).transpose(1, 0, 3, 2, 4).astype(jnp.float32)

    log_g = jnp.log(1.0 - 2.0 ** (-5.0 - jnp.arange(RET_HEADS, dtype=jnp.float32)))
    idx = jnp.arange(CHUNK, dtype=jnp.float32)
    intra_decay = jnp.exp(log_g[:, None, None] * jnp.abs(idx[:, None] - idx[None, :]))
    q_decay = jnp.exp(log_g[:, None] * (idx[None, :] + 1.0))[None, :, :, None]
    k_decay = jnp.exp(log_g[:, None] * (CHUNK - 1.0 - idx[None, :]))[None, :, :, None]
    chunk_decay = jnp.exp(log_g * CHUNK)[None, :, None, None]

    def step(state, qkv):
        qc, kc, vc = qkv
        scores = jnp.einsum('bhnd,bhmd->bhnm', qc, kc) * intra_decay
        o = (jnp.einsum('bhnm,bhmv->bhnv', scores, vc)
             + jnp.einsum('bhnd,bhdv->bhnv', qc, state) * q_decay)
        state = state * chunk_decay + jnp.einsum('bhmd,bhmv->bhdv', kc * k_decay, vc)
        return state, o

    state0 = jnp.zeros((B, RET_HEADS, RET_QK_DIM, RET_V_DIM), jnp.float32)
    _, o = lax.scan(step, state0, (to_chunks(q), to_chunks(k), to_chunks(v)))
    o = o.transpose(1, 0, 3, 2, 4).reshape(B, S, RET_HEADS, RET_V_DIM)
    mu = jnp.mean(o, axis=-1, keepdims=True)
    var = jnp.mean(jnp.square(o - mu), axis=-1, keepdims=True)
    y = ((o - mu) * lax.rsqrt(var + EPS)).reshape(B, S, 2 * D).astype(h.dtype)
    return (jax.nn.silu(g) * y) @ w_o


def fox_shared_kv(hn, w_kv, w_f, b_f):
    B, S, D = hn.shape
    k, v = jnp.split(hn @ w_kv, 2, axis=-1)
    k = k.reshape(B, S, FOX_HEADS, FOX_HEAD_DIM).transpose(0, 2, 1, 3)
    v = v.reshape(B, S, FOX_HEADS, FOX_HEAD_DIM).transpose(0, 2, 1, 3)
    log_f = jax.nn.log_sigmoid((hn @ w_f).astype(jnp.float32) + b_f.astype(jnp.float32))
    F = jnp.cumsum(log_f, axis=1).transpose(0, 2, 1)
    return k, v, F


def forgetting_attention(hn, w_qg, w_o, k, v, F):
    B, S, D = hn.shape
    nb = S // Q_BLOCK
    q, g = jnp.split(hn @ w_qg, 2, axis=-1)
    qb_all = q.reshape(B, nb, Q_BLOCK, FOX_HEADS, FOX_HEAD_DIM).transpose(1, 0, 3, 2, 4)
    Fq_all = F.reshape(B, FOX_HEADS, nb, Q_BLOCK).transpose(2, 0, 1, 3)
    key_pos = jnp.arange(S)
    scale = FOX_HEAD_DIM ** -0.5

    def block(args):
        qb, Fqb, i = args
        q_pos = i * Q_BLOCK + jnp.arange(Q_BLOCK)
        s = (jnp.einsum('bhqd,bhkd->bhqk', qb, k).astype(jnp.float32) * scale
             + (Fqb[..., :, None] - F[:, :, None, :]))
        s = jnp.where(key_pos[None, :] <= q_pos[:, None], s, -jnp.inf)
        p = jax.nn.softmax(s, axis=-1)
        return jnp.einsum('bhqk,bhkd->bhqd', p.astype(v.dtype), v)

    o = lax.map(block, (qb_all, Fq_all, jnp.arange(nb)))
    o = o.transpose(1, 0, 3, 2, 4).reshape(B, S, D)
    return (o * jax.nn.sigmoid(g)) @ w_o


def swiglu(h, w_gate, w_up, w_down):
    return (jax.nn.silu(h @ w_gate) * (h @ w_up)) @ w_down


def moe_swiglu(h, w_router, b_router, w_gate, w_up, w_down):
    logits = (h @ w_router).astype(jnp.float32) + b_router.astype(jnp.float32)
    top_val, top_idx = lax.top_k(logits, TOP_K)
    top_w = jax.nn.softmax(top_val, axis=-1)
    gates = jnp.sum(jax.nn.one_hot(top_idx, N_EXPERTS, dtype=jnp.float32) * top_w[..., None], axis=-2)
    gates = gates.astype(h.dtype)
    out = jnp.zeros_like(h)
    for e in range(N_EXPERTS):
        out = out + gates[..., e:e + 1] * swiglu(h, w_gate[e], w_up[e], w_down[e])
    return out


def setup_inputs(seed: int = 0) -> dict:
    key = jax.random.key(seed)
    ks = jax.random.split(key, 32)
    D = D_MODEL
    f32 = jnp.float32

    def nrm(k, shape):
        return jax.random.normal(k, shape, f32)

    def w(k, shape, fan_in, scale=1.0):
        return nrm(k, shape) * (scale * fan_in ** -0.5)

    return {
        "x": nrm(ks[0], (BATCH, SEQ, D)),
        "c": nrm(ks[1], (BATCH, D)),
        "ada_w": w(ks[2], (DEPTH, D, 6 * D), D, 0.5),
        "ada_b": 0.02 * nrm(ks[3], (DEPTH, 6 * D)),
        "norm_g": 1.0 + 0.01 * nrm(ks[4], (DEPTH, 2, D)),
        "ret_w_in": w(ks[5], (N_A, D, 6 * D), D),
        "ret_w_o": w(ks[6], (N_A, 2 * D, D), 2 * D),
        "kv_ada_w": w(ks[7], (D, 2 * D), D, 0.5),
        "kv_ada_b": 0.02 * nrm(ks[8], (2 * D,)),
        "kv_norm_g": 1.0 + 0.01 * nrm(ks[9], (D,)),
        "fox_w_kv": w(ks[10], (D, 2 * D), D),
        "fox_w_f": w(ks[11], (D, FOX_HEADS), D),
        "fox_b_f": FORGET_BIAS + 0.1 * nrm(ks[12], (FOX_HEADS,)),
        "fox_w_qg": w(ks[13], (N_B, D, 2 * D), D),
        "fox_w_o": w(ks[14], (N_B, D, D), D),
        "ffn_w_gate": w(ks[15], (N_DENSE, D, D_FF), D),
        "ffn_w_up": w(ks[16], (N_DENSE, D, D_FF), D),
        "ffn_w_down": w(ks[17], (N_DENSE, D_FF, D), D_FF),
        "router_w": w(ks[18], (N_MOE, D, N_EXPERTS), D),
        "router_b": 0.01 * nrm(ks[19], (N_MOE, N_EXPERTS)),
        "moe_w_gate": w(ks[20], (N_MOE, N_EXPERTS, D, D_FF_EXPERT), D),
        "moe_w_up": w(ks[21], (N_MOE, N_EXPERTS, D, D_FF_EXPERT), D),
        "moe_w_down": w(ks[22], (N_MOE, N_EXPERTS, D_FF_EXPERT, D), D_FF_EXPERT),
        "final_ada_w": w(ks[23], (D, 2 * D), D, 0.5),
        "final_ada_b": 0.02 * nrm(ks[24], (2 * D,)),
        "final_norm_g": 1.0 + 0.01 * nrm(ks[25], (D,)),
    }


def reference(x, c, ada_w, ada_b, norm_g, ret_w_in, ret_w_o, kv_ada_w, kv_ada_b, kv_norm_g,
              fox_w_kv, fox_w_f, fox_b_f, fox_w_qg, fox_w_o, ffn_w_gate, ffn_w_up, ffn_w_down,
              router_w, router_b, moe_w_gate, moe_w_up, moe_w_down, final_ada_w, final_ada_b,
              final_norm_g):
    c_act = jax.nn.silu(c)
    h = x
    shared = None
    for l in range(DEPTH):
        sh1, sc1, g1, sh2, sc2, g2 = jnp.split(c_act @ ada_w[l] + ada_b[l], 6, axis=-1)
        if l == N_A:
            kv_sh, kv_sc = jnp.split(c_act @ kv_ada_w + kv_ada_b, 2, axis=-1)
            hn_kv = modulate(rmsnorm(h, kv_norm_g), kv_sh, kv_sc)
            shared = fox_shared_kv(hn_kv, fox_w_kv, fox_w_f, fox_b_f)
        a = modulate(rmsnorm(h, norm_g[l, 0]), sh1, sc1)
        if l < N_A:
            mix = retention(a, ret_w_in[l], ret_w_o[l])
        else:
            j = l - N_A
            mix = forgetting_attention(a, fox_w_qg[j], fox_w_o[j], shared[0], shared[1], shared[2])
        h = h + g1[:, None, :] * mix
        m = modulate(rmsnorm(h, norm_g[l, 1]), sh2, sc2)
        if l % 2 == 0:
            i = l // 2
            ff = swiglu(m, ffn_w_gate[i], ffn_w_up[i], ffn_w_down[i])
        else:
            i = l // 2
            ff = moe_swiglu(m, router_w[i], router_b[i], moe_w_gate[i], moe_w_up[i], moe_w_down[i])
        h = h + g2[:, None, :] * ff
    f_sh, f_sc = jnp.split(c_act @ final_ada_w + final_ada_b, 2, axis=-1)
    return modulate(rmsnorm(h, final_norm_g), f_sh, f_sc)
```

```cpp
#include <hip/hip_runtime.h>
#include <hip/hip_bf16.h>
#include <cstdio>
#include <cstdint>
#include <cmath>

#ifndef MK_N_LAUNCHES
#define MK_N_LAUNCHES 1
#endif

constexpr int BATCH = 2, SEQ = 16384, D = 1024, T = BATCH * SEQ;
constexpr int RH = 4, RQK = 256, RV = 512, PROJW = 6 * D;
constexpr int FH = 16, FD = 64;
constexpr int DFF = 2816, NE = 8, DFE = 3584;
constexpr float EPS = 1e-6f;
constexpr float LOG2E = 1.4426950408889634f;
constexpr float QC2 = 0.125f * 1.4426950408889634f;

#define GAS __attribute__((address_space(1)))
#define LAS __attribute__((address_space(3)))
typedef unsigned short bf16;
typedef unsigned v4u __attribute__((ext_vector_type(4)));
typedef unsigned v2u __attribute__((ext_vector_type(2)));
typedef float f32x4 __attribute__((ext_vector_type(4)));
typedef float f32x2 __attribute__((ext_vector_type(2)));
typedef short bf16x8 __attribute__((ext_vector_type(8)));
typedef short s16x4 __attribute__((ext_vector_type(4)));
typedef GAS unsigned gu32;
#define RLX_AGENT __ATOMIC_RELAXED, __HIP_MEMORY_SCOPE_AGENT
#define LDS_WAIT() asm volatile("s_waitcnt lgkmcnt(0)" ::: "memory")
#define VM_WAIT() asm volatile("s_waitcnt vmcnt(0)" ::: "memory")

__device__ __forceinline__ unsigned cvt_pk_bf16(float lo, float hi) { unsigned r; asm volatile("v_cvt_pk_bf16_f32 %0, %1, %2" : "=v"(r) : "v"(lo), "v"(hi)); return r; }
__device__ __forceinline__ float bf_lo(unsigned u) { return __uint_as_float(u << 16); }
__device__ __forceinline__ float bf_hi(unsigned u) { return __uint_as_float(u & 0xffff0000u); }
__device__ __forceinline__ float fast_sigmoid(float x) { return __builtin_amdgcn_rcpf(1.0f + __builtin_amdgcn_exp2f(-x * LOG2E)); }
__device__ __forceinline__ float fast_silu(float x) { return x * fast_sigmoid(x); }

constexpr size_t MiB = 1u << 20;
constexpr size_t WS_CTL = 0, CTL_ZERO_BYTES = 1 * MiB;
constexpr size_t WS_MOD = 1 * MiB;
constexpr size_t WS_LOGF = 2 * MiB;
constexpr size_t WS_FL2 = 4 * MiB;
constexpr size_t WS_LIST = 6 * MiB;
constexpr size_t WS_ROPE = 10 * MiB;
constexpr size_t WS_LST = 26 * MiB;
constexpr size_t WS_W = 64 * MiB;
constexpr size_t W_RIN = WS_W;
constexpr size_t W_RO = W_RIN + 2 * 12 * MiB;
constexpr size_t W_KV = W_RO + 2 * 4 * MiB;
constexpr size_t W_QG = W_KV + 4 * MiB;
constexpr size_t W_FO = W_QG + 2 * 4 * MiB;
constexpr size_t W_FUP = W_FO + 2 * 2 * MiB;
constexpr size_t W_FDN = W_FUP + 2 * 11 * MiB;
constexpr size_t W_MUP = W_FDN + 11 * MiB;
constexpr size_t W_MDN = W_MUP + 16 * 14 * MiB;
constexpr size_t WS_XN = W_MDN + 16 * 7 * MiB;
constexpr size_t WS_BIG = WS_XN + 64 * MiB;
constexpr size_t WS_PROJ = WS_BIG;
constexpr size_t WS_Q = WS_BIG, WS_G = WS_BIG + 64 * MiB, WS_K = WS_BIG + 256 * MiB, WS_V = WS_BIG + 320 * MiB;
constexpr size_t WS_HID = WS_BIG;
constexpr size_t WS_END = WS_BIG + 384 * MiB;
static_assert(WS_XN == 481 * MiB && WS_END == 929 * MiB, "ws map");
constexpr int HID_ROWS = T + NE * 256;
static_assert((size_t)HID_ROWS * DFE * 2 <= 256 * MiB, "moe hidden fits below K/V");

constexpr int MOD_L = 2 * 6 * D;
constexpr int MOD_KV = 4 * MOD_L, MOD_FIN = MOD_KV + 2 * 2 * D;
constexpr int CW_BAR = 4096;
constexpr int CW_MOE = 16384;
constexpr int CW_DBG = 32768;

namespace pg8 {
constexpr int BM = 256, BK = 64, HALF = 128, HTB = HALF * BK * 2, STAGE_BYTES = 8 * HTB, NXCD = 8, WGM = 8;
__host__ __device__ __forceinline__ int lds_byte(int r, int c) { const int st = (r >> 4) * 2 + (c >> 5), rr = r & 15, cc = c & 31, ob = rr * 64 + cc * 2; return st * 1024 + (ob ^ (((ob >> 9) & 1) << 5)); }
__host__ __device__ __forceinline__ void stage_rc(int b, int& R, int& C) { const int st = b / 1024, sb = b % 1024, swz = sb ^ (((sb >> 9) & 1) << 5); R = (st >> 1) * 16 + swz / 64; C = (st & 1) * 32 + (swz % 64) / 2; }
__host__ __device__ __forceinline__ int perm32(int rho) { const int n = rho >> 4, i = rho & 15; return 8 * (i >> 2) + 4 * n + (i & 3); }

struct Unit { int pm, pn, e, mt; };

__device__ __forceinline__ bool order_tile(int i, int G, int c, int nM, int nN, int& pm, int& pn) {
    const int nwg = nM * nN; const long L = (long)i * G + c; if (L >= nwg) return false;
    int wgid = (int)L; { const int q = nwg / NXCD, r = nwg % NXCD, xcd = wgid % NXCD, off = wgid / NXCD; wgid = (xcd < r ? xcd * (q + 1) : r * (q + 1) + (xcd - r) * q) + off; }
    const int nig = WGM * nN, gid = wgid / nig, fm = gid * WGM, gsz = (nM - fm) < WGM ? (nM - fm) : WGM;
    pm = fm + ((wgid % nig) % gsz); pn = (wgid % nig) / gsz; return true;
}
struct DenseOrder {
    const bf16* A; const bf16* Bt; int lda, K, nM, nN, G, c;
    __device__ __forceinline__ bool next(int i, Unit& u) const { u.e = 0; u.mt = 0; return order_tile(i, G, c, nM, nN, u.pm, u.pn); }
    __device__ __forceinline__ const char* a_tile(const Unit& u) const { return (const char*)A + (size_t)u.pm * BM * lda * 2; }
    __device__ __forceinline__ const char* b_tile(const Unit& u) const { return (const char*)Bt + (size_t)u.pn * BM * K * 2; }
    __device__ __forceinline__ int row_tok(const Unit&, int) const { return 0; }
};
struct MoeOrder {
    const bf16* A; const bf16* Bt; int lda, K, nN, G, c; size_t bstride  ; const int2* list  ; const LAS int* tb; bool gather;
    __device__ __forceinline__ bool next(int i, Unit& u) const {
        const int ntile = tb[8]; const int nwg = ntile * nN; const long L = (long)i * G + c; if (L >= nwg) return false;
        int wgid = (int)L; { const int q = nwg / NXCD, r = nwg % NXCD, xcd = wgid % NXCD, off = wgid / NXCD; wgid = (xcd < r ? xcd * (q + 1) : r * (q + 1) + (xcd - r) * q) + off; }
        int e = 0;
#pragma unroll
        for (int j = 1; j < 8; ++j) if (wgid >= tb[j] * nN) e = j;
        const int tbase = tb[e], nM = tb[e + 1] - tbase, local = wgid - tbase * nN;
        const int nig = WGM * nN, gid = local / nig, fm = gid * WGM, gsz = (nM - fm) < WGM ? (nM - fm) : WGM;
        u.mt = fm + ((local % nig) % gsz); u.pn = (local % nig) / gsz; u.e = e; u.pm = tbase + u.mt; return true;
    }
    __device__ __forceinline__ const char* a_tile(const Unit& u) const { return gather ? (const char*)A : (const char*)A + (size_t)u.pm * BM * lda * 2; }
    __device__ __forceinline__ const char* b_tile(const Unit& u) const { return (const char*)Bt + ((size_t)u.e * bstride + (size_t)u.pn * BM * K) * 2; }
    __device__ __forceinline__ int row_tok(const Unit& u, int r) const { const int idx = u.mt * BM + r; const int cnt = tb[16 + u.e]; return idx < cnt ? list[(size_t)u.e * T + idx].x : 0; }
};

struct EpiBf16 {
    static constexpr bool PERM = true;
    bf16* O; int ldc; int split_cols; size_t split_stride; float scale0;
    __device__ __forceinline__ void operator()(const f32x4 (&acc)[2][2][4][2], const Unit& u, int wr, int wc, int fr, int fq) const {
        const int row0 = u.pm * BM + wr * 64 + fr; int colt = u.pn * BM; bf16* base = O;
        float sc = 1.f; if (split_cols) { const int t = colt / split_cols; base += (size_t)t * split_stride; colt -= t * split_cols; if (t == 0) sc = scale0; }
        const int col0 = colt + wc * 32 + 8 * fq;
#pragma unroll
        for (int ai = 0; ai < 2; ++ai)
#pragma unroll
            for (int m = 0; m < 4; ++m) { bf16* rowp = base + (size_t)(row0 + ai * HALF + m * 16) * ldc + col0;
#pragma unroll
                for (int bj = 0; bj < 2; ++bj) { const f32x4 v0 = acc[ai][bj][m][0] * sc, v1 = acc[ai][bj][m][1] * sc;
                    v4u w; w.x = cvt_pk_bf16(v0[0], v0[1]); w.y = cvt_pk_bf16(v0[2], v0[3]); w.z = cvt_pk_bf16(v1[0], v1[1]); w.w = cvt_pk_bf16(v1[2], v1[3]);
                    *(v4u*)(rowp + bj * HALF) = w; } }
    }
};
struct EpiRetIn {
    static constexpr bool PERM = true;
    bf16* O; const f32x2* rope;
    __device__ __forceinline__ void operator()(const f32x4 (&acc)[2][2][4][2], const Unit& u, int wr, int wc, int fr, int fq) const {
        const int row0 = u.pm * BM + wr * 64 + fr; const int col0 = u.pn * BM + wc * 32 + 8 * fq;
        const bool rot = u.pn < 8; const float ksc = (u.pn >= 4 && u.pn < 8) ? 0.0625f : 1.0f;
#pragma unroll
        for (int ai = 0; ai < 2; ++ai)
#pragma unroll
            for (int m = 0; m < 4; ++m) { const int row = row0 + ai * HALF + m * 16; bf16* rowp = O + (size_t)row * PROJW + col0;
                f32x4 a0 = acc[ai][0][m][0], a1 = acc[ai][0][m][1], b0 = acc[ai][1][m][0], b1 = acc[ai][1][m][1];
                if (rot) { const f32x4* rp = (const f32x4*)(rope + (size_t)(row & (SEQ - 1)) * 128 + wc * 32 + 8 * fq);
                    const f32x4 r0 = rp[0], r1 = rp[1], r2 = rp[2], r3 = rp[3];
                    f32x4 x, y;
                    x = a0; y = b0; a0 = (f32x4){x[0] * r0[0] - y[0] * r0[1], x[1] * r0[2] - y[1] * r0[3], x[2] * r1[0] - y[2] * r1[1], x[3] * r1[2] - y[3] * r1[3]};
                                    b0 = (f32x4){y[0] * r0[0] + x[0] * r0[1], y[1] * r0[2] + x[1] * r0[3], y[2] * r1[0] + x[2] * r1[1], y[3] * r1[2] + x[3] * r1[3]};
                    x = a1; y = b1; a1 = (f32x4){x[0] * r2[0] - y[0] * r2[1], x[1] * r2[2] - y[1] * r2[3], x[2] * r3[0] - y[2] * r3[1], x[3] * r3[2] - y[3] * r3[3]};
                                    b1 = (f32x4){y[0] * r2[0] + x[0] * r2[1], y[1] * r2[2] + x[1] * r2[3], y[2] * r3[0] + x[2] * r3[1], y[3] * r3[2] + x[3] * r3[3]};
                    a0 = a0 * ksc; a1 = a1 * ksc; b0 = b0 * ksc; b1 = b1 * ksc; }
                v4u w; w.x = cvt_pk_bf16(a0[0], a0[1]); w.y = cvt_pk_bf16(a0[2], a0[3]); w.z = cvt_pk_bf16(a1[0], a1[1]); w.w = cvt_pk_bf16(a1[2], a1[3]);
                *(v4u*)(rowp) = w;
                w.x = cvt_pk_bf16(b0[0], b0[1]); w.y = cvt_pk_bf16(b0[2], b0[3]); w.z = cvt_pk_bf16(b1[0], b1[1]); w.w = cvt_pk_bf16(b1[2], b1[3]);
                *(v4u*)(rowp + HALF) = w; }
    }
};
struct EpiResid {
    static constexpr bool PERM = false;
    const float* base; float* out; const float* gates; int gstride;
    __device__ __forceinline__ void operator()(const f32x4 (&acc)[2][2][4][2], const Unit& u, int wr, int wc, int fr, int fq) const {
        const int row0 = u.pm * BM + wr * 64 + fr, col0 = u.pn * BM + wc * 32 + 4 * fq;
        const float* gp = gates + (size_t)((u.pm * BM) / SEQ) * gstride + col0;
        f32x4 gv[2][2];
#pragma unroll
        for (int bj = 0; bj < 2; ++bj)
#pragma unroll
            for (int n = 0; n < 2; ++n) gv[bj][n] = *(const f32x4*)(gp + bj * HALF + n * 16);
#pragma unroll
        for (int ai = 0; ai < 2; ++ai)
#pragma unroll
            for (int m = 0; m < 4; ++m) { const size_t off = (size_t)(row0 + ai * HALF + m * 16) * D + col0;
#pragma unroll
                for (int bj = 0; bj < 2; ++bj)
#pragma unroll
                    for (int n = 0; n < 2; ++n) { const f32x4 bs = *(const f32x4*)(base + off + bj * HALF + n * 16); *(f32x4*)(out + off + bj * HALF + n * 16) = bs + gv[bj][n] * acc[ai][bj][m][n]; } }
    }
};
struct EpiSwiglu {
    static constexpr bool PERM = true;
    bf16* O; int ldc;
    __device__ __forceinline__ void operator()(const f32x4 (&acc)[2][2][4][2], const Unit& u, int wr, int wc, int fr, int fq) const {
        const int row0 = u.pm * BM + wr * 64 + fr, col0 = u.pn * HALF + wc * 32 + 8 * fq;
#pragma unroll
        for (int ai = 0; ai < 2; ++ai)
#pragma unroll
            for (int m = 0; m < 4; ++m) { bf16* rowp = O + (size_t)(row0 + ai * HALF + m * 16) * ldc + col0;
                float h[8];
#pragma unroll
                for (int n = 0; n < 2; ++n)
#pragma unroll
                    for (int i = 0; i < 4; ++i) h[n * 4 + i] = fast_silu(acc[ai][0][m][n][i]) * acc[ai][1][m][n][i];
                v4u w; w.x = cvt_pk_bf16(h[0], h[1]); w.y = cvt_pk_bf16(h[2], h[3]); w.z = cvt_pk_bf16(h[4], h[5]); w.w = cvt_pk_bf16(h[6], h[7]);
                *(v4u*)(rowp) = w; }
    }
};
struct EpiMoeDown {
    static constexpr bool PERM = false;
    float* H; const float* gates; int gstride; const int2* list; const LAS int* tb;
    __device__ __forceinline__ void operator()(const f32x4 (&acc)[2][2][4][2], const Unit& u, int wr, int wc, int fr, int fq) const {
        const int col0 = u.pn * BM + wc * 32 + 4 * fq; const int cnt = tb[16 + u.e];
#pragma unroll
        for (int ai = 0; ai < 2; ++ai)
#pragma unroll
            for (int m = 0; m < 4; ++m) { const int idx = u.mt * BM + ai * HALF + wr * 64 + m * 16 + fr;
                if (idx < cnt) { const int2 tw = list[(size_t)u.e * T + idx]; const float w = __int_as_float(tw.y);
                    const float* gp = gates + (size_t)(tw.x / SEQ) * gstride + col0; float* hp = H + (size_t)tw.x * D + col0;
#pragma unroll
                    for (int bj = 0; bj < 2; ++bj)
#pragma unroll
                        for (int n = 0; n < 2; ++n) { const f32x4 g = *(const f32x4*)(gp + bj * HALF + n * 16); f32x4* p = (f32x4*)(hp + bj * HALF + n * 16); *p = *p + (g * w) * acc[ai][bj][m][n]; } } }
    }
};

template <class Epi, class Sched, bool GATHER>
__device__ __forceinline__ void gemm_phase(LAS unsigned char* lds, const Sched& S, const Epi& E, const int tid) {
    const int wid = __builtin_amdgcn_readfirstlane(tid >> 6), lane = tid & 63, wr = wid >> 2, wc = wid & 3, fr = lane & 15, fq = lane >> 4;
    const int K = S.K, lda = S.lda, nt = K / BK;
    int RA[2], CA[2]; unsigned voffB[2];
#pragma unroll
    for (int i = 0; i < 2; ++i) { int R, C; stage_rc(tid * 16 + i * 8192, R, C); const int Rb = Epi::PERM ? ((R & ~31) + perm32(R & 31)) : R;
        RA[i] = R; CA[i] = C; voffB[i] = (unsigned)(Rb * K + C) * 2u; }
    const size_t kstep = (size_t)(BK * 2);
    const size_t hstepB = (size_t)HALF * K * 2;
    const unsigned ldsw = (unsigned)wid * 1024u;
    const int aoff = lds_byte(wr * 64 + fr, fq * 8), boff = lds_byte(wc * 32 + fr, fq * 8);
#define PG8_SA(b, h) (((b) * 2 + (h)) * HTB)
#define PG8_SB(b, h) ((4 + (b) * 2 + (h)) * HTB)
#define PG8_STAGE2(bufoff, gbase, v0, v1) do { \
        __builtin_amdgcn_global_load_lds((const unsigned*)((const char*)(gbase) + (v0)), (LAS unsigned*)(lds + (bufoff) + ldsw), 16, 0, 0); \
        __builtin_amdgcn_global_load_lds((const unsigned*)((const char*)(gbase) + (v1)), (LAS unsigned*)(lds + (bufoff) + ldsw + 8192), 16, 0, 0); } while (0)
#define PG8_STA(b, h, ptr, V) PG8_STAGE2(PG8_SA(b, h), ptr, V[h][0], V[h][1])
#define PG8_STB(b, h, ptr) PG8_STAGE2(PG8_SB(b, h), (ptr) + (h) * hstepB, voffB[0], voffB[1])
#define PG8_LDA(dst, b, h) do { _Pragma("unroll") for (int m = 0; m < 4; ++m) _Pragma("unroll") for (int k = 0; k < 2; ++k) dst[m][k] = *(const LAS bf16x8*)(lds + PG8_SA(b, h) + aoff + m * 2048 + k * 1024); } while (0)
#define PG8_LDB(dst, b, h) do { _Pragma("unroll") for (int n = 0; n < 2; ++n) _Pragma("unroll") for (int k = 0; k < 2; ++k) dst[n][k] = *(const LAS bf16x8*)(lds + PG8_SB(b, h) + boff + n * 2048 + k * 1024); } while (0)
#define PG8_MMA(ai, bj, At, Bt) do { __builtin_amdgcn_s_setprio(1); _Pragma("unroll") for (int m = 0; m < 4; ++m) _Pragma("unroll") for (int n = 0; n < 2; ++n) _Pragma("unroll") for (int k = 0; k < 2; ++k) \
        acc[ai][bj][m][n] = __builtin_amdgcn_mfma_f32_16x16x32_bf16(Bt[n][k], At[m][k], acc[ai][bj][m][n], 0, 0, 0); __builtin_amdgcn_s_setprio(0); } while (0)
#define PG8_WAIT_V(n) asm volatile("s_waitcnt vmcnt(" #n ")" ::: "memory")
#define PG8_WAIT_L(n) asm volatile("s_waitcnt lgkmcnt(" #n ")" ::: "memory")
#define PG8_BAR __builtin_amdgcn_s_barrier()
#define PG8_SCHED __builtin_amdgcn_sched_barrier(0)
    Unit cur, nxt; int ui = 0;
    if (!S.next(0, cur)) return;
    unsigned cv[2][2], nv[2][2];
#pragma unroll
    for (int h = 0; h < 2; ++h)
#pragma unroll
        for (int i = 0; i < 2; ++i) { const int rr = RA[i] + HALF * h; cv[h][i] = (unsigned)((GATHER ? S.row_tok(cur, rr) : rr) * lda + CA[i]) * 2u; nv[h][i] = cv[h][i]; }
    if (GATHER) { asm volatile("s_waitcnt vmcnt(0)" : "+v"(cv[0][0]), "+v"(cv[0][1]), "+v"(cv[1][0]), "+v"(cv[1][1]) :: "memory"); }
    f32x4 acc[2][2][4][2];
#pragma unroll
    for (int a = 0; a < 2; ++a)
#pragma unroll
        for (int b = 0; b < 2; ++b)
#pragma unroll
            for (int m = 0; m < 4; ++m)
#pragma unroll
                for (int n = 0; n < 2; ++n) acc[a][b][m][n] = (f32x4){0.f, 0.f, 0.f, 0.f};
    bf16x8 At[4][2], B0[2][2], B1[2][2];
    const char* cA = S.a_tile(cur); const char* cB = S.b_tile(cur);
    PG8_STB(0, 0, cB); PG8_STB(0, 1, cB); PG8_STA(0, 0, cA, cv); PG8_STA(0, 1, cA, cv);
    if (wr == 1) PG8_BAR;
    PG8_WAIT_V(2); PG8_BAR;
    PG8_STB(1, 0, cB + kstep); PG8_STA(1, 0, cA + kstep, cv); PG8_STB(1, 1, cB + kstep);
    PG8_WAIT_V(6); PG8_BAR;
    for (;;) {
        const bool has_next = S.next(ui + 1, nxt);
        const char* nA = has_next ? S.a_tile(nxt) : cA; const char* nB = has_next ? S.b_tile(nxt) : cB;
        if (GATHER) {
            if (has_next) {
#pragma unroll
                for (int h = 0; h < 2; ++h)
#pragma unroll
                    for (int i = 0; i < 2; ++i) nv[h][i] = (unsigned)(S.row_tok(nxt, RA[i] + HALF * h) * lda + CA[i]) * 2u;
            }
            asm volatile("s_waitcnt vmcnt(0)" : "+v"(nv[0][0]), "+v"(nv[0][1]), "+v"(nv[1][0]), "+v"(nv[1][1]) :: "memory");
        }
        for (int t = 0; t < nt; t += 2) {
            const bool last = (t == nt - 2);
            const char* a1 = cA + (size_t)(t + 1) * kstep;
            const char* a2 = last ? nA : cA + (size_t)(t + 2) * kstep; const char* b2 = last ? nB : cB + (size_t)(t + 2) * kstep;
            const char* a3 = a2 + kstep; const char* b3 = b2 + kstep;
            unsigned v2[2][2];
#pragma unroll
            for (int h = 0; h < 2; ++h)
#pragma unroll
                for (int i = 0; i < 2; ++i) v2[h][i] = GATHER ? (last ? nv[h][i] : cv[h][i]) : cv[h][i];
            PG8_LDB(B0, 0, 0); PG8_LDB(B1, 0, 1); PG8_SCHED; PG8_LDA(At, 0, 0); PG8_STA(1, 1, a1, cv);
            PG8_WAIT_V(8); PG8_WAIT_L(0); PG8_BAR; PG8_MMA(0, 0, At, B0); PG8_MMA(0, 1, At, B1); PG8_BAR; PG8_SCHED;
            PG8_LDA(At, 0, 1); PG8_STB(0, 0, b2); PG8_STB(0, 1, b2); PG8_STA(0, 0, a2, v2);
            PG8_WAIT_V(8); PG8_WAIT_L(0); PG8_BAR; PG8_MMA(1, 0, At, B0); PG8_MMA(1, 1, At, B1); PG8_BAR; PG8_SCHED;
            PG8_LDB(B0, 1, 0); PG8_LDB(B1, 1, 1); PG8_SCHED; PG8_LDA(At, 1, 0); PG8_STA(0, 1, a2, v2);
            PG8_WAIT_V(8); PG8_WAIT_L(0); PG8_BAR; PG8_MMA(0, 0, At, B0); PG8_MMA(0, 1, At, B1); PG8_BAR; PG8_SCHED;
            PG8_LDA(At, 1, 1); PG8_STB(1, 0, b3); PG8_STB(1, 1, b3); PG8_STA(1, 0, a3, v2);
            PG8_WAIT_V(8); PG8_WAIT_L(0); PG8_BAR; PG8_MMA(1, 0, At, B0); PG8_MMA(1, 1, At, B1); PG8_BAR; PG8_SCHED;
        }
        if (wr == 0) PG8_BAR;
        E(acc, cur, wr, wc, fr, fq);
        if (!has_next) break;
#pragma unroll
        for (int a = 0; a < 2; ++a)
#pragma unroll
            for (int b = 0; b < 2; ++b)
#pragma unroll
                for (int m = 0; m < 4; ++m)
#pragma unroll
                    for (int n = 0; n < 2; ++n) acc[a][b][m][n] = (f32x4){0.f, 0.f, 0.f, 0.f};
        cur = nxt; cA = nA; cB = nB; ++ui;
#pragma unroll
        for (int h = 0; h < 2; ++h)
#pragma unroll
            for (int i = 0; i < 2; ++i) cv[h][i] = nv[h][i];
        if (wr == 1) PG8_BAR;
    }
    PG8_WAIT_V(0);
    PG8_BAR;
#undef PG8_SA
#undef PG8_SB
#undef PG8_STAGE2
#undef PG8_STA
#undef PG8_STB
#undef PG8_LDA
#undef PG8_LDB
#undef PG8_MMA
#undef PG8_WAIT_V
#undef PG8_WAIT_L
#undef PG8_BAR
#undef PG8_SCHED
}
}

namespace attn_body {
using hbf16 = __hip_bfloat16;
using f32x16 = __attribute__((ext_vector_type(16))) float;
using u32x4 = __attribute__((ext_vector_type(4))) unsigned;
constexpr int NHEAD = FH, DH = 64, DM = NHEAD * DH;
constexpr int NW = 8, QBLK = 32, QB = QBLK * NW, KVBLK = 64, NQB = SEQ / QB;
__device__ __forceinline__ int crow(int r, int hi) { return (r & 3) + 8 * (r >> 2) + 4 * hi; }
#define SBAR() __builtin_amdgcn_sched_barrier(0)
__device__ __forceinline__ void cmask(f32x16& p0, f32x16& p1, int jb, int qrel, int hi) {
  const float NEG = -INFINITY; int kb = 64 * jb + 4 * hi;
  #pragma unroll
  for (int r = 0; r < 16; ++r) { int kv = kb + (r & 3) + 8 * (r >> 2); if (kv > qrel) p0[r] = NEG; if (kv + 32 > qrel) p1[r] = NEG; }
}
constexpr int NSLOT = 3, SLOTB = 8192;
constexpr int LDS_K = 0, LDS_V = NSLOT * SLOTB, LDS_WS = 2 * NSLOT * SLOTB, LDS_OST = LDS_WS + NW * 64 * 4, LDS_BIAS = LDS_OST + NW * 4096, LDS_BYTES = LDS_BIAS + SEQ * 4;
__device__ __forceinline__ void glds16(const void* gsrc, unsigned lds_dst) { unsigned keep;
  asm volatile("s_mov_b32 %0, m0\n\ts_mov_b32 m0, %2\n\ts_nop 0\n\tglobal_load_lds_dwordx4 %1, off\n\ts_mov_b32 m0, %0" : "=&s"(keep) : "v"(gsrc), "s"(lds_dst) : "memory"); }
__device__ __forceinline__ float max3f(float a, float b, float c) { float r; asm("v_max3_f32 %0, %1, %2, %3" : "=v"(r) : "v"(a), "v"(b), "v"(c)); return r; }
__device__ __forceinline__ float max2f(float a, float b) { float r; asm("v_max_f32_e32 %0, %1, %2" : "=v"(r) : "v"(a), "v"(b)); return r; }
__device__ __forceinline__ float fadd_s(float a, float b) { float r; asm("v_add_f32_e32 %0, %1, %2" : "=v"(r) : "v"(a), "v"(b)); return r; }
__device__ __forceinline__ float fsub_s(float a, float b) { float r; asm("v_sub_f32_e32 %0, %1, %2" : "=v"(r) : "v"(a), "v"(b)); return r; }
typedef float f32x2_t __attribute__((ext_vector_type(2))); typedef __bf16 bf16x2_t __attribute__((ext_vector_type(2)));
__device__ __forceinline__ unsigned cvtpk_s(float lo, float hi) { f32x2_t v = {lo, hi}; bf16x2_t b = __builtin_convertvector(v, bf16x2_t); return __builtin_bit_cast(unsigned, b); }
#define WAIT_BAR(N) asm volatile("s_waitcnt vmcnt(" #N ") lgkmcnt(0)\n\ts_barrier" ::: "memory")

__device__ __forceinline__ void qkt(f32x16& p0, f32x16& p1, const char* Kslot, const bf16x8* qr, int r32, int hi) { const f32x16 zero16 = f32x16{};
  const char* kb = Kslot + hi * 1024 + r32 * 16;
  #pragma unroll
  for (int d0 = 0; d0 < 4; ++d0) {
    const bf16x8 b0 = *reinterpret_cast<const bf16x8*>(kb + d0 * 2048);
    const bf16x8 b1 = *reinterpret_cast<const bf16x8*>(kb + d0 * 2048 + 512);
    if (d0 == 0) { p0 = __builtin_amdgcn_mfma_f32_32x32x16_bf16(b0, qr[0], zero16, 0, 0, 0); p1 = __builtin_amdgcn_mfma_f32_32x32x16_bf16(b1, qr[0], zero16, 0, 0, 0); }
    else { p0 = __builtin_amdgcn_mfma_f32_32x32x16_bf16(b0, qr[d0], p0, 0, 0, 0); p1 = __builtin_amdgcn_mfma_f32_32x32x16_bf16(b1, qr[d0], p1, 0, 0, 0); } }
}
typedef __attribute__((address_space(3))) const char* lds_cptr;
typedef short v4i16_t __attribute__((ext_vector_type(4)));
__device__ __forceinline__ void kload8(bf16x8* kf, lds_cptr kp) {
  kf[0] = *(const LAS bf16x8*)(kp);        kf[1] = *(const LAS bf16x8*)(kp + 512);
  kf[2] = *(const LAS bf16x8*)(kp + 2048); kf[3] = *(const LAS bf16x8*)(kp + 2560);
  kf[4] = *(const LAS bf16x8*)(kp + 4096); kf[5] = *(const LAS bf16x8*)(kp + 4608);
  kf[6] = *(const LAS bf16x8*)(kp + 6144); kf[7] = *(const LAS bf16x8*)(kp + 6656);
}
__device__ __forceinline__ void kload2(bf16x8* kf, lds_cptr kp, int j) { kf[2 * j] = *(const LAS bf16x8*)(kp + j * 2048); kf[2 * j + 1] = *(const LAS bf16x8*)(kp + j * 2048 + 512); }
__device__ __forceinline__ s16x4 vtr(lds_cptr p) { return __builtin_bit_cast(s16x4, __builtin_amdgcn_ds_read_tr16_b64_v4i16((LAS v4i16_t*)p)); }
__device__ __forceinline__ float rowmax(const f32x16& p0, const f32x16& p1) {
  float a = max3f(p0[0], p0[1], p1[0]), b = max3f(p0[2], p0[3], p1[1]); a = max3f(a, p1[2], p1[3]);
  #pragma unroll
  for (int r = 4; r < 16; r += 4) { a = max3f(a, p0[r], p0[r + 1]); b = max3f(b, p0[r + 2], p0[r + 3]); a = max3f(a, p1[r], p1[r + 1]); b = max3f(b, p1[r + 2], p1[r + 3]); }
  const float m = max2f(a, b);
  auto rr = __builtin_amdgcn_permlane32_swap(__float_as_uint(m), __float_as_uint(m), false, false);
  return max2f(__uint_as_float(rr[0]), __uint_as_float(rr[1]));
}
__device__ __forceinline__ void pv(f32x16* o, int vb, bf16x8 pa0, bf16x8 pa1, bf16x8 pa2, bf16x8 pa3) {
  #pragma unroll
  for (int d0 = 0; d0 < 2; ++d0) { s16x4 lo[4], hi[4];
    #pragma unroll
    for (int ks = 0; ks < 4; ++ks) {
      asm volatile("ds_read_b64_tr_b16 %0,%1 offset:%c2" : "=&v"(lo[ks]) : "v"(vb), "i"(d0 * 4096 + ks * 1024) : "memory");
      asm volatile("ds_read_b64_tr_b16 %0,%1 offset:%c2" : "=&v"(hi[ks]) : "v"(vb), "i"(d0 * 4096 + ks * 1024 + 512) : "memory"); }
    asm volatile("s_waitcnt lgkmcnt(0)" ::: "memory"); SBAR();
    #define PK(k) (bf16x8){lo[k][0], lo[k][1], lo[k][2], lo[k][3], hi[k][0], hi[k][1], hi[k][2], hi[k][3]}
    o[d0] = __builtin_amdgcn_mfma_f32_32x32x16_bf16(pa0, PK(0), o[d0], 0, 0, 0);
    o[d0] = __builtin_amdgcn_mfma_f32_32x32x16_bf16(pa1, PK(1), o[d0], 0, 0, 0);
    o[d0] = __builtin_amdgcn_mfma_f32_32x32x16_bf16(pa2, PK(2), o[d0], 0, 0, 0);
    o[d0] = __builtin_amdgcn_mfma_f32_32x32x16_bf16(pa3, PK(3), o[d0], 0, 0, 0);
    #undef PK
  }
}
#define ADDBIAS(P0, P1, t) do { const LAS f32x4* bp_ = (const LAS f32x4*)((const LAS float*)((LAS char*)shm + LDS_BIAS) + (t) * 64 + 4 * hi); const float nm_ = -mhat; \
    _Pragma("unroll") for (int k_ = 0; k_ < 4; ++k_) { const f32x4 b0_ = bp_[2 * k_] + nm_, b1_ = bp_[8 + 2 * k_] + nm_; \
      P0[4 * k_] += b0_[0]; P0[4 * k_ + 1] += b0_[1]; P0[4 * k_ + 2] += b0_[2]; P0[4 * k_ + 3] += b0_[3]; \
      P1[4 * k_] += b1_[0]; P1[4 * k_ + 1] += b1_[1]; P1[4 * k_ + 2] += b1_[2]; P1[4 * k_ + 3] += b1_[3]; SBAR(); } } while (0)

template <int THRL> __device__ __forceinline__ void attn_unit(int b, int h, int qb, const hbf16* Q, const hbf16* __restrict__ K, const hbf16* __restrict__ V, const hbf16* __restrict__ Gt, const float* __restrict__ FL, hbf16* O, char* shm, const int tid_in) {
  int tid = tid_in; asm volatile("" : "+v"(tid));
  const int lane = tid & 63, r32 = lane & 31, hi = lane >> 5; const int wid = __builtin_amdgcn_readfirstlane(tid >> 6);
  const long rowbase = (long)b * SEQ; const int q0 = qb * QB;
  const hbf16* Qw = Q + (rowbase + q0 + wid * QBLK) * DM + h * DH;
  const hbf16* Kh = K + rowbase * DM + h * DH, *Vh = V + rowbase * DM + h * DH;
  const unsigned lds0 = (unsigned)(uintptr_t)shm;
  float* wsf = (float*)(shm + LDS_WS) + wid * 64;
  { const float* fl = FL + (size_t)(b * NHEAD + h) * SEQ; const float fref = fl[q0]; LAS float* bw = (LAS float*)((LAS char*)shm + LDS_BIAS);
    for (int i = tid; i < q0 + QB; i += NW * 64) bw[i] = fref - fl[i]; }
  const hbf16* ksrc = Kh + (long)lane * DM + wid * 8;
  const hbf16* vsrc = Vh + (long)(16 * (wid & 3) + (lane >> 2)) * DM + (wid >> 2) * 32 + (lane & 3) * 8;
  const unsigned kdst = lds0 + LDS_K + wid * 1024, vdst = lds0 + LDS_V + wid * 1024;
  #define DMA_K(t, slot) glds16(ksrc + (long)(t) * KVBLK * DM, (unsigned)__builtin_amdgcn_readfirstlane(kdst + (slot)))
  #define DMA_V(t, slot) glds16(vsrc + (long)(t) * KVBLK * DM, (unsigned)__builtin_amdgcn_readfirstlane(vdst + (slot)))
  const char* Kbase = shm + LDS_K; bf16x8 kf[8];
  const lds_cptr shm3 = (lds_cptr)shm; const lds_cptr kp0 = shm3 + LDS_K + hi * 1024 + r32 * 16; const lds_cptr vp0 = shm3 + LDS_V + ((lane >> 4) & 1) * 32 + (lane & 3) * 8 + (4 * hi + ((lane & 15) >> 2)) * 64;
  const int NT = (q0 + QB) / KVBLK;
  DMA_K(0, 0); DMA_V(0, 0); DMA_K(1, SLOTB);
  bf16x8 qr[4];
  #pragma unroll
  for (int d0 = 0; d0 < 4; ++d0) qr[d0] = *reinterpret_cast<const bf16x8*>(&Qw[(long)r32 * DM + d0 * 16 + hi * 8]);
  float mhat = 0.f, l_reg = 0.f; f32x16 o[2]; o[0] = f32x16{}; o[1] = f32x16{}; const f32x16 zero16 = f32x16{};
  const int qrel = wid * QBLK + r32;
  #define CMASK(P0, P1, t) do { int jb_ = (t) - (NT - 4); if (jb_ >= 0) cmask(P0, P1, jb_, qrel, hi); } while (0)
  bool resc = false;
  #define START(P0, P1) do { const float rm = rowmax(P0, P1); resc = false; \
    { const float dl = rm; mhat = fadd_s(mhat, dl); \
      _Pragma("unroll") for (int r = 0; r < 16; ++r) { P0[r] = fsub_s(P0[r], dl); P1[r] = fsub_s(P1[r], dl); } \
      } \
    _Pragma("unroll") for (int r = 0; r < 16; ++r) P0[r] = __builtin_amdgcn_exp2f(P0[r]); } while (0)
  #define RESC() do { if (resc) { asm volatile("s_waitcnt lgkmcnt(0)" ::: "memory"); \
      _Pragma("unroll") for (int d_ = 0; d_ < 2; ++d_) _Pragma("unroll") for (int r = 0; r < 16; ++r) o[d_][r] *= wsf[crow(r, hi)]; } } while (0)
  f32x16 pA0, pA1, pB0, pB1;
  int sl_prev = 0, sl_cur = 0, sl_next = SLOTB;
  #define ROT() do { sl_prev = sl_cur; sl_cur = sl_next; sl_next = (sl_next == (NSLOT - 1) * SLOTB) ? 0 : sl_next + SLOTB; } while (0)
  DMA_K(2, 2 * SLOTB);
  WAIT_BAR(3);
  qkt(pA0, pA1, Kbase, qr, r32, hi); asm volatile("s_nop 15\n\ts_nop 7" : "+v"(pA0), "+v"(pA1)); ADDBIAS(pA0, pA1, 0); CMASK(pA0, pA1, 0);
  START(pA0, pA1);
  _Pragma("unroll") for (int r = 0; r < 16; ++r) pA1[r] = __builtin_amdgcn_exp2f(pA1[r]);
  WAIT_BAR(0);
  DMA_K(3, 0); DMA_V(1, SLOTB);
  ROT();
  kload8(kf, kp0 + sl_cur);
  WAIT_BAR(2);
  s16x4 vlo[8], vhi[8]; u32x4 pw0, pw1, pw2, pw3;
  #define PKW(P, B) cvtpk_s(P[B], P[B + 1])
  #define PAF(k) __builtin_bit_cast(bf16x8, pw##k)
  #define VFR(i) (bf16x8){vlo[i][0], vlo[i][1], vlo[i][2], vlo[i][3], vhi[i][0], vhi[i][1], vhi[i][2], vhi[i][3]}
  #define PIN(x) asm volatile("" : "+v"(x))
  #define MX3(a, b, c) __builtin_fmaxf(__builtin_fmaxf((a), (b)), (c))
  #define GAPA(MF, A0, A1, A2, A3, W0, W1, PW) do { MF; sacc += A0; sacc += A1; sacc += A2; sacc += A3; PIN(sacc); W0; W1; PIN(PW); SBAR(); } while (0)
  #define EX(v) __builtin_amdgcn_exp2f(v)
  #define GAPB(MF, X, B) do { MF; X[B] = EX(X[B]); X[B + 1] = EX(X[B + 1]); X[B + 2] = EX(X[B + 2]); X[B + 3] = EX(X[B + 3]); PIN(X); SBAR(); } while (0)
  #define VRD(i) do { vlo[i] = vtr(vp_ + (((i) >> 2) * 4096 + ((i) & 3) * 1024)); vhi[i] = vtr(vp_ + (((i) >> 2) * 4096 + ((i) & 3) * 1024 + 512)); } while (0)
  #define KRD(G, j) do { if (G) { kload2(kf, kp0 + sl_next, j); SBAR(); } } while (0)
  #define STEP(C0, C1, P0, P1, t, GK, GV, GL) do { SBAR(); \
    const lds_cptr vp_ = vp0 + sl_prev; \
    VRD(0); SBAR(); float sacc = (P0[0] + P0[1]); \
    GAPA(C0 = __builtin_amdgcn_mfma_f32_32x32x16_bf16(kf[0], qr[0], zero16, 0, 0, 0), P0[2], P0[3], P0[4], P0[5],     pw0[0] = PKW(P0, 0), pw0[1] = PKW(P0, 2), pw0); \
    VRD(4); SBAR(); GAPA(C1 = __builtin_amdgcn_mfma_f32_32x32x16_bf16(kf[1], qr[0], zero16, 0, 0, 0), P0[6], P0[7], P0[8], P0[9],     pw0[2] = PKW(P0, 4), pw0[3] = PKW(P0, 6), pw0); \
    VRD(1); SBAR(); GAPA(C0 = __builtin_amdgcn_mfma_f32_32x32x16_bf16(kf[2], qr[1], C0, 0, 0, 0),   P0[10], P0[11], P0[12], P0[13], pw1[0] = PKW(P0, 8), pw1[1] = PKW(P0, 10), pw1); \
    VRD(5); SBAR(); GAPA(C1 = __builtin_amdgcn_mfma_f32_32x32x16_bf16(kf[3], qr[1], C1, 0, 0, 0),   P0[14], P0[15], P1[0], P1[1],   pw1[2] = PKW(P0, 12), pw1[3] = PKW(P0, 14), pw1); \
    VRD(2); SBAR(); GAPA(C0 = __builtin_amdgcn_mfma_f32_32x32x16_bf16(kf[4], qr[2], C0, 0, 0, 0),   P1[2], P1[3], P1[4], P1[5],     pw2[0] = PKW(P1, 0), pw2[1] = PKW(P1, 2), pw2); \
    VRD(6); SBAR(); GAPA(C1 = __builtin_amdgcn_mfma_f32_32x32x16_bf16(kf[5], qr[2], C1, 0, 0, 0),   P1[6], P1[7], P1[8], P1[9],     pw2[2] = PKW(P1, 4), pw2[3] = PKW(P1, 6), pw2); \
    VRD(3); SBAR(); GAPA(C0 = __builtin_amdgcn_mfma_f32_32x32x16_bf16(kf[6], qr[3], C0, 0, 0, 0),   P1[10], P1[11], P1[12], P1[13], pw3[0] = PKW(P1, 8), pw3[1] = PKW(P1, 10), pw3); \
    VRD(7); SBAR(); GAPA(C1 = __builtin_amdgcn_mfma_f32_32x32x16_bf16(kf[7], qr[3], C1, 0, 0, 0),   P1[14], P1[15], 0.f, 0.f,       pw3[2] = PKW(P1, 12), pw3[3] = PKW(P1, 14), pw3); \
    l_reg += sacc; \
    if (GK) { DMA_K((t) + 3, sl_cur); } if (GV) { DMA_V((t) + 1, sl_next); } \
    ADDBIAS(C0, C1, t); \
    CMASK(C0, C1, t); \
    { float a = MX3(C0[0], C0[1], C1[0]), b = MX3(C0[2], C0[3], C1[1]); a = MX3(a, C1[2], C1[3]); \
      _Pragma("unroll") for (int r = 4; r < 16; r += 4) { a = MX3(a, C0[r], C0[r + 1]); b = MX3(b, C0[r + 2], C0[r + 3]); a = MX3(a, C1[r], C1[r + 1]); b = MX3(b, C1[r + 2], C1[r + 3]); } \
      float rm = __builtin_fmaxf(a, b); { auto rr = __builtin_amdgcn_permlane32_swap(__float_as_uint(rm), __float_as_uint(rm), false, false); rm = __builtin_fmaxf(__uint_as_float(rr[0]), __uint_as_float(rr[1])); } \
      resc = false; \
      if (__builtin_expect(__any(rm > (float)THRL), 0)) { const float dl = __builtin_fmaxf(rm, 0.f); mhat += dl; \
        _Pragma("unroll") for (int r = 0; r < 16; ++r) { C0[r] -= dl; C1[r] -= dl; } \
        const float f = __builtin_amdgcn_exp2f(-dl); l_reg *= f; if (hi == 0) wsf[r32] = f; resc = true; } } \
    SBAR(); \
    GAPB(o[0] = __builtin_amdgcn_mfma_f32_32x32x16_bf16(PAF(0), VFR(0), o[0], 0, 0, 0), C0, 0); \
    GAPB(o[1] = __builtin_amdgcn_mfma_f32_32x32x16_bf16(PAF(0), VFR(4), o[1], 0, 0, 0), C0, 4); \
    KRD(GL, 0); GAPB(o[0] = __builtin_amdgcn_mfma_f32_32x32x16_bf16(PAF(1), VFR(1), o[0], 0, 0, 0), C0, 8); \
    KRD(GL, 1); GAPB(o[1] = __builtin_amdgcn_mfma_f32_32x32x16_bf16(PAF(1), VFR(5), o[1], 0, 0, 0), C0, 12); \
    KRD(GL, 2); GAPB(o[0] = __builtin_amdgcn_mfma_f32_32x32x16_bf16(PAF(2), VFR(2), o[0], 0, 0, 0), C1, 0); \
    KRD(GL, 3); GAPB(o[1] = __builtin_amdgcn_mfma_f32_32x32x16_bf16(PAF(2), VFR(6), o[1], 0, 0, 0), C1, 4); \
    GAPB(o[0] = __builtin_amdgcn_mfma_f32_32x32x16_bf16(PAF(3), VFR(3), o[0], 0, 0, 0), C1, 8); \
    GAPB(o[1] = __builtin_amdgcn_mfma_f32_32x32x16_bf16(PAF(3), VFR(7), o[1], 0, 0, 0), C1, 12); \
    } while (0)
  int t = 1;
  #undef CMASK
  #define CMASK(P0, P1, t) do {} while (0)
  for (; t + 5 < NT; t += 2) {
    STEP(pB0, pB1, pA0, pA1, t, true, true, true);     WAIT_BAR(2); RESC(); ROT();
    STEP(pA0, pA1, pB0, pB1, t + 1, true, true, true); WAIT_BAR(2); RESC(); ROT();
  }
  #undef CMASK
  #define CMASK(P0, P1, t) do { int jb_ = (t) - (NT - 4); if (jb_ >= 0) cmask(P0, P1, jb_, qrel, hi); } while (0)
  #define ENDW(tt) do { if ((tt) + 3 < NT) { WAIT_BAR(2); } else if ((tt) + 2 < NT) { WAIT_BAR(1); } else { WAIT_BAR(0); } } while (0)
  for (; t + 1 < NT; t += 2) {
    STEP(pB0, pB1, pA0, pA1, t, (t + 3 < NT), (t + 1 < NT), (t + 1 < NT));         ENDW(t);     RESC(); ROT();
    STEP(pA0, pA1, pB0, pB1, t + 1, (t + 4 < NT), (t + 2 < NT), (t + 2 < NT));     ENDW(t + 1); RESC(); ROT();
  }
  STEP(pB0, pB1, pA0, pA1, NT - 1, false, false, false); RESC();
  { float sacc = pB0[0] + pB0[1]; _Pragma("unroll") for (int r = 2; r < 16; ++r) sacc += pB0[r]; _Pragma("unroll") for (int r = 0; r < 16; ++r) sacc += pB1[r]; l_reg += sacc;
    pw0 = (u32x4){PKW(pB0, 0), PKW(pB0, 2), PKW(pB0, 4), PKW(pB0, 6)}; pw1 = (u32x4){PKW(pB0, 8), PKW(pB0, 10), PKW(pB0, 12), PKW(pB0, 14)}; pw2 = (u32x4){PKW(pB1, 0), PKW(pB1, 2), PKW(pB1, 4), PKW(pB1, 6)}; pw3 = (u32x4){PKW(pB1, 8), PKW(pB1, 10), PKW(pB1, 12), PKW(pB1, 14)};
    SBAR(); int lane_d = lane; asm volatile("" : "+v"(lane_d)); const int vb0 = (int)(lds0 + LDS_V) + ((lane_d >> 4) & 1) * 32 + (lane_d & 3) * 8 + (4 * (lane_d >> 5) + ((lane_d & 15) >> 2)) * 64; pv(o, vb0 + sl_cur, PAF(0), PAF(1), PAF(2), PAF(3)); }
  #undef PKW
  #undef PAF
  #undef VFR
  #undef PIN
  #undef MX3
  #undef GAPA
  #undef GAPB
  #undef EX
  #undef VRD
  #undef KRD
  #undef STEP
  #undef ENDW
  { auto rr = __builtin_amdgcn_permlane32_swap(__float_as_uint(l_reg), __float_as_uint(l_reg), false, false); l_reg = __uint_as_float(rr[0]) + __uint_as_float(rr[1]); }
  if (hi == 0) wsf[32 + r32] = l_reg; asm volatile("s_waitcnt lgkmcnt(0)" ::: "memory");
  float rli[16];
  #pragma unroll
  for (int r = 0; r < 16; ++r) rli[r] = __builtin_amdgcn_rcpf(wsf[32 + crow(r, hi)]);
  int lane_e = lane; asm volatile("" : "+v"(lane_e));
  hbf16* Ow = O + (rowbase + q0 + wid * QBLK) * DM + h * DH;
  const hbf16* Gw = Gt + (rowbase + q0 + wid * QBLK) * DM + h * DH;
  { hbf16* stg = (hbf16*)(shm + LDS_OST) + wid * 2048;
    #pragma unroll
    for (int r = 0; r < 16; ++r) { const int orow = crow(r, hi);
      #pragma unroll
      for (int d0 = 0; d0 < 2; ++d0) stg[orow * 64 + d0 * 32 + r32] = __float2bfloat16(o[d0][r] * rli[r]); }
    asm volatile("s_waitcnt lgkmcnt(0)" ::: "memory");
    #pragma unroll
    for (int i = 0; i < 4; ++i) { const int row = i * 8 + (lane_e >> 3), ch = lane_e & 7; const u32x4 v = *(const u32x4*)(stg + row * 64 + ch * 8);
      const u32x4 g = *(const u32x4*)(Gw + (long)row * DM + ch * 8);
      u32x4 w;
      #pragma unroll
      for (int j = 0; j < 4; ++j) w[j] = cvt_pk_bf16(bf_lo(v[j]) * fast_sigmoid(bf_lo(g[j])), bf_hi(v[j]) * fast_sigmoid(bf_hi(g[j])));
      *(u32x4*)(Ow + (long)row * DM + ch * 8) = w; } }
  asm volatile("s_waitcnt lgkmcnt(0)\n\ts_barrier" ::: "memory");
  #undef DMA_K
  #undef DMA_V
  #undef CMASK
  #undef START
  #undef RESC
  #undef ROT
}
#undef SBAR
#undef WAIT_BAR
#undef ADDBIAS
}

constexpr int RING_OFF = 0, RING_BYTES = 131072;
constexpr int LDSCTL_OFF = 149504, MISC_OFF = LDSCTL_OFF + 320;
constexpr int TB_OFF = MISC_OFF + 128;
constexpr int LDS_BYTES = 150528;
static_assert(attn_body::LDS_BYTES <= LDSCTL_OFF && TB_OFF + 128 <= LDS_BYTES, "LDS map");
constexpr int NWAVES = 8;

#define XB_TMO      128
#define XB_XCNT(j)  (256  + 64 * (j))
#define XB_XSUB(j)  (1280 + 64 * (j))
#define XB_XGEN(j)  (2304 + 64 * (j))
#define XB_TOP      3328
#define XB_TOPGEN   3392
#define XCD_BAR_WORDS 3456
#define XB_SPIN_CAP (1u << 18)
__device__ __forceinline__ unsigned xb_ld(unsigned* p)              { return __hip_atomic_load(p, __ATOMIC_RELAXED, __HIP_MEMORY_SCOPE_AGENT); }
__device__ __forceinline__ unsigned xb_add(unsigned* p, unsigned v) { return __hip_atomic_fetch_add(p, v, __ATOMIC_RELAXED, __HIP_MEMORY_SCOPE_AGENT); }
__device__ __forceinline__ unsigned xb_xcc_id() { return (unsigned)__builtin_amdgcn_s_getreg((3 << 11) | 20) & 0xFu; }
#define XB_SPIN(cond, bar) do { unsigned _sp = 0; while (cond) { __builtin_amdgcn_s_sleep(1); \
    if ((++_sp & 255u) == 0u) { if (xb_ld(&(bar)[XB_TMO])) break; if (_sp > XB_SPIN_CAP) { atomicAdd(&(bar)[XB_TMO], 1u); break; } } } } while (0)
struct XcdBarrier { unsigned* bar; unsigned x; volatile LAS unsigned* st; };
__device__ __forceinline__ XcdBarrier xcd_barrier_post(unsigned* bar, volatile LAS unsigned* st) {
    XcdBarrier b; b.bar = bar; b.x = xb_xcc_id(); b.st = st;
    if (threadIdx.x == 0) (void)xb_add(&bar[XB_XCNT(b.x)], 1u);
    return b;
}
__device__ __forceinline__ void xcd_barrier_complete(unsigned* bar, unsigned x, unsigned& nloc, unsigned& nx) {
    const unsigned G = gridDim.x * gridDim.y * gridDim.z;
    unsigned sum, cnt, mine, sp = 0u;
    for (;;) {
        sum = 0u; cnt = 0u; mine = 0u;
#pragma unroll
        for (unsigned j = 0; j < 16; ++j) { const unsigned c = xb_ld(&bar[XB_XCNT(j)]); sum += c; cnt += (c > 0u) ? 1u : 0u; mine = (j == x) ? c : mine; }
        if (sum == G) break;
        __builtin_amdgcn_s_sleep(1);
        if ((++sp & 255u) == 0u) { if (xb_ld(&bar[XB_TMO])) break; if (sp > XB_SPIN_CAP) { atomicAdd(&bar[XB_TMO], 1u); break; } }
    }
    nloc = mine > 0u ? mine : 1u; nx = cnt > 0u ? cnt : 1u;
}
__device__ __forceinline__ void xcd_barrier(const XcdBarrier& b, const int tid_) {
    asm volatile("s_waitcnt vmcnt(0)" ::: "memory");
    __syncthreads();
    if (tid_ == 0) {
        unsigned* bar = b.bar;
        __builtin_amdgcn_s_waitcnt(0);
        unsigned nloc = b.st[0], nx = b.st[1];
        if (nloc == 0u) { xcd_barrier_complete(bar, b.x, nloc, nx); b.st[0] = nloc; b.st[1] = nx; }
        const unsigned old = xb_add(&bar[XB_XSUB(b.x)], 1u);
        const unsigned gen = old / nloc;
        if (old + 1u == (gen + 1u) * nloc) {
            __builtin_amdgcn_fence(__ATOMIC_RELEASE, "agent");
            asm volatile("s_waitcnt vmcnt(0)" ::: "memory");
            const unsigned og = xb_add(&bar[XB_TOP], 1u);
            const unsigned tg = og / nx;
            if (og + 1u == (tg + 1u) * nx) xb_add(&bar[XB_TOPGEN], 1u);
            else XB_SPIN(xb_ld(&bar[XB_TOPGEN]) == tg, bar);
            __builtin_amdgcn_fence(__ATOMIC_ACQUIRE, "agent");
            xb_add(&bar[XB_XGEN(b.x)], 1u);
            asm volatile("s_waitcnt vmcnt(0)" ::: "memory");
        } else {
            XB_SPIN(xb_ld(&bar[XB_XGEN(b.x)]) == gen, bar);
            __builtin_amdgcn_fence(__ATOMIC_ACQUIRE, "agent");
            asm volatile("s_waitcnt vmcnt(0)" ::: "memory");
        }
    }
    __syncthreads();
}

struct Frame {
    LAS unsigned char* lds;
    volatile LAS unsigned* MISC;
    gu32* ctl;
    int tid, lane, wave;
    int vcu, G;
};
__device__ __forceinline__ float wave_sum(float v) {
#pragma unroll
    for (int o = 1; o < 64; o <<= 1) v += __shfl_xor(v, o);
    return v;
}

__device__ __forceinline__ void p0_transpose_item(const float* W, int K, int N, bf16* WT, int kb, int nb, int dst_row0, LAS float* scr, int lane) {
    const int k0 = 64 * kb, n0 = 32 * nb;
#pragma unroll 8
    for (int i = 0; i < 32; ++i) { const int kk = 2 * i + (lane >> 5); scr[kk * 33 + (lane & 31)] = W[(size_t)(k0 + kk) * N + n0 + (lane & 31)]; }
    LDS_WAIT(); asm volatile("" ::: "memory");
    const int c = lane & 7;
#pragma unroll
    for (int j = 0; j < 4; ++j) { const int n = (lane >> 3) + 8 * j; const LAS float* s = scr + (8 * c) * 33 + n;
        v4u o; o.x = cvt_pk_bf16(s[0 * 33], s[1 * 33]); o.y = cvt_pk_bf16(s[2 * 33], s[3 * 33]); o.z = cvt_pk_bf16(s[4 * 33], s[5 * 33]); o.w = cvt_pk_bf16(s[6 * 33], s[7 * 33]);
        *(GAS v4u*)(WT + (size_t)(dst_row0 + n) * K + k0 + 8 * c) = o; }
    LDS_WAIT(); asm volatile("" ::: "memory");
}
__device__ __forceinline__ bool conv_group(int& r, const float* src, int cnt, int K, int N, bf16* dst, size_t dstride, int mode, LAS float* scr, int lane) {
    const int per = (K / 64) * (N / 32), tot = per * cnt;
    if (r >= tot) { r -= tot; return false; }
    const int mi = r / per, it = r % per, nblk = N / 32, kb = it / nblk, nb = it % nblk, n0 = 32 * nb;
    const int drow = mode == 0 ? n0 : (256 * (n0 / 128) + (n0 % 128) + (mode == 2 ? 128 : 0));
    p0_transpose_item(src + (size_t)mi * K * N, K, N, dst + (size_t)mi * dstride, kb, nb, drow, scr, lane);
    return true;
}


template <int IDX> __device__ __forceinline__ const float* karg() { unsigned long long p; const unsigned long long ka = (unsigned long long)__builtin_amdgcn_kernarg_segment_ptr();
    asm volatile("s_load_dwordx2 %0, %1, %2\n\ts_waitcnt lgkmcnt(0)" : "=s"(p) : "s"(ka), "i"(IDX * 8) : "memory"); return (const float*)(const GAS float*)p; }
#define KIN(i) karg<(i)>()
#define KOUT ((float*)karg<26>())
#define KWS ((unsigned char*)karg<27>())
struct Args { const float* in[26]; float* out; unsigned char* ws; int ph_lo, ph_hi, li, pad; };

template <int MODE>
__device__ __forceinline__ void norm_phase(Frame& F, const float* src, const float* gain, const float* shift, const float* scale, int bstride, bf16* dst, float* dstf,
                                           const float* rw, const float* rb, gu32* moe_cnt, int2* list, const float* wf, const float* bfv, float* logf) {
    const int gw = F.vcu * NWAVES + F.wave, NGW = F.G * NWAVES, lane = F.lane;
    float wr_[MODE == 1 ? 16 : 1][8];
    if (MODE == 1) {
#pragma unroll
        for (int j = 0; j < 4; ++j)
#pragma unroll
            for (int i = 0; i < 4; ++i) { const int col = 256 * j + 4 * lane + i; const f32x4 a = *(const f32x4*)(rw + col * 8), b = *(const f32x4*)(rw + col * 8 + 4);
                wr_[MODE == 1 ? j * 4 + i : 0][0] = a[0]; wr_[MODE == 1 ? j * 4 + i : 0][1] = a[1]; wr_[MODE == 1 ? j * 4 + i : 0][2] = a[2]; wr_[MODE == 1 ? j * 4 + i : 0][3] = a[3];
                wr_[MODE == 1 ? j * 4 + i : 0][4] = b[0]; wr_[MODE == 1 ? j * 4 + i : 0][5] = b[1]; wr_[MODE == 1 ? j * 4 + i : 0][6] = b[2]; wr_[MODE == 1 ? j * 4 + i : 0][7] = b[3]; }
    }
    LAS float* wfl = (LAS float*)(F.lds + RING_OFF);
    if (MODE == 2) { for (int i = F.tid; i < D * FH / 4; i += NWAVES * 64) ((LAS f32x4*)wfl)[i] = ((const f32x4*)wf)[i]; __syncthreads(); }
    for (int b = 0; b < BATCH; ++b) {
        f32x4 ga[4], sh[4];
#pragma unroll
        for (int j = 0; j < 4; ++j) { const f32x4 g = *(const f32x4*)(gain + 256 * j + 4 * lane), sc = *(const f32x4*)(scale + (size_t)b * bstride + 256 * j + 4 * lane);
            ga[j] = g * (sc + 1.0f); sh[j] = *(const f32x4*)(shift + (size_t)b * bstride + 256 * j + 4 * lane); }
        for (int m = b * SEQ + gw; m < (b + 1) * SEQ; m += NGW) {
            const GAS f32x4* xr = (const GAS f32x4*)(src + (size_t)m * D) + lane;
            f32x4 v[4]; float s = 0.f;
#pragma unroll
            for (int j = 0; j < 4; ++j) { v[j] = xr[64 * j]; s += (v[j].x * v[j].x + v[j].y * v[j].y) + (v[j].z * v[j].z + v[j].w * v[j].w); }
            const float rstd = 1.0f / sqrtf(wave_sum(s) * (1.f / D) + EPS);
#pragma unroll
            for (int j = 0; j < 4; ++j) v[j] = (v[j] * rstd) * ga[j] + sh[j];
            if (MODE == 3) { GAS f32x4* o = (GAS f32x4*)(dstf + (size_t)m * D) + lane;
#pragma unroll
                for (int j = 0; j < 4; ++j) o[64 * j] = v[j]; }
            else { GAS unsigned long long* o8 = (GAS unsigned long long*)(dst + (size_t)m * D) + lane;
#pragma unroll
                for (int j = 0; j < 4; ++j) o8[64 * j] = (unsigned long long)cvt_pk_bf16(v[j].x, v[j].y) | ((unsigned long long)cvt_pk_bf16(v[j].z, v[j].w) << 32); }
            if (MODE == 1) {
                float lg[8];
#pragma unroll
                for (int e = 0; e < 8; ++e) { float a = 0.f;
#pragma unroll
                    for (int j = 0; j < 4; ++j)
#pragma unroll
                        for (int i = 0; i < 4; ++i) a += v[j][i] * wr_[MODE == 1 ? j * 4 + i : 0][e];
                    lg[e] = wave_sum(a) + rb[e]; }
                int i1 = 0; float v1 = lg[0];
#pragma unroll
                for (int e = 1; e < 8; ++e) if (lg[e] > v1) { v1 = lg[e]; i1 = e; }
                int i2 = -1; float v2 = -INFINITY;
#pragma unroll
                for (int e = 0; e < 8; ++e) if (e != i1 && lg[e] > v2) { v2 = lg[e]; i2 = e; }
                const float w1 = 1.0f / (1.0f + __expf(v2 - v1)), w2 = 1.0f - w1;
                if (lane == 0) {
                    const unsigned s1 = __hip_atomic_fetch_add(moe_cnt + 64 * i1, 1u, RLX_AGENT);
                    list[(size_t)i1 * T + s1] = make_int2(m, __float_as_int(w1));
                    const unsigned s2 = __hip_atomic_fetch_add(moe_cnt + 64 * (8 + i2), 1u, RLX_AGENT);
                    list[(size_t)(8 + i2) * T + s2] = make_int2(m, __float_as_int(w2));
                }
            }
            if (MODE == 2) {
                float z[16];
#pragma unroll
                for (int hh = 0; hh < 16; ++hh) z[hh] = 0.f;
#pragma unroll
                for (int j = 0; j < 4; ++j)
#pragma unroll
                    for (int i = 0; i < 4; ++i) { const LAS f32x4* wp = (const LAS f32x4*)(wfl + (256 * j + 4 * lane + i) * 16); const float xv = v[j][i];
#pragma unroll
                        for (int q = 0; q < 4; ++q) { const f32x4 w4 = wp[q]; z[4 * q] += xv * w4[0]; z[4 * q + 1] += xv * w4[1]; z[4 * q + 2] += xv * w4[2]; z[4 * q + 3] += xv * w4[3]; } }
                float mine = 0.f;
#pragma unroll
                for (int hh = 0; hh < 16; ++hh) { const float t = wave_sum(z[hh]); if (lane == hh) mine = t; }
                if (lane < 16) { const float zz = mine + bfv[lane];
                    const float ls = -__builtin_amdgcn_logf(1.0f + __builtin_amdgcn_exp2f(-zz * LOG2E));
                    logf[(size_t)m * FH + lane] = ls; }
            }
        }
    }
    if (MODE == 2) __syncthreads();
}

namespace ret {
constexpr int NG = 8, CG = SEQ / 64 / NG  , VS = 128;
constexpr int QSB = 528, VSB = 272, PSB = 144, OSB = 272;
constexpr int L_Q = 0, L_K = 64 * QSB, L_V = 2 * 64 * QSB, L_P = L_V + 64 * VSB, L_O = L_P + 64 * PSB, L_END = L_O + 64 * OSB;
static_assert(L_END <= RING_BYTES, "scan LDS");
__device__ __forceinline__ s16x4 trr(const LAS unsigned char* p) { return __builtin_bit_cast(s16x4, __builtin_amdgcn_ds_read_tr16_b64_v4i16((LAS attn_body::v4i16_t*)p)); }
template <bool OUT>
__device__ __forceinline__ void scan_unit(Frame& F, int u, bf16* proj, float* Lbuf) {
    const int vs = u & 3, grp = (u >> 2) & 7, h = (u >> 5) & 3, b = u >> 7;
    if (!OUT && grp == NG - 1) return;
    const int tid = F.tid, lane = F.lane, w = F.wave, c = lane & 15, g = lane >> 4;
    LAS unsigned char* L = F.lds + RING_OFF;
    const float l2g0 = __builtin_amdgcn_logf(1.0f - __builtin_amdgcn_exp2f(-5.0f - (float)h));
    f32x4 st[16];
#pragma unroll
    for (int t = 0; t < 16; ++t) st[t] = (f32x4){0.f, 0.f, 0.f, 0.f};
    if (OUT) {
        for (int gp = 0; gp < grp; ++gp) {
            const float wgt = __builtin_amdgcn_exp2f(l2g0 * 2048.0f * (float)(grp - 1 - gp));
            const int up = (u & ~(7 << 2)) | (gp << 2);
            const f32x4* lp = (const f32x4*)Lbuf + ((size_t)(up * 8 + w) * 16) * 64 + lane;
#pragma unroll
            for (int t = 0; t < 16; ++t) st[t] += lp[t * 64] * wgt;
        }
    }
    const size_t row0 = (size_t)b * SEQ + (size_t)grp * (CG * 64);
    const bf16* qg = proj + row0 * PROJW + h * RQK;
    const bf16* kg = proj + row0 * PROJW + D + h * RQK;
    bf16* vg = proj + row0 * PROJW + 2 * D + h * RV + vs * VS;
    v4u pq[4], pk[4], pvv[2];
#define LOADCH(cc) do { \
        _Pragma("unroll") for (int i = 0; i < 4; ++i) { const int p = tid + 512 * i, r = p >> 5, cp = p & 31; \
            if (OUT) pq[i] = *(const v4u*)(qg + ((size_t)(cc) * 64 + r) * PROJW + cp * 8); \
            pk[i] = *(const v4u*)(kg + ((size_t)(cc) * 64 + r) * PROJW + cp * 8); } \
        _Pragma("unroll") for (int i = 0; i < 2; ++i) { const int p = tid + 512 * i, r = p >> 4, cp = p & 15; \
            pvv[i] = *(const v4u*)(vg + ((size_t)(cc) * 64 + r) * PROJW + cp * 8); } } while (0)
    LOADCH(0);
    for (int cc = 0; cc < CG; ++cc) {
        float l2g = l2g0; asm volatile("" : "+v"(l2g));
#pragma unroll
        for (int i = 0; i < 4; ++i) { const int p = tid + 512 * i, r = p >> 5, cp = p & 31;
            if (OUT) *(LAS v4u*)(L + L_Q + r * QSB + cp * 16) = pq[i];
            *(LAS v4u*)(L + L_K + r * QSB + cp * 16) = pk[i]; }
#pragma unroll
        for (int i = 0; i < 2; ++i) { const int p = tid + 512 * i, r = p >> 4, cp = p & 15; const float kd = __builtin_amdgcn_exp2f(l2g * (float)(63 - r));
            v4u o;
#pragma unroll
            for (int j = 0; j < 4; ++j) o[j] = cvt_pk_bf16(bf_lo(pvv[i][j]) * kd, bf_hi(pvv[i][j]) * kd);
            *(LAS v4u*)(L + L_V + r * VSB + cp * 16) = o; }
        __syncthreads();
        if (cc + 1 < CG) LOADCH(cc + 1);
        if (OUT) {
#pragma unroll
            for (int ti = 0; ti < 2; ++ti) { const int idx = 2 * w + ti, mt = idx >> 2, ntl = idx & 3;
                f32x4 acc = (f32x4){0.f, 0.f, 0.f, 0.f};
#pragma unroll
                for (int ks = 0; ks < 8; ++ks) { const bf16x8 a = *(const LAS bf16x8*)(L + L_K + (16 * mt + c) * QSB + (32 * ks + 8 * g) * 2), bq = *(const LAS bf16x8*)(L + L_Q + (16 * ntl + c) * QSB + (32 * ks + 8 * g) * 2);
                    acc = __builtin_amdgcn_mfma_f32_16x16x32_bf16(a, bq, acc, 0, 0, 0); }
                const int n = 16 * ntl + c; float pvl[4];
#pragma unroll
                for (int i = 0; i < 4; ++i) { const int m = 16 * mt + 4 * g + i; const float e = (m <= n) ? -64.0f : (float)(2 * (m - n) - 64); pvl[i] = acc[i] * __builtin_amdgcn_exp2f(l2g * e); }
                v2u pw; pw.x = cvt_pk_bf16(pvl[0], pvl[1]); pw.y = cvt_pk_bf16(pvl[2], pvl[3]);
                *(LAS v2u*)(L + L_P + n * PSB + (16 * mt + 4 * g) * 2) = pw; }
            __syncthreads();
        }
        bf16x8 bv[2];
#pragma unroll
        for (int ks = 0; ks < 2; ++ks) { const LAS unsigned char* vp = L + L_V + (32 * ks + 8 * g + (c >> 2)) * VSB + (16 * w + 4 * (c & 3)) * 2;
            const s16x4 lo = trr(vp), hi = trr(vp + 4 * VSB); bv[ks] = (bf16x8){lo[0], lo[1], lo[2], lo[3], hi[0], hi[1], hi[2], hi[3]}; }
        if (OUT) {
            f32x4 ao[4];
#pragma unroll
            for (int nt_ = 0; nt_ < 4; ++nt_) ao[nt_] = (f32x4){0.f, 0.f, 0.f, 0.f};
#pragma unroll
            for (int ks = 0; ks < 2; ++ks)
#pragma unroll
                for (int nt_ = 0; nt_ < 4; ++nt_) { const bf16x8 a = *(const LAS bf16x8*)(L + L_P + (16 * nt_ + c) * PSB + (32 * ks + 8 * g) * 2); ao[nt_] = __builtin_amdgcn_mfma_f32_16x16x32_bf16(a, bv[ks], ao[nt_], 0, 0, 0); }
#pragma unroll
            for (int ks = 0; ks < 8; ++ks) { v4u sb; sb.x = cvt_pk_bf16(st[2 * ks][0], st[2 * ks][1]); sb.y = cvt_pk_bf16(st[2 * ks][2], st[2 * ks][3]); sb.z = cvt_pk_bf16(st[2 * ks + 1][0], st[2 * ks + 1][1]); sb.w = cvt_pk_bf16(st[2 * ks + 1][2], st[2 * ks + 1][3]);
                const bf16x8 sfrag = __builtin_bit_cast(bf16x8, sb);
#pragma unroll
                for (int nt_ = 0; nt_ < 4; ++nt_) { const bf16x8 a = *(const LAS bf16x8*)(L + L_Q + (16 * nt_ + c) * QSB + (32 * ks + 8 * g) * 2); ao[nt_] = __builtin_amdgcn_mfma_f32_16x16x32_bf16(a, sfrag, ao[nt_], 0, 0, 0); } }
#pragma unroll
            for (int nt_ = 0; nt_ < 4; ++nt_)
#pragma unroll
                for (int i = 0; i < 4; ++i) { const int n = 16 * nt_ + 4 * g + i; const float ov = ao[nt_][i] * __builtin_amdgcn_exp2f(l2g * (float)(n + 1));
                    *(LAS bf16*)(L + L_O + n * OSB + (16 * w + c) * 2) = (bf16)(cvt_pk_bf16(ov, 0.f) & 0xffffu); }
        }
        const float cdec = __builtin_amdgcn_exp2f(l2g * 64.0f);
#pragma unroll
        for (int t = 0; t < 16; ++t) { f32x4 a = st[t] * cdec;
#pragma unroll
            for (int ks = 0; ks < 2; ++ks) { const LAS unsigned char* kp = L + L_K + (32 * ks + 8 * g + (c >> 2)) * QSB + (32 * (t >> 1) + 4 * (t & 1) + 8 * (c & 3)) * 2;
                const s16x4 lo = trr(kp), hi = trr(kp + 4 * QSB); const bf16x8 kf = (bf16x8){lo[0], lo[1], lo[2], lo[3], hi[0], hi[1], hi[2], hi[3]};
                a = __builtin_amdgcn_mfma_f32_16x16x32_bf16(kf, bv[ks], a, 0, 0, 0); }
            st[t] = a; }
        __syncthreads();
        if (OUT) {
#pragma unroll
            for (int i = 0; i < 2; ++i) { const int p = tid + 512 * i, r = p >> 4, cp = p & 15;
                *(v4u*)(vg + ((size_t)cc * 64 + r) * PROJW + cp * 8) = *(const LAS v4u*)(L + L_O + r * OSB + cp * 16); }
        }
    }
#undef LOADCH
    if (!OUT) { f32x4* lp = (f32x4*)Lbuf + ((size_t)(u * 8 + w) * 16) * 64 + lane;
#pragma unroll
        for (int t = 0; t < 16; ++t) lp[t * 64] = st[t]; }
}
}

__device__ __forceinline__ int lane_id_opaque() { int l; asm volatile("v_mbcnt_lo_u32_b32 %0, -1, 0\n\tv_mbcnt_hi_u32_b32 %0, -1, %0" : "=v"(l)); return l; }
#define PHASE(k, sync, ...) do { if (lo <= (k) && (k) < hi) { F.lane = lane_id_opaque(); F.tid = F.wave * 64 + F.lane; __VA_ARGS__ if ((sync) && (k) + 1 < hi) xcd_barrier(bar, F.tid); } } while (0)
#define WSP(T_, off) ((T_*)(KWS + (off)))
#define MODP(l) (WSP(float, WS_MOD) + (l) * MOD_L)

__device__ __forceinline__ void moe_table(Frame& F, LAS int* TB, gu32* mcnt, int rk) {
    __syncthreads();
    if (F.tid == 0) { int acc = 0; for (int e = 0; e < 8; ++e) { const int cnt = (int)__hip_atomic_load(mcnt + 64 * (rk * 8 + e), RLX_AGENT); TB[e] = acc; TB[16 + e] = cnt; acc += (cnt + 255) >> 8; } TB[8] = acc; }
    __syncthreads();
}

template <int L, int P>
__device__ __forceinline__ void ffn_part(Frame& F, const XcdBarrier& bar, const int lo, const int hi) {
    constexpr int I = L >> 1;
    if constexpr ((L & 1) == 0) {
        PHASE(P, true, { norm_phase<0>(F, KOUT, KIN(4) + (L * 2 + 1) * D, MODP(L) + 3 * D, MODP(L) + 4 * D, 6 * D, WSP(bf16, WS_XN), nullptr, nullptr, nullptr, nullptr, nullptr, nullptr, nullptr, nullptr); });
        PHASE(P + 1, true, { pg8::DenseOrder S{WSP(bf16, WS_XN), WSP(bf16, W_FUP) + (size_t)I * 2 * DFF * D, D, D, T / 256, 2 * DFF / 256, F.G, (int)blockIdx.x};
              pg8::EpiSwiglu E{WSP(bf16, WS_HID), DFF};
              pg8::gemm_phase<pg8::EpiSwiglu, pg8::DenseOrder, false>(F.lds + RING_OFF, S, E, F.tid); });
        PHASE(P + 2, true, { pg8::DenseOrder S{WSP(bf16, WS_HID), WSP(bf16, W_FDN) + (size_t)I * DFF * D, DFF, DFF, T / 256, D / 256, F.G, (int)blockIdx.x};
              pg8::EpiResid E{KOUT, KOUT, MODP(L) + 5 * D, 6 * D};
              pg8::gemm_phase<pg8::EpiResid, pg8::DenseOrder, false>(F.lds + RING_OFF, S, E, F.tid); });
    } else {
        PHASE(P, true, { norm_phase<1>(F, KOUT, KIN(4) + (L * 2 + 1) * D, MODP(L) + 3 * D, MODP(L) + 4 * D, 6 * D, WSP(bf16, WS_XN), nullptr, KIN(18) + (size_t)I * D * NE, KIN(19) + I * NE,
                                       (gu32*)WSP(unsigned, WS_CTL) + CW_MOE + I * 16 * 64, WSP(int2, WS_LIST), nullptr, nullptr, nullptr); });
_Pragma("unroll")
        for (int rk = 0; rk < 2; ++rk) {
            PHASE(P + 1 + 2 * rk, true, { LAS int* TB = (LAS int*)(F.lds + TB_OFF); moe_table(F, TB, (gu32*)WSP(unsigned, WS_CTL) + CW_MOE + I * 16 * 64, rk);
                  pg8::MoeOrder S{WSP(bf16, WS_XN), WSP(bf16, W_MUP) + (size_t)I * 8 * 2 * DFE * D, D, D, 2 * DFE / 256, F.G, (int)blockIdx.x, (size_t)2 * DFE * D, WSP(int2, WS_LIST) + (size_t)rk * 8 * T, TB, true};
                  pg8::EpiSwiglu E{WSP(bf16, WS_HID), DFE};
                  pg8::gemm_phase<pg8::EpiSwiglu, pg8::MoeOrder, true>(F.lds + RING_OFF, S, E, F.tid); });
            PHASE(P + 2 + 2 * rk, true, { LAS int* TB = (LAS int*)(F.lds + TB_OFF); moe_table(F, TB, (gu32*)WSP(unsigned, WS_CTL) + CW_MOE + I * 16 * 64, rk);
                  pg8::MoeOrder S{WSP(bf16, WS_HID), WSP(bf16, W_MDN) + (size_t)I * 8 * DFE * D, DFE, DFE, D / 256, F.G, (int)blockIdx.x, (size_t)DFE * D, WSP(int2, WS_LIST) + (size_t)rk * 8 * T, TB, false};
                  pg8::EpiMoeDown E{KOUT, MODP(L) + 5 * D, 6 * D, WSP(int2, WS_LIST) + (size_t)rk * 8 * T, TB};
                  pg8::gemm_phase<pg8::EpiMoeDown, pg8::MoeOrder, false>(F.lds + RING_OFF, S, E, F.tid); });
        }
    }
}

template <int L, int P>
__device__ __forceinline__ void ret_layer(Frame& F, const XcdBarrier& bar, const int lo, const int hi) {
    PHASE(P, true, { norm_phase<0>(F, L == 0 ? KIN(0) : KOUT, KIN(4) + (L * 2 + 0) * D, MODP(L) + 0 * D, MODP(L) + 1 * D, 6 * D, WSP(bf16, WS_XN), nullptr, nullptr, nullptr, nullptr, nullptr, nullptr, nullptr, nullptr); });
    PHASE(P + 1, true, { pg8::DenseOrder S{WSP(bf16, WS_XN), WSP(bf16, W_RIN) + (size_t)L * 6 * D * D, D, D, T / 256, PROJW / 256, F.G, (int)blockIdx.x};
          pg8::EpiRetIn E{WSP(bf16, WS_PROJ), WSP(f32x2, WS_ROPE)};
          pg8::gemm_phase<pg8::EpiRetIn, pg8::DenseOrder, false>(F.lds + RING_OFF, S, E, F.tid); });
    PHASE(P + 2, true, { for (int u = blockIdx.x; u < 256; u += F.G) ret::scan_unit<false>(F, u, WSP(bf16, WS_PROJ), WSP(float, WS_LST)); });
    PHASE(P + 3, true, { for (int u = blockIdx.x; u < 256; u += F.G) ret::scan_unit<true>(F, u, WSP(bf16, WS_PROJ), WSP(float, WS_LST)); });
    PHASE(P + 4, true, {
          const int gw = F.vcu * NWAVES + F.wave, NGW = F.G * NWAVES; bf16* PROJ = WSP(bf16, WS_PROJ);
          for (int it = gw; it < T * RH; it += NGW) { const int row = it >> 2, hh = it & 3;
              bf16* op = PROJ + (size_t)row * PROJW + 2 * D + hh * RV + F.lane * 8; const bf16* gp = op + 2 * D;
              const v4u ov = *(const v4u*)op, gv = *(const v4u*)gp; float o[8], gg[8];
_Pragma("unroll")
              for (int j = 0; j < 4; ++j) { o[2 * j] = bf_lo(ov[j]); o[2 * j + 1] = bf_hi(ov[j]); gg[2 * j] = bf_lo(gv[j]); gg[2 * j + 1] = bf_hi(gv[j]); }
              float s = 0.f;
_Pragma("unroll")
              for (int j = 0; j < 8; ++j) s += o[j];
              const float mu = wave_sum(s) * (1.0f / RV); float q = 0.f;
_Pragma("unroll")
              for (int j = 0; j < 8; ++j) { o[j] -= mu; q += o[j] * o[j]; }
              const float rstd = 1.0f / sqrtf(wave_sum(q) * (1.0f / RV) + EPS);
              v4u w;
_Pragma("unroll")
              for (int j = 0; j < 4; ++j) w[j] = cvt_pk_bf16(o[2 * j] * rstd * fast_silu(gg[2 * j]), o[2 * j + 1] * rstd * fast_silu(gg[2 * j + 1]));
              *(v4u*)op = w; } });
    PHASE(P + 5, true, { pg8::DenseOrder S{WSP(bf16, WS_PROJ) + 2 * D, WSP(bf16, W_RO) + (size_t)L * 2 * D * D, PROJW, 2 * D, T / 256, D / 256, F.G, (int)blockIdx.x};
          pg8::EpiResid E{L == 0 ? KIN(0) : KOUT, KOUT, MODP(L) + 2 * D, 6 * D};
          pg8::gemm_phase<pg8::EpiResid, pg8::DenseOrder, false>(F.lds + RING_OFF, S, E, F.tid); });
    ffn_part<L, P + 6>(F, bar, lo, hi);
}

template <int L, int P>
__device__ __forceinline__ void fox_layer(Frame& F, const XcdBarrier& bar, const int lo, const int hi, unsigned char* ldsg) {
    constexpr int J = L - 2; constexpr int X = (L == 2) ? 2 : 0;
    PHASE(P, true, { norm_phase<0>(F, KOUT, KIN(4) + (L * 2 + 0) * D, MODP(L) + 0 * D, MODP(L) + 1 * D, 6 * D, WSP(bf16, WS_XN), nullptr, nullptr, nullptr, nullptr, nullptr, nullptr, nullptr, nullptr); });
    if constexpr (L == 2) {
        PHASE(P + 1, true, { norm_phase<2>(F, KOUT, KIN(9), WSP(float, WS_MOD) + MOD_KV, WSP(float, WS_MOD) + MOD_KV + D, 2 * D, WSP(bf16, WS_G), nullptr, nullptr, nullptr, nullptr, nullptr, KIN(11), KIN(12), WSP(float, WS_LOGF)); });
        PHASE(P + 2, true, {
            if (blockIdx.x < 32) {
                const int bb = blockIdx.x >> 4, hh = blockIdx.x & 15; const float* lf = WSP(float, WS_LOGF) + (size_t)bb * SEQ * FH + hh; float* fo = WSP(float, WS_FL2) + (size_t)blockIdx.x * SEQ;
                LAS double* sc = (LAS double*)(F.lds + RING_OFF);
                double s = 0.0;
                for (int i = 0; i < 32; ++i) s += (double)lf[(size_t)(F.tid * 32 + i) * FH];
                sc[F.tid] = s; __syncthreads();
                for (int off = 1; off < 512; off <<= 1) { double t = (F.tid >= off) ? sc[F.tid - off] : 0.0; __syncthreads(); sc[F.tid] += t; __syncthreads(); }
                double run = sc[F.tid] - s;
                for (int i = 0; i < 32; ++i) { run += (double)lf[(size_t)(F.tid * 32 + i) * FH]; fo[F.tid * 32 + i] = (float)run; }
                __syncthreads();
            }
            pg8::DenseOrder S{WSP(bf16, WS_G), WSP(bf16, W_KV), D, D, T / 256, 2 * D / 256, F.G, (int)blockIdx.x};
            pg8::EpiBf16 E{WSP(bf16, WS_K), D, D, (size_t)(WS_V - WS_K) / 2, 1.0f};
            pg8::gemm_phase<pg8::EpiBf16, pg8::DenseOrder, false>(F.lds + RING_OFF, S, E, F.tid); });
    }
    PHASE(P + 1 + X, true, { pg8::DenseOrder S{WSP(bf16, WS_XN), WSP(bf16, W_QG) + (size_t)J * 2 * D * D, D, D, T / 256, 2 * D / 256, F.G, (int)blockIdx.x};
          pg8::EpiBf16 E{WSP(bf16, WS_Q), D, D, (size_t)(WS_G - WS_Q) / 2, QC2};
          pg8::gemm_phase<pg8::EpiBf16, pg8::DenseOrder, false>(F.lds + RING_OFF, S, E, F.tid); });
    PHASE(P + 2 + X, true, { const int vcu = F.vcu, s = vcu & 7, bh = vcu >> 3;
          if (F.G == 256) {
            for (int i = 0; i < 8; ++i) { const int base = 16 * (i >> 1); const int qb = (i & 1) ? base + 15 - s : base + s;
                attn_body::attn_unit<8>(bh / FH, bh % FH, qb, WSP(const attn_body::hbf16, WS_Q), WSP(const attn_body::hbf16, WS_K), WSP(const attn_body::hbf16, WS_V), WSP(const attn_body::hbf16, WS_G),
                                        WSP(const float, WS_FL2), WSP(attn_body::hbf16, WS_Q), (char*)ldsg + RING_OFF, F.tid); }
          } });
    PHASE(P + 3 + X, true, { pg8::DenseOrder S{WSP(bf16, WS_Q), WSP(bf16, W_FO) + (size_t)J * D * D, D, D, T / 256, D / 256, F.G, (int)blockIdx.x};
          pg8::EpiResid E{KOUT, KOUT, MODP(L) + 2 * D, 6 * D};
          pg8::gemm_phase<pg8::EpiResid, pg8::DenseOrder, false>(F.lds + RING_OFF, S, E, F.tid); });
    ffn_part<L, P + 4 + X>(F, bar, lo, hi);
}

__global__ void __launch_bounds__(NWAVES * 64, 2) yoco_fwd(Args args) {
    extern __shared__ __attribute__((aligned(16))) unsigned char lds[];
    Frame F;
    F.lds = (LAS unsigned char*)lds;
    F.MISC = (volatile LAS unsigned*)(F.lds + MISC_OFF);
    F.tid = threadIdx.x; F.lane = F.tid & 63; F.wave = __builtin_amdgcn_readfirstlane(F.tid >> 6);
    F.G = gridDim.x; { const int bx = blockIdx.x; F.vcu = (F.G % 8 == 0) ? (bx % 8) * (F.G / 8) + bx / 8 : bx; }
    F.ctl = (gu32*)(KWS + WS_CTL);
    for (int u = F.tid; u < (LDS_BYTES - LDSCTL_OFF) / 4; u += NWAVES * 64) ((LAS unsigned*)(F.lds + LDSCTL_OFF))[u] = 0u;
    __syncthreads();
    const XcdBarrier bar = xcd_barrier_post((unsigned*)(F.ctl + CW_BAR) + args.li * XCD_BAR_WORDS, F.MISC + 8);
    const int lo = args.ph_lo, hi = args.ph_hi;

    PHASE(0, true, {
    {
        LAS float* ca = (LAS float*)(F.lds + RING_OFF);
        LAS float* red = ca + 2048;
        { const float* cin = KIN(1); for (int i = F.tid; i < 2 * D; i += NWAVES * 64) ca[i] = fast_silu(cin[i]); }
        __syncthreads();
        constexpr int NCOLB = (4 * 6 * D + 2 * D + 2 * D) / 128;
        float* MOD = WSP(float, WS_MOD);
        for (int cb = blockIdx.x; cb < NCOLB; cb += F.G) {
            const int gc = cb * 128 + (F.tid & 127), kq = F.tid >> 7;
            const float* W; const float* bias; int ldw, n; float* outp; int ostride;
            if (gc < 4 * 6 * D) { const int l = gc / (6 * D); n = gc % (6 * D); W = KIN(2) + (size_t)l * D * 6 * D; ldw = 6 * D; bias = KIN(3) + l * 6 * D; outp = MOD + l * MOD_L; ostride = 6 * D; }
            else if (gc < 4 * 6 * D + 2 * D) { n = gc - 4 * 6 * D; W = KIN(7); ldw = 2 * D; bias = KIN(8); outp = MOD + MOD_KV; ostride = 2 * D; }
            else { n = gc - 4 * 6 * D - 2 * D; W = KIN(23); ldw = 2 * D; bias = KIN(24); outp = MOD + MOD_FIN; ostride = 2 * D; }
            float a0 = 0.f, a1 = 0.f; const float* wp = W + (size_t)(256 * kq) * ldw + n;
_Pragma("unroll 8")
            for (int k = 0; k < 256; ++k) { const float wv = wp[(size_t)k * ldw]; a0 += ca[256 * kq + k] * wv; a1 += ca[D + 256 * kq + k] * wv; }
            red[(kq * 2 + 0) * 128 + (F.tid & 127)] = a0; red[(kq * 2 + 1) * 128 + (F.tid & 127)] = a1;
            __syncthreads();
            if (F.tid < 256) { const int bb = F.tid >> 7, cl = F.tid & 127;
                const float s = (red[(0 * 2 + bb) * 128 + cl] + red[(1 * 2 + bb) * 128 + cl]) + (red[(2 * 2 + bb) * 128 + cl] + red[(3 * 2 + bb) * 128 + cl]);
                outp[(size_t)bb * ostride + n] = s + bias[n]; }
            __syncthreads();
        }
    }
    {
        f32x2* rope = WSP(f32x2, WS_ROPE);
        for (int i = blockIdx.x * (NWAVES * 64) + F.tid; i < SEQ * 128; i += F.G * NWAVES * 64) { const int pos = i >> 7, j = i & 127;
            const float inv = __builtin_amdgcn_exp2f(-(float)j * (13.287712379549449f / 128.0f));
            const float ang = (float)pos * inv;
            double tr = (double)ang * 0.15915494309189535; tr -= __builtin_rint(tr); const float tf = (float)tr;
            rope[i] = (f32x2){__builtin_amdgcn_cosf(tf), __builtin_amdgcn_sinf(tf)}; }
    }
    {
        LAS float* scr = (LAS float*)(F.lds + RING_OFF + 16384 + F.wave * 12288);
        const int gw = F.vcu * NWAVES + F.wave, NGW = F.G * NWAVES;
        constexpr int NIT = 2 * 16 * 192 + 2 * 32 * 32 + 16 * 64 + 2 * 16 * 64 + 2 * 16 * 32 + 2 * 2 * 16 * 88 + 2 * 44 * 32 + 2 * 16 * 16 * 112 + 16 * 56 * 32;
        for (int it = gw; it < NIT; it += NGW) { int r = it;
            if (conv_group(r, KIN(5), 2, D, 6 * D, WSP(bf16, W_RIN), (size_t)6 * D * D, 0, scr, F.lane)) continue;
            if (conv_group(r, KIN(6), 2, 2 * D, D, WSP(bf16, W_RO), (size_t)2 * D * D, 0, scr, F.lane)) continue;
            if (conv_group(r, KIN(10), 1, D, 2 * D, WSP(bf16, W_KV), 0, 0, scr, F.lane)) continue;
            if (conv_group(r, KIN(13), 2, D, 2 * D, WSP(bf16, W_QG), (size_t)2 * D * D, 0, scr, F.lane)) continue;
            if (conv_group(r, KIN(14), 2, D, D, WSP(bf16, W_FO), (size_t)D * D, 0, scr, F.lane)) continue;
            if (conv_group(r, KIN(15), 2, D, DFF, WSP(bf16, W_FUP), (size_t)2 * DFF * D, 1, scr, F.lane)) continue;
            if (conv_group(r, KIN(16), 2, D, DFF, WSP(bf16, W_FUP), (size_t)2 * DFF * D, 2, scr, F.lane)) continue;
            if (conv_group(r, KIN(17), 2, DFF, D, WSP(bf16, W_FDN), (size_t)DFF * D, 0, scr, F.lane)) continue;
            if (conv_group(r, KIN(20), 16, D, DFE, WSP(bf16, W_MUP), (size_t)2 * DFE * D, 1, scr, F.lane)) continue;
            if (conv_group(r, KIN(21), 16, D, DFE, WSP(bf16, W_MUP), (size_t)2 * DFE * D, 2, scr, F.lane)) continue;
            conv_group(r, KIN(22), 16, DFE, D, WSP(bf16, W_MDN), (size_t)DFE * D, 0, scr, F.lane);
        }
    }
    });
    ret_layer<0, 1>(F, bar, lo, hi);
    ret_layer<1, 10>(F, bar, lo, hi);
    fox_layer<2, 21>(F, bar, lo, hi, lds);
    fox_layer<3, 30>(F, bar, lo, hi, lds);
    PHASE(39, false, { norm_phase<3>(F, KOUT, KIN(25), WSP(float, WS_MOD) + MOD_FIN, WSP(float, WS_MOD) + MOD_FIN + D, 2 * D, nullptr, KOUT, nullptr, nullptr, nullptr, nullptr, nullptr, nullptr, nullptr); });
}

extern "C" void kernel_launch(void* const* d_in, const int* in_sizes, int n_in, void* d_out, int out_size, void* d_ws, size_t ws_size, hipStream_t stream) {
    static int grid = 0;
    if (grid == 0) {
        if (n_in != 26 || in_sizes[0] != T * D || out_size != T * D || ws_size < WS_END) { fprintf(stderr, "kernel_launch: unexpected shapes / workspace (n_in %d, ws %zu, need %zu)\n", n_in, ws_size, (size_t)WS_END); grid = -1; return; }
        int dev = 0, cus = 0;
        if (hipGetDevice(&dev) != hipSuccess || hipDeviceGetAttribute(&cus, hipDeviceAttributeMultiprocessorCount, dev) != hipSuccess) { grid = -1; return; }
        if (hipFuncSetAttribute((const void*)yoco_fwd, hipFuncAttributeMaxDynamicSharedMemorySize, LDS_BYTES) != hipSuccess) { fprintf(stderr, "kernel_launch: hipFuncSetAttribute failed\n"); grid = -1; return; }
        int per_cu = 0;
        if (hipOccupancyMaxActiveBlocksPerMultiprocessor(&per_cu, (const void*)yoco_fwd, NWAVES * 64, LDS_BYTES) != hipSuccess || per_cu < 1) { fprintf(stderr, "kernel_launch: occupancy query says %d\n", per_cu); }
        (void)hipGetLastError();
        grid = cus;
    }
    if (grid < 0) return;
    (void)hipMemsetAsync((char*)d_ws + WS_CTL, 0, CTL_ZERO_BYTES, stream);
    Args a{};
    for (int i = 0; i < 26; ++i) a.in[i] = (const float*)d_in[i];
    a.out = (float*)d_out; a.ws = (unsigned char*)d_ws;
    constexpr int NPH = 40;
#if MK_N_LAUNCHES == 1
    a.ph_lo = 0; a.ph_hi = NPH; a.li = 0; a.pad = 0;
    hipLaunchKernelGGL(yoco_fwd, dim3(grid), dim3(NWAVES * 64), LDS_BYTES, stream, a);
#else
    for (int p = 0; p < NPH; ++p) { a.ph_lo = p; a.ph_hi = p + 1; a.li = 0; a.pad = 0;
        hipLaunchKernelGGL(yoco_fwd, dim3(grid), dim3(NWAVES * 64), LDS_BYTES, stream, a); }
#endif
}
```

```cpp
#include <hip/hip_runtime.h>
#include <hip/hip_bf16.h>
#include <cstdio>
#include <cstdint>
#include <cmath>

#ifndef MK_N_LAUNCHES
#define MK_N_LAUNCHES 1
#endif

constexpr int BATCH = 2, SEQ = 16384, D = 1024, T = BATCH * SEQ;
constexpr int RH = 4, RQK = 256, RV = 512, PROJW = 6 * D;
constexpr int FH = 16, FD = 64;
constexpr int DFF = 2816, NE = 8, DFE = 3584;
constexpr float EPS = 1e-6f;
constexpr float LOG2E = 1.4426950408889634f;
constexpr float QC2 = 0.125f * 1.4426950408889634f;

#define GAS __attribute__((address_space(1)))
#define LAS __attribute__((address_space(3)))
typedef unsigned short bf16;
typedef unsigned v4u __attribute__((ext_vector_type(4)));
typedef unsigned v2u __attribute__((ext_vector_type(2)));
typedef float f32x4 __attribute__((ext_vector_type(4)));
typedef float f32x2 __attribute__((ext_vector_type(2)));
typedef short bf16x8 __attribute__((ext_vector_type(8)));
typedef short s16x4 __attribute__((ext_vector_type(4)));
typedef GAS unsigned gu32;
#define RLX_AGENT __ATOMIC_RELAXED, __HIP_MEMORY_SCOPE_AGENT
#define LDS_WAIT() asm volatile("s_waitcnt lgkmcnt(0)" ::: "memory")
#define VM_WAIT() asm volatile("s_waitcnt vmcnt(0)" ::: "memory")

__device__ __forceinline__ unsigned cvt_pk_bf16(float lo, float hi) { unsigned r; asm volatile("v_cvt_pk_bf16_f32 %0, %1, %2" : "=v"(r) : "v"(lo), "v"(hi)); return r; }
__device__ __forceinline__ float bf_lo(unsigned u) { return __uint_as_float(u << 16); }
__device__ __forceinline__ float bf_hi(unsigned u) { return __uint_as_float(u & 0xffff0000u); }
__device__ __forceinline__ float fast_sigmoid(float x) { return __builtin_amdgcn_rcpf(1.0f + __builtin_amdgcn_exp2f(-x * LOG2E)); }
__device__ __forceinline__ float fast_silu(float x) { return x * fast_sigmoid(x); }

constexpr size_t MiB = 1u << 20;
constexpr size_t WS_CTL = 0, CTL_ZERO_BYTES = 1 * MiB;
constexpr size_t WS_MOD = 1 * MiB;
constexpr size_t WS_LOGF = 2 * MiB;
constexpr size_t WS_FL2 = 4 * MiB;
constexpr size_t WS_LIST = 6 * MiB;
constexpr size_t WS_ROPE = 10 * MiB;
constexpr size_t WS_LST = 26 * MiB;
constexpr size_t WS_W = 64 * MiB;
constexpr size_t W_RIN = WS_W;
constexpr size_t W_RO = W_RIN + 2 * 12 * MiB;
constexpr size_t W_KV = W_RO + 2 * 4 * MiB;
constexpr size_t W_QG = W_KV + 4 * MiB;
constexpr size_t W_FO = W_QG + 2 * 4 * MiB;
constexpr size_t W_FUP = W_FO + 2 * 2 * MiB;
constexpr size_t W_FDN = W_FUP + 2 * 11 * MiB;
constexpr size_t W_MUP = W_FDN + 11 * MiB;
constexpr size_t W_MDN = W_MUP + 16 * 14 * MiB;
constexpr size_t WS_XN = W_MDN + 16 * 7 * MiB;
constexpr size_t WS_BIG = WS_XN + 64 * MiB;
constexpr size_t WS_PROJ = WS_BIG;
constexpr size_t WS_Q = WS_BIG, WS_G = WS_BIG + 64 * MiB, WS_K = WS_BIG + 256 * MiB, WS_V = WS_BIG + 320 * MiB;
constexpr size_t WS_HID = WS_BIG;
constexpr size_t WS_END = WS_BIG + 384 * MiB;
static_assert(WS_XN == 481 * MiB && WS_END == 929 * MiB, "ws map");
constexpr int HID_ROWS = T + NE * 256;
static_assert((size_t)HID_ROWS * DFE * 2 <= 256 * MiB, "moe hidden fits below K/V");

constexpr int MOD_L = 2 * 6 * D;
constexpr int MOD_KV = 4 * MOD_L, MOD_FIN = MOD_KV + 2 * 2 * D;
constexpr int CW_BAR = 4096;
constexpr int CW_MOE = 16384;
constexpr int CW_NMAX = 24576;
constexpr int CW_DBG = 32768;

namespace pg8 {
constexpr int BM = 256, BK = 64, HALF = 128, HTB = HALF * BK * 2, STAGE_BYTES = 8 * HTB, NXCD = 8, WGM = 8;
__host__ __device__ __forceinline__ int lds_byte(int r, int c) { const int st = (r >> 4) * 2 + (c >> 5), rr = r & 15, cc = c & 31, ob = rr * 64 + cc * 2; return st * 1024 + (ob ^ (((ob >> 9) & 1) << 5)); }
__host__ __device__ __forceinline__ void stage_rc(int b, int& R, int& C) { const int st = b / 1024, sb = b % 1024, swz = sb ^ (((sb >> 9) & 1) << 5); R = (st >> 1) * 16 + swz / 64; C = (st & 1) * 32 + (swz % 64) / 2; }
__host__ __device__ __forceinline__ int perm32(int rho) { const int n = rho >> 4, i = rho & 15; return 8 * (i >> 2) + 4 * n + (i & 3); }

struct Unit { int pm, pn, e, mt; };

__device__ __forceinline__ bool order_tile(int i, int G, int c, int nM, int nN, int& pm, int& pn) {
    const int nwg = nM * nN; const long L = (long)i * G + c; if (L >= nwg) return false;
    int wgid = (int)L; { const int q = nwg / NXCD, r = nwg % NXCD, xcd = wgid % NXCD, off = wgid / NXCD; wgid = (xcd < r ? xcd * (q + 1) : r * (q + 1) + (xcd - r) * q) + off; }
    const int nig = WGM * nN, gid = wgid / nig, fm = gid * WGM, gsz = (nM - fm) < WGM ? (nM - fm) : WGM;
    pm = fm + ((wgid % nig) % gsz); pn = (wgid % nig) / gsz; return true;
}
struct DenseOrder {
    const bf16* A; const bf16* Bt; int lda, K, nM, nN, G, c;
    __device__ __forceinline__ bool next(int i, Unit& u) const { u.e = 0; u.mt = 0; return order_tile(i, G, c, nM, nN, u.pm, u.pn); }
    __device__ __forceinline__ const char* a_tile(const Unit& u) const { return (const char*)A + (size_t)u.pm * BM * lda * 2; }
    __device__ __forceinline__ const char* b_tile(const Unit& u) const { return (const char*)Bt + (size_t)u.pn * BM * K * 2; }
    __device__ __forceinline__ int row_tok(const Unit&, int) const { return 0; }
};
struct MoeOrder {
    const bf16* A; const bf16* Bt; int lda, K, nN, G, c; size_t bstride  ; const int2* list  ; const LAS int* tb; bool gather;
    __device__ __forceinline__ bool next(int i, Unit& u) const {
        const int ntile = tb[8]; const int nwg = ntile * nN; const long L = (long)i * G + c; if (L >= nwg) return false;
        int wgid = (int)L; { const int q = nwg / NXCD, r = nwg % NXCD, xcd = wgid % NXCD, off = wgid / NXCD; wgid = (xcd < r ? xcd * (q + 1) : r * (q + 1) + (xcd - r) * q) + off; }
        int e = 0;
#pragma unroll
        for (int j = 1; j < 8; ++j) if (wgid >= tb[j] * nN) e = j;
        const int tbase = tb[e], nM = tb[e + 1] - tbase, local = wgid - tbase * nN;
        const int nig = WGM * nN, gid = local / nig, fm = gid * WGM, gsz = (nM - fm) < WGM ? (nM - fm) : WGM;
        u.mt = fm + ((local % nig) % gsz); u.pn = (local % nig) / gsz; u.e = e; u.pm = tbase + u.mt; return true;
    }
    __device__ __forceinline__ const char* a_tile(const Unit& u) const { return gather ? (const char*)A : (const char*)A + (size_t)u.pm * BM * lda * 2; }
    __device__ __forceinline__ const char* b_tile(const Unit& u) const { return (const char*)Bt + ((size_t)u.e * bstride + (size_t)u.pn * BM * K) * 2; }
    __device__ __forceinline__ int row_tok(const Unit& u, int r) const { const int idx = u.mt * BM + r; const int cnt = tb[16 + u.e]; return idx < cnt ? list[(size_t)u.e * T + idx].x : 0; }
};

struct EpiBf16 {
    static constexpr bool PERM = true;
    bf16* O; int ldc; int split_cols; size_t split_stride; float scale0;
    unsigned* nmax;
    __device__ __forceinline__ void operator()(const f32x4 (&acc)[2][2][4][2], const Unit& u, int wr, int wc, int fr, int fq) const {
        const int row0 = u.pm * BM + wr * 64 + fr; int colt = u.pn * BM; bf16* base = O;
        float sc = 1.f; int t = 0; if (split_cols) { t = colt / split_cols; base += (size_t)t * split_stride; colt -= t * split_cols; if (t == 0) sc = scale0; }
        const int col0 = colt + wc * 32 + 8 * fq;
        const bool track = (nmax != nullptr) && (t == 0);
        float mx[2] = {0.f, 0.f};
#pragma unroll
        for (int ai = 0; ai < 2; ++ai)
#pragma unroll
            for (int m = 0; m < 4; ++m) { bf16* rowp = base + (size_t)(row0 + ai * HALF + m * 16) * ldc + col0;
#pragma unroll
                for (int bj = 0; bj < 2; ++bj) { const f32x4 v0 = acc[ai][bj][m][0] * sc, v1 = acc[ai][bj][m][1] * sc;
                    v4u w; w.x = cvt_pk_bf16(v0[0], v0[1]); w.y = cvt_pk_bf16(v0[2], v0[3]); w.z = cvt_pk_bf16(v1[0], v1[1]); w.w = cvt_pk_bf16(v1[2], v1[3]);
                    *(v4u*)(rowp + bj * HALF) = w;
                    if (track) { float s = 0.f;
#pragma unroll
                        for (int q = 0; q < 4; ++q) { const float a = bf_lo(w[q]), b = bf_hi(w[q]); s += a * a + b * b; }
                        s += __shfl_xor(s, 16); s += __shfl_xor(s, 32); mx[bj] = fmaxf(mx[bj], s); } } }
        if (track) {
#pragma unroll
            for (int bj = 0; bj < 2; ++bj) { float v = mx[bj];
#pragma unroll
                for (int o = 1; o < 16; o <<= 1) v = fmaxf(v, __shfl_xor(v, o));
                if (fr == 0 && fq == 0) { const int head = colt / 64 + 2 * bj + (wc >> 1), bb = (u.pm * BM) / SEQ;
                    __hip_atomic_fetch_max(nmax + ((bb * 16 + head) * 2 + (wc & 1)), __float_as_uint(v), __ATOMIC_RELAXED, __HIP_MEMORY_SCOPE_AGENT); } }
        }
    }
};
struct EpiRetIn {
    static constexpr bool PERM = true;
    bf16* O; const f32x2* rope;
    __device__ __forceinline__ void operator()(const f32x4 (&acc)[2][2][4][2], const Unit& u, int wr, int wc, int fr, int fq) const {
        const int row0 = u.pm * BM + wr * 64 + fr; const int col0 = u.pn * BM + wc * 32 + 8 * fq;
        const bool rot = u.pn < 8; const float ksc = (u.pn >= 4 && u.pn < 8) ? 0.0625f : 1.0f;
#pragma unroll
        for (int ai = 0; ai < 2; ++ai)
#pragma unroll
            for (int m = 0; m < 4; ++m) { const int row = row0 + ai * HALF + m * 16; bf16* rowp = O + (size_t)row * PROJW + col0;
                f32x4 a0 = acc[ai][0][m][0], a1 = acc[ai][0][m][1], b0 = acc[ai][1][m][0], b1 = acc[ai][1][m][1];
                if (rot) { const f32x4* rp = (const f32x4*)(rope + (size_t)(row & (SEQ - 1)) * 128 + wc * 32 + 8 * fq);
                    const f32x4 r0 = rp[0], r1 = rp[1], r2 = rp[2], r3 = rp[3];
                    f32x4 x, y;
                    x = a0; y = b0; a0 = (f32x4){x[0] * r0[0] - y[0] * r0[1], x[1] * r0[2] - y[1] * r0[3], x[2] * r1[0] - y[2] * r1[1], x[3] * r1[2] - y[3] * r1[3]};
                                    b0 = (f32x4){y[0] * r0[0] + x[0] * r0[1], y[1] * r0[2] + x[1] * r0[3], y[2] * r1[0] + x[2] * r1[1], y[3] * r1[2] + x[3] * r1[3]};
                    x = a1; y = b1; a1 = (f32x4){x[0] * r2[0] - y[0] * r2[1], x[1] * r2[2] - y[1] * r2[3], x[2] * r3[0] - y[2] * r3[1], x[3] * r3[2] - y[3] * r3[3]};
                                    b1 = (f32x4){y[0] * r2[0] + x[0] * r2[1], y[1] * r2[2] + x[1] * r2[3], y[2] * r3[0] + x[2] * r3[1], y[3] * r3[2] + x[3] * r3[3]};
                    a0 = a0 * ksc; a1 = a1 * ksc; b0 = b0 * ksc; b1 = b1 * ksc; }
                v4u w; w.x = cvt_pk_bf16(a0[0], a0[1]); w.y = cvt_pk_bf16(a0[2], a0[3]); w.z = cvt_pk_bf16(a1[0], a1[1]); w.w = cvt_pk_bf16(a1[2], a1[3]);
                *(v4u*)(rowp) = w;
                w.x = cvt_pk_bf16(b0[0], b0[1]); w.y = cvt_pk_bf16(b0[2], b0[3]); w.z = cvt_pk_bf16(b1[0], b1[1]); w.w = cvt_pk_bf16(b1[2], b1[3]);
                *(v4u*)(rowp + HALF) = w; }
    }
};
struct EpiResid {
    static constexpr bool PERM = false;
    const float* base; float* out; const float* gates; int gstride;
    __device__ __forceinline__ void operator()(const f32x4 (&acc)[2][2][4][2], const Unit& u, int wr, int wc, int fr, int fq) const {
        const int row0 = u.pm * BM + wr * 64 + fr, col0 = u.pn * BM + wc * 32 + 4 * fq;
        const float* gp = gates + (size_t)((u.pm * BM) / SEQ) * gstride + col0;
        f32x4 gv[2][2];
#pragma unroll
        for (int bj = 0; bj < 2; ++bj)
#pragma unroll
            for (int n = 0; n < 2; ++n) gv[bj][n] = *(const f32x4*)(gp + bj * HALF + n * 16);
#pragma unroll
        for (int ai = 0; ai < 2; ++ai)
#pragma unroll
            for (int m = 0; m < 4; ++m) { const size_t off = (size_t)(row0 + ai * HALF + m * 16) * D + col0;
#pragma unroll
                for (int bj = 0; bj < 2; ++bj)
#pragma unroll
                    for (int n = 0; n < 2; ++n) { const f32x4 bs = *(const f32x4*)(base + off + bj * HALF + n * 16); *(f32x4*)(out + off + bj * HALF + n * 16) = bs + gv[bj][n] * acc[ai][bj][m][n]; } }
    }
};
struct EpiSwiglu {
    static constexpr bool PERM = true;
    bf16* O; int ldc;
    __device__ __forceinline__ void operator()(const f32x4 (&acc)[2][2][4][2], const Unit& u, int wr, int wc, int fr, int fq) const {
        const int row0 = u.pm * BM + wr * 64 + fr, col0 = u.pn * HALF + wc * 32 + 8 * fq;
#pragma unroll
        for (int ai = 0; ai < 2; ++ai)
#pragma unroll
            for (int m = 0; m < 4; ++m) { bf16* rowp = O + (size_t)(row0 + ai * HALF + m * 16) * ldc + col0;
                float h[8];
#pragma unroll
                for (int n = 0; n < 2; ++n)
#pragma unroll
                    for (int i = 0; i < 4; ++i) h[n * 4 + i] = fast_silu(acc[ai][0][m][n][i]) * acc[ai][1][m][n][i];
                v4u w; w.x = cvt_pk_bf16(h[0], h[1]); w.y = cvt_pk_bf16(h[2], h[3]); w.z = cvt_pk_bf16(h[4], h[5]); w.w = cvt_pk_bf16(h[6], h[7]);
                *(v4u*)(rowp) = w; }
    }
};
struct EpiMoeDown {
    static constexpr bool PERM = false;
    float* H; const float* gates; int gstride; const int2* list; const LAS int* tb;
    __device__ __forceinline__ void operator()(const f32x4 (&acc)[2][2][4][2], const Unit& u, int wr, int wc, int fr, int fq) const {
        const int col0 = u.pn * BM + wc * 32 + 4 * fq; const int cnt = tb[16 + u.e];
#pragma unroll
        for (int ai = 0; ai < 2; ++ai)
#pragma unroll
            for (int m = 0; m < 4; ++m) { const int idx = u.mt * BM + ai * HALF + wr * 64 + m * 16 + fr;
                if (idx < cnt) { const int2 tw = list[(size_t)u.e * T + idx]; const float w = __int_as_float(tw.y);
                    const float* gp = gates + (size_t)(tw.x / SEQ) * gstride + col0; float* hp = H + (size_t)tw.x * D + col0;
#pragma unroll
                    for (int bj = 0; bj < 2; ++bj)
#pragma unroll
                        for (int n = 0; n < 2; ++n) { const f32x4 g = *(const f32x4*)(gp + bj * HALF + n * 16); f32x4* p = (f32x4*)(hp + bj * HALF + n * 16); *p = *p + (g * w) * acc[ai][bj][m][n]; } } }
    }
};

template <class Epi, class Sched, bool GATHER>
__device__ __forceinline__ void gemm_phase(LAS unsigned char* lds, const Sched& S, const Epi& E, const int tid) {
    const int wid = __builtin_amdgcn_readfirstlane(tid >> 6), lane = tid & 63, wr = wid >> 2, wc = wid & 3, fr = lane & 15, fq = lane >> 4;
    const int K = S.K, lda = S.lda, nt = K / BK;
    int RA[2], CA[2]; unsigned voffB[2];
#pragma unroll
    for (int i = 0; i < 2; ++i) { int R, C; stage_rc(tid * 16 + i * 8192, R, C); const int Rb = Epi::PERM ? ((R & ~31) + perm32(R & 31)) : R;
        RA[i] = R; CA[i] = C; voffB[i] = (unsigned)(Rb * K + C) * 2u; }
    const size_t kstep = (size_t)(BK * 2);
    const size_t hstepB = (size_t)HALF * K * 2;
    const unsigned ldsw = (unsigned)wid * 1024u;
    const int aoff = lds_byte(wr * 64 + fr, fq * 8), boff = lds_byte(wc * 32 + fr, fq * 8);
#define PG8_SA(b, h) (((b) * 2 + (h)) * HTB)
#define PG8_SB(b, h) ((4 + (b) * 2 + (h)) * HTB)
#define PG8_STAGE2(bufoff, gbase, v0, v1) do { \
        __builtin_amdgcn_global_load_lds((const unsigned*)((const char*)(gbase) + (v0)), (LAS unsigned*)(lds + (bufoff) + ldsw), 16, 0, 0); \
        __builtin_amdgcn_global_load_lds((const unsigned*)((const char*)(gbase) + (v1)), (LAS unsigned*)(lds + (bufoff) + ldsw + 8192), 16, 0, 0); } while (0)
#define PG8_STA(b, h, ptr, V) PG8_STAGE2(PG8_SA(b, h), ptr, V[h][0], V[h][1])
#define PG8_STB(b, h, ptr) PG8_STAGE2(PG8_SB(b, h), (ptr) + (h) * hstepB, voffB[0], voffB[1])
#define PG8_LDA(dst, b, h) do { _Pragma("unroll") for (int m = 0; m < 4; ++m) _Pragma("unroll") for (int k = 0; k < 2; ++k) dst[m][k] = *(const LAS bf16x8*)(lds + PG8_SA(b, h) + aoff + m * 2048 + k * 1024); } while (0)
#define PG8_LDB(dst, b, h) do { _Pragma("unroll") for (int n = 0; n < 2; ++n) _Pragma("unroll") for (int k = 0; k < 2; ++k) dst[n][k] = *(const LAS bf16x8*)(lds + PG8_SB(b, h) + boff + n * 2048 + k * 1024); } while (0)
#define PG8_MMA(ai, bj, At, Bt) do { __builtin_amdgcn_s_setprio(1); _Pragma("unroll") for (int m = 0; m < 4; ++m) _Pragma("unroll") for (int n = 0; n < 2; ++n) _Pragma("unroll") for (int k = 0; k < 2; ++k) \
        acc[ai][bj][m][n] = __builtin_amdgcn_mfma_f32_16x16x32_bf16(Bt[n][k], At[m][k], acc[ai][bj][m][n], 0, 0, 0); __builtin_amdgcn_s_setprio(0); } while (0)
#define PG8_WAIT_V(n) asm volatile("s_waitcnt vmcnt(" #n ")" ::: "memory")
#define PG8_WAIT_L(n) asm volatile("s_waitcnt lgkmcnt(" #n ")" ::: "memory")
#define PG8_BAR __builtin_amdgcn_s_barrier()
#define PG8_SCHED __builtin_amdgcn_sched_barrier(0)
    Unit cur, nxt; int ui = 0;
    if (!S.next(0, cur)) return;
    unsigned cv[2][2], nv[2][2];
#pragma unroll
    for (int h = 0; h < 2; ++h)
#pragma unroll
        for (int i = 0; i < 2; ++i) { const int rr = RA[i] + HALF * h; cv[h][i] = (unsigned)((GATHER ? S.row_tok(cur, rr) : rr) * lda + CA[i]) * 2u; nv[h][i] = cv[h][i]; }
    if (GATHER) { asm volatile("s_waitcnt vmcnt(0)" : "+v"(cv[0][0]), "+v"(cv[0][1]), "+v"(cv[1][0]), "+v"(cv[1][1]) :: "memory"); }
    f32x4 acc[2][2][4][2];
#pragma unroll
    for (int a = 0; a < 2; ++a)
#pragma unroll
        for (int b = 0; b < 2; ++b)
#pragma unroll
            for (int m = 0; m < 4; ++m)
#pragma unroll
                for (int n = 0; n < 2; ++n) acc[a][b][m][n] = (f32x4){0.f, 0.f, 0.f, 0.f};
    bf16x8 At[4][2], B0[2][2], B1[2][2];
    const char* cA = S.a_tile(cur); const char* cB = S.b_tile(cur);
    PG8_STB(0, 0, cB); PG8_STB(0, 1, cB); PG8_STA(0, 0, cA, cv); PG8_STA(0, 1, cA, cv);
    if (wr == 1) PG8_BAR;
    PG8_WAIT_V(2); PG8_BAR;
    PG8_STB(1, 0, cB + kstep); PG8_STA(1, 0, cA + kstep, cv); PG8_STB(1, 1, cB + kstep);
    PG8_WAIT_V(6); PG8_BAR;
    for (;;) {
        const bool has_next = S.next(ui + 1, nxt);
        const char* nA = has_next ? S.a_tile(nxt) : cA; const char* nB = has_next ? S.b_tile(nxt) : cB;
        if (GATHER) {
            if (has_next) {
#pragma unroll
                for (int h = 0; h < 2; ++h)
#pragma unroll
                    for (int i = 0; i < 2; ++i) nv[h][i] = (unsigned)(S.row_tok(nxt, RA[i] + HALF * h) * lda + CA[i]) * 2u;
            }
            asm volatile("s_waitcnt vmcnt(0)" : "+v"(nv[0][0]), "+v"(nv[0][1]), "+v"(nv[1][0]), "+v"(nv[1][1]) :: "memory");
        }
        for (int t = 0; t < nt; t += 2) {
            const bool last = (t == nt - 2);
            const char* a1 = cA + (size_t)(t + 1) * kstep;
            const char* a2 = last ? nA : cA + (size_t)(t + 2) * kstep; const char* b2 = last ? nB : cB + (size_t)(t + 2) * kstep;
            const char* a3 = a2 + kstep; const char* b3 = b2 + kstep;
            unsigned v2[2][2];
#pragma unroll
            for (int h = 0; h < 2; ++h)
#pragma unroll
                for (int i = 0; i < 2; ++i) v2[h][i] = GATHER ? (last ? nv[h][i] : cv[h][i]) : cv[h][i];
            PG8_LDB(B0, 0, 0); PG8_LDB(B1, 0, 1); PG8_SCHED; PG8_LDA(At, 0, 0); PG8_STA(1, 1, a1, cv);
            PG8_WAIT_V(8); PG8_WAIT_L(0); PG8_BAR; PG8_MMA(0, 0, At, B0); PG8_MMA(0, 1, At, B1); PG8_BAR; PG8_SCHED;
            PG8_LDA(At, 0, 1); PG8_STB(0, 0, b2); PG8_STB(0, 1, b2); PG8_STA(0, 0, a2, v2);
            PG8_WAIT_V(8); PG8_WAIT_L(0); PG8_BAR; PG8_MMA(1, 0, At, B0); PG8_MMA(1, 1, At, B1); PG8_BAR; PG8_SCHED;
            PG8_LDB(B0, 1, 0); PG8_LDB(B1, 1, 1); PG8_SCHED; PG8_LDA(At, 1, 0); PG8_STA(0, 1, a2, v2);
            PG8_WAIT_V(8); PG8_WAIT_L(0); PG8_BAR; PG8_MMA(0, 0, At, B0); PG8_MMA(0, 1, At, B1); PG8_BAR; PG8_SCHED;
            PG8_LDA(At, 1, 1); PG8_STB(1, 0, b3); PG8_STB(1, 1, b3); PG8_STA(1, 0, a3, v2);
            PG8_WAIT_V(8); PG8_WAIT_L(0); PG8_BAR; PG8_MMA(1, 0, At, B0); PG8_MMA(1, 1, At, B1); PG8_BAR; PG8_SCHED;
        }
        if (wr == 0) PG8_BAR;
        E(acc, cur, wr, wc, fr, fq);
        if (!has_next) break;
#pragma unroll
        for (int a = 0; a < 2; ++a)
#pragma unroll
            for (int b = 0; b < 2; ++b)
#pragma unroll
                for (int m = 0; m < 4; ++m)
#pragma unroll
                    for (int n = 0; n < 2; ++n) acc[a][b][m][n] = (f32x4){0.f, 0.f, 0.f, 0.f};
        cur = nxt; cA = nA; cB = nB; ++ui;
#pragma unroll
        for (int h = 0; h < 2; ++h)
#pragma unroll
            for (int i = 0; i < 2; ++i) cv[h][i] = nv[h][i];
        if (wr == 1) PG8_BAR;
    }
    PG8_WAIT_V(0);
    PG8_BAR;
#undef PG8_SA
#undef PG8_SB
#undef PG8_STAGE2
#undef PG8_STA
#undef PG8_STB
#undef PG8_LDA
#undef PG8_LDB
#undef PG8_MMA
#undef PG8_WAIT_V
#undef PG8_WAIT_L
#undef PG8_BAR
#undef PG8_SCHED
}
}

namespace attn_body {
using hbf16 = __hip_bfloat16;
using f32x16 = __attribute__((ext_vector_type(16))) float;
using u32x4 = __attribute__((ext_vector_type(4))) unsigned;
constexpr int NHEAD = FH, DH = 64, DM = NHEAD * DH;
constexpr int NW = 8, QBLK = 32, QB = QBLK * NW, KVBLK = 64, NQB = SEQ / QB;
__device__ __forceinline__ int crow(int r, int hi) { return (r & 3) + 8 * (r >> 2) + 4 * hi; }
#define SBAR() __builtin_amdgcn_sched_barrier(0)
__device__ __forceinline__ void cmask(f32x16& p0, f32x16& p1, int jb, int qrel, int hi) {
  const float NEG = -INFINITY; int kb = 64 * jb + 4 * hi;
  #pragma unroll
  for (int r = 0; r < 16; ++r) { int kv = kb + (r & 3) + 8 * (r >> 2); if (kv > qrel) p0[r] = NEG; if (kv + 32 > qrel) p1[r] = NEG; }
}
constexpr int NSLOT = 3, SLOTB = 8192;
constexpr int LDS_K = 0, LDS_V = NSLOT * SLOTB, LDS_WS = 2 * NSLOT * SLOTB, LDS_OST = LDS_WS + NW * 64 * 4, LDS_BIAS = LDS_OST + NW * 4096, LDS_BYTES = LDS_BIAS + SEQ * 4;
__device__ __forceinline__ void glds16(const void* gsrc, unsigned lds_dst) { unsigned keep;
  asm volatile("s_mov_b32 %0, m0\n\ts_mov_b32 m0, %2\n\ts_nop 0\n\tglobal_load_lds_dwordx4 %1, off\n\ts_mov_b32 m0, %0" : "=&s"(keep) : "v"(gsrc), "s"(lds_dst) : "memory"); }
__device__ __forceinline__ float max3f(float a, float b, float c) { float r; asm("v_max3_f32 %0, %1, %2, %3" : "=v"(r) : "v"(a), "v"(b), "v"(c)); return r; }
__device__ __forceinline__ float max2f(float a, float b) { float r; asm("v_max_f32_e32 %0, %1, %2" : "=v"(r) : "v"(a), "v"(b)); return r; }
__device__ __forceinline__ float fadd_s(float a, float b) { float r; asm("v_add_f32_e32 %0, %1, %2" : "=v"(r) : "v"(a), "v"(b)); return r; }
__device__ __forceinline__ float fsub_s(float a, float b) { float r; asm("v_sub_f32_e32 %0, %1, %2" : "=v"(r) : "v"(a), "v"(b)); return r; }
typedef float f32x2_t __attribute__((ext_vector_type(2))); typedef __bf16 bf16x2_t __attribute__((ext_vector_type(2)));
__device__ __forceinline__ unsigned cvtpk_s(float lo, float hi) { f32x2_t v = {lo, hi}; bf16x2_t b = __builtin_convertvector(v, bf16x2_t); return __builtin_bit_cast(unsigned, b); }
#define WAIT_BAR(N) asm volatile("s_waitcnt vmcnt(" #N ") lgkmcnt(0)\n\ts_barrier" ::: "memory")

__device__ __forceinline__ void qkt(f32x16& p0, f32x16& p1, const char* Kslot, const bf16x8* qr, int r32, int hi) { const f32x16 zero16 = f32x16{};
  const char* kb = Kslot + hi * 1024 + r32 * 16;
  #pragma unroll
  for (int d0 = 0; d0 < 4; ++d0) {
    const bf16x8 b0 = *reinterpret_cast<const bf16x8*>(kb + d0 * 2048);
    const bf16x8 b1 = *reinterpret_cast<const bf16x8*>(kb + d0 * 2048 + 512);
    if (d0 == 0) { p0 = __builtin_amdgcn_mfma_f32_32x32x16_bf16(b0, qr[0], zero16, 0, 0, 0); p1 = __builtin_amdgcn_mfma_f32_32x32x16_bf16(b1, qr[0], zero16, 0, 0, 0); }
    else { p0 = __builtin_amdgcn_mfma_f32_32x32x16_bf16(b0, qr[d0], p0, 0, 0, 0); p1 = __builtin_amdgcn_mfma_f32_32x32x16_bf16(b1, qr[d0], p1, 0, 0, 0); } }
}
typedef __attribute__((address_space(3))) const char* lds_cptr;
typedef short v4i16_t __attribute__((ext_vector_type(4)));
__device__ __forceinline__ void kload8(bf16x8* kf, lds_cptr kp) {
  kf[0] = *(const LAS bf16x8*)(kp);        kf[1] = *(const LAS bf16x8*)(kp + 512);
  kf[2] = *(const LAS bf16x8*)(kp + 2048); kf[3] = *(const LAS bf16x8*)(kp + 2560);
  kf[4] = *(const LAS bf16x8*)(kp + 4096); kf[5] = *(const LAS bf16x8*)(kp + 4608);
  kf[6] = *(const LAS bf16x8*)(kp + 6144); kf[7] = *(const LAS bf16x8*)(kp + 6656);
}
__device__ __forceinline__ void kload2(bf16x8* kf, lds_cptr kp, int j) { kf[2 * j] = *(const LAS bf16x8*)(kp + j * 2048); kf[2 * j + 1] = *(const LAS bf16x8*)(kp + j * 2048 + 512); }
__device__ __forceinline__ s16x4 vtr(lds_cptr p) { return __builtin_bit_cast(s16x4, __builtin_amdgcn_ds_read_tr16_b64_v4i16((LAS v4i16_t*)p)); }
__device__ __forceinline__ float rowmax(const f32x16& p0, const f32x16& p1) {
  float a = max3f(p0[0], p0[1], p1[0]), b = max3f(p0[2], p0[3], p1[1]); a = max3f(a, p1[2], p1[3]);
  #pragma unroll
  for (int r = 4; r < 16; r += 4) { a = max3f(a, p0[r], p0[r + 1]); b = max3f(b, p0[r + 2], p0[r + 3]); a = max3f(a, p1[r], p1[r + 1]); b = max3f(b, p1[r + 2], p1[r + 3]); }
  const float m = max2f(a, b);
  auto rr = __builtin_amdgcn_permlane32_swap(__float_as_uint(m), __float_as_uint(m), false, false);
  return max2f(__uint_as_float(rr[0]), __uint_as_float(rr[1]));
}
__device__ __forceinline__ void pv(f32x16* o, int vb, bf16x8 pa0, bf16x8 pa1, bf16x8 pa2, bf16x8 pa3) {
  #pragma unroll
  for (int d0 = 0; d0 < 2; ++d0) { s16x4 lo[4], hi[4];
    #pragma unroll
    for (int ks = 0; ks < 4; ++ks) {
      asm volatile("ds_read_b64_tr_b16 %0,%1 offset:%c2" : "=&v"(lo[ks]) : "v"(vb), "i"(d0 * 4096 + ks * 1024) : "memory");
      asm volatile("ds_read_b64_tr_b16 %0,%1 offset:%c2" : "=&v"(hi[ks]) : "v"(vb), "i"(d0 * 4096 + ks * 1024 + 512) : "memory"); }
    asm volatile("s_waitcnt lgkmcnt(0)" ::: "memory"); SBAR();
    #define PK(k) (bf16x8){lo[k][0], lo[k][1], lo[k][2], lo[k][3], hi[k][0], hi[k][1], hi[k][2], hi[k][3]}
    o[d0] = __builtin_amdgcn_mfma_f32_32x32x16_bf16(pa0, PK(0), o[d0], 0, 0, 0);
    o[d0] = __builtin_amdgcn_mfma_f32_32x32x16_bf16(pa1, PK(1), o[d0], 0, 0, 0);
    o[d0] = __builtin_amdgcn_mfma_f32_32x32x16_bf16(pa2, PK(2), o[d0], 0, 0, 0);
    o[d0] = __builtin_amdgcn_mfma_f32_32x32x16_bf16(pa3, PK(3), o[d0], 0, 0, 0);
    #undef PK
  }
}
#define ADDBIAS(P0, P1, t) do { const LAS f32x4* bp_ = (const LAS f32x4*)((const LAS float*)((LAS char*)shm + LDS_BIAS) + (t) * 64 + 4 * hi); const float nm_ = -mhat; \
    _Pragma("unroll") for (int k_ = 0; k_ < 4; ++k_) { const f32x4 b0_ = bp_[2 * k_] + nm_, b1_ = bp_[8 + 2 * k_] + nm_; \
      P0[4 * k_] += b0_[0]; P0[4 * k_ + 1] += b0_[1]; P0[4 * k_ + 2] += b0_[2]; P0[4 * k_ + 3] += b0_[3]; \
      P1[4 * k_] += b1_[0]; P1[4 * k_ + 1] += b1_[1]; P1[4 * k_ + 2] += b1_[2]; P1[4 * k_ + 3] += b1_[3]; SBAR(); } } while (0)

template <int THRL> __device__ __forceinline__ void attn_unit(int b, int h, int qb, const hbf16* Q, const hbf16* __restrict__ K, const hbf16* __restrict__ V, const hbf16* __restrict__ Gt, const float* __restrict__ FL, const unsigned* __restrict__ nmx, const int jq, hbf16* O, char* shm, const int tid_in) {
  int tid = tid_in; asm volatile("" : "+v"(tid));
  const int lane = tid & 63, r32 = lane & 31, hi = lane >> 5; const int wid = __builtin_amdgcn_readfirstlane(tid >> 6);
  const long rowbase = (long)b * SEQ; const int q0 = qb * QB;
  const hbf16* Qw = Q + (rowbase + q0 + wid * QBLK) * DM + h * DH;
  const unsigned lds0 = (unsigned)(uintptr_t)shm;
  float* wsf = (float*)(shm + LDS_WS) + wid * 64;
  const float* fl = FL + (size_t)(b * NHEAD + h) * SEQ; const float fref = fl[q0];
  const int NT0 = (q0 + QB) / KVBLK;
  int ts;
  { const unsigned* nk = nmx + (b * 16 + h) * 2; const unsigned* nq = nmx + 64 * (1 + jq) + (b * 16 + h) * 2;
    const float kb = sqrtf(__uint_as_float(nk[0]) + __uint_as_float(nk[1])), qbn = sqrtf(__uint_as_float(nq[0]) + __uint_as_float(nq[1]));
    const float thr = fref + 2.0f * (kb * qbn * 1.001f) + 151.0f;
    int jstar = NT0 - 4;
    for (int k = 0; k < NT0; k += 64) { const int jj = k + lane; const float v = (jj < NT0) ? fl[64 * jj + 63] : -INFINITY;
      const unsigned long long bal = __ballot(v <= thr); if (bal) { jstar = k + (int)__builtin_ctzll(bal); break; } }
    ts = jstar & ~1; if (ts > NT0 - 4) ts = NT0 - 4; ts = __builtin_amdgcn_readfirstlane(ts); }
  const hbf16* Kh = K + (rowbase + (long)ts * KVBLK) * DM + h * DH, *Vh = V + (rowbase + (long)ts * KVBLK) * DM + h * DH;
  { LAS float* bw = (LAS float*)((LAS char*)shm + LDS_BIAS);
    for (int i = ts * KVBLK + tid; i < q0 + QB; i += NW * 64) bw[i - ts * KVBLK] = fref - fl[i]; }
  const hbf16* ksrc = Kh + (long)lane * DM + wid * 8;
  const hbf16* vsrc = Vh + (long)(16 * (wid & 3) + (lane >> 2)) * DM + (wid >> 2) * 32 + (lane & 3) * 8;
  const unsigned kdst = lds0 + LDS_K + wid * 1024, vdst = lds0 + LDS_V + wid * 1024;
  #define DMA_K(t, slot) glds16(ksrc + (long)(t) * KVBLK * DM, (unsigned)__builtin_amdgcn_readfirstlane(kdst + (slot)))
  #define DMA_V(t, slot) glds16(vsrc + (long)(t) * KVBLK * DM, (unsigned)__builtin_amdgcn_readfirstlane(vdst + (slot)))
  const char* Kbase = shm + LDS_K; bf16x8 kf[8];
  const lds_cptr shm3 = (lds_cptr)shm; const lds_cptr kp0 = shm3 + LDS_K + hi * 1024 + r32 * 16; const lds_cptr vp0 = shm3 + LDS_V + ((lane >> 4) & 1) * 32 + (lane & 3) * 8 + (4 * hi + ((lane & 15) >> 2)) * 64;
  const int NT = NT0 - ts;
  DMA_K(0, 0); DMA_V(0, 0); DMA_K(1, SLOTB);
  bf16x8 qr[4];
  #pragma unroll
  for (int d0 = 0; d0 < 4; ++d0) qr[d0] = *reinterpret_cast<const bf16x8*>(&Qw[(long)r32 * DM + d0 * 16 + hi * 8]);
  float mhat = 0.f, l_reg = 0.f; f32x16 o[2]; o[0] = f32x16{}; o[1] = f32x16{}; const f32x16 zero16 = f32x16{};
  const int qrel = wid * QBLK + r32;
  #define CMASK(P0, P1, t) do { int jb_ = (t) - (NT - 4); if (jb_ >= 0) cmask(P0, P1, jb_, qrel, hi); } while (0)
  bool resc = false;
  #define START(P0, P1) do { const float rm = rowmax(P0, P1); resc = false; \
    { const float dl = rm; mhat = fadd_s(mhat, dl); \
      _Pragma("unroll") for (int r = 0; r < 16; ++r) { P0[r] = fsub_s(P0[r], dl); P1[r] = fsub_s(P1[r], dl); } \
      } \
    _Pragma("unroll") for (int r = 0; r < 16; ++r) P0[r] = __builtin_amdgcn_exp2f(P0[r]); } while (0)
  #define RESC() do { if (resc) { asm volatile("s_waitcnt lgkmcnt(0)" ::: "memory"); \
      _Pragma("unroll") for (int d_ = 0; d_ < 2; ++d_) _Pragma("unroll") for (int r = 0; r < 16; ++r) o[d_][r] *= wsf[crow(r, hi)]; } } while (0)
  f32x16 pA0, pA1, pB0, pB1;
  int sl_prev = 0, sl_cur = 0, sl_next = SLOTB;
  #define ROT() do { sl_prev = sl_cur; sl_cur = sl_next; sl_next = (sl_next == (NSLOT - 1) * SLOTB) ? 0 : sl_next + SLOTB; } while (0)
  DMA_K(2, 2 * SLOTB);
  WAIT_BAR(3);
  qkt(pA0, pA1, Kbase, qr, r32, hi); asm volatile("s_nop 15\n\ts_nop 7" : "+v"(pA0), "+v"(pA1)); ADDBIAS(pA0, pA1, 0); CMASK(pA0, pA1, 0);
  START(pA0, pA1);
  _Pragma("unroll") for (int r = 0; r < 16; ++r) pA1[r] = __builtin_amdgcn_exp2f(pA1[r]);
  WAIT_BAR(0);
  DMA_K(3, 0); DMA_V(1, SLOTB);
  ROT();
  kload8(kf, kp0 + sl_cur);
  WAIT_BAR(2);
  s16x4 vlo[8], vhi[8]; u32x4 pw0, pw1, pw2, pw3;
  #define PKW(P, B) cvtpk_s(P[B], P[B + 1])
  #define PAF(k) __builtin_bit_cast(bf16x8, pw##k)
  #define VFR(i) (bf16x8){vlo[i][0], vlo[i][1], vlo[i][2], vlo[i][3], vhi[i][0], vhi[i][1], vhi[i][2], vhi[i][3]}
  #define PIN(x) asm volatile("" : "+v"(x))
  #define MX3(a, b, c) __builtin_fmaxf(__builtin_fmaxf((a), (b)), (c))
  #define GAPA(MF, A0, A1, A2, A3, W0, W1, PW) do { MF; sacc += A0; sacc += A1; sacc += A2; sacc += A3; PIN(sacc); W0; W1; PIN(PW); SBAR(); } while (0)
  #define EX(v) __builtin_amdgcn_exp2f(v)
  #define GAPB(MF, X, B) do { MF; X[B] = EX(X[B]); X[B + 1] = EX(X[B + 1]); X[B + 2] = EX(X[B + 2]); X[B + 3] = EX(X[B + 3]); PIN(X); SBAR(); } while (0)
  #define VRD(i) do { vlo[i] = vtr(vp_ + (((i) >> 2) * 4096 + ((i) & 3) * 1024)); vhi[i] = vtr(vp_ + (((i) >> 2) * 4096 + ((i) & 3) * 1024 + 512)); } while (0)
  #define KRD(G, j) do { if (G) { kload2(kf, kp0 + sl_next, j); SBAR(); } } while (0)
  #define STEP(C0, C1, P0, P1, t, GK, GV, GL) do { SBAR(); \
    const lds_cptr vp_ = vp0 + sl_prev; \
    VRD(0); SBAR(); float sacc = (P0[0] + P0[1]); \
    GAPA(C0 = __builtin_amdgcn_mfma_f32_32x32x16_bf16(kf[0], qr[0], zero16, 0, 0, 0), P0[2], P0[3], P0[4], P0[5],     pw0[0] = PKW(P0, 0), pw0[1] = PKW(P0, 2), pw0); \
    VRD(4); SBAR(); GAPA(C1 = __builtin_amdgcn_mfma_f32_32x32x16_bf16(kf[1], qr[0], zero16, 0, 0, 0), P0[6], P0[7], P0[8], P0[9],     pw0[2] = PKW(P0, 4), pw0[3] = PKW(P0, 6), pw0); \
    VRD(1); SBAR(); GAPA(C0 = __builtin_amdgcn_mfma_f32_32x32x16_bf16(kf[2], qr[1], C0, 0, 0, 0),   P0[10], P0[11], P0[12], P0[13], pw1[0] = PKW(P0, 8), pw1[1] = PKW(P0, 10), pw1); \
    VRD(5); SBAR(); GAPA(C1 = __builtin_amdgcn_mfma_f32_32x32x16_bf16(kf[3], qr[1], C1, 0, 0, 0),   P0[14], P0[15], P1[0], P1[1],   pw1[2] = PKW(P0, 12), pw1[3] = PKW(P0, 14), pw1); \
    VRD(2); SBAR(); GAPA(C0 = __builtin_amdgcn_mfma_f32_32x32x16_bf16(kf[4], qr[2], C0, 0, 0, 0),   P1[2], P1[3], P1[4], P1[5],     pw2[0] = PKW(P1, 0), pw2[1] = PKW(P1, 2), pw2); \
    VRD(6); SBAR(); GAPA(C1 = __builtin_amdgcn_mfma_f32_32x32x16_bf16(kf[5], qr[2], C1, 0, 0, 0),   P1[6], P1[7], P1[8], P1[9],     pw2[2] = PKW(P1, 4), pw2[3] = PKW(P1, 6), pw2); \
    VRD(3); SBAR(); GAPA(C0 = __builtin_amdgcn_mfma_f32_32x32x16_bf16(kf[6], qr[3], C0, 0, 0, 0),   P1[10], P1[11], P1[12], P1[13], pw3[0] = PKW(P1, 8), pw3[1] = PKW(P1, 10), pw3); \
    VRD(7); SBAR(); GAPA(C1 = __builtin_amdgcn_mfma_f32_32x32x16_bf16(kf[7], qr[3], C1, 0, 0, 0),   P1[14], P1[15], 0.f, 0.f,       pw3[2] = PKW(P1, 12), pw3[3] = PKW(P1, 14), pw3); \
    l_reg += sacc; \
    if (GK) { DMA_K((t) + 3, sl_cur); } if (GV) { DMA_V((t) + 1, sl_next); } \
    ADDBIAS(C0, C1, t); \
    CMASK(C0, C1, t); \
    { float a = MX3(C0[0], C0[1], C1[0]), b = MX3(C0[2], C0[3], C1[1]); a = MX3(a, C1[2], C1[3]); \
      _Pragma("unroll") for (int r = 4; r < 16; r += 4) { a = MX3(a, C0[r], C0[r + 1]); b = MX3(b, C0[r + 2], C0[r + 3]); a = MX3(a, C1[r], C1[r + 1]); b = MX3(b, C1[r + 2], C1[r + 3]); } \
      float rm = __builtin_fmaxf(a, b); { auto rr = __builtin_amdgcn_permlane32_swap(__float_as_uint(rm), __float_as_uint(rm), false, false); rm = __builtin_fmaxf(__uint_as_float(rr[0]), __uint_as_float(rr[1])); } \
      resc = false; \
      if (__builtin_expect(__any(rm > (float)THRL), 0)) { const float dl = __builtin_fmaxf(rm, 0.f); mhat += dl; \
        _Pragma("unroll") for (int r = 0; r < 16; ++r) { C0[r] -= dl; C1[r] -= dl; } \
        const float f = __builtin_amdgcn_exp2f(-dl); l_reg *= f; if (hi == 0) wsf[r32] = f; resc = true; } } \
    SBAR(); \
    GAPB(o[0] = __builtin_amdgcn_mfma_f32_32x32x16_bf16(PAF(0), VFR(0), o[0], 0, 0, 0), C0, 0); \
    GAPB(o[1] = __builtin_amdgcn_mfma_f32_32x32x16_bf16(PAF(0), VFR(4), o[1], 0, 0, 0), C0, 4); \
    KRD(GL, 0); GAPB(o[0] = __builtin_amdgcn_mfma_f32_32x32x16_bf16(PAF(1), VFR(1), o[0], 0, 0, 0), C0, 8); \
    KRD(GL, 1); GAPB(o[1] = __builtin_amdgcn_mfma_f32_32x32x16_bf16(PAF(1), VFR(5), o[1], 0, 0, 0), C0, 12); \
    KRD(GL, 2); GAPB(o[0] = __builtin_amdgcn_mfma_f32_32x32x16_bf16(PAF(2), VFR(2), o[0], 0, 0, 0), C1, 0); \
    KRD(GL, 3); GAPB(o[1] = __builtin_amdgcn_mfma_f32_32x32x16_bf16(PAF(2), VFR(6), o[1], 0, 0, 0), C1, 4); \
    GAPB(o[0] = __builtin_amdgcn_mfma_f32_32x32x16_bf16(PAF(3), VFR(3), o[0], 0, 0, 0), C1, 8); \
    GAPB(o[1] = __builtin_amdgcn_mfma_f32_32x32x16_bf16(PAF(3), VFR(7), o[1], 0, 0, 0), C1, 12); \
    } while (0)
  int t = 1;
  #undef CMASK
  #define CMASK(P0, P1, t) do {} while (0)
  for (; t + 5 < NT; t += 2) {
    STEP(pB0, pB1, pA0, pA1, t, true, true, true);     WAIT_BAR(2); RESC(); ROT();
    STEP(pA0, pA1, pB0, pB1, t + 1, true, true, true); WAIT_BAR(2); RESC(); ROT();
  }
  #undef CMASK
  #define CMASK(P0, P1, t) do { int jb_ = (t) - (NT - 4); if (jb_ >= 0) cmask(P0, P1, jb_, qrel, hi); } while (0)
  #define ENDW(tt) do { if ((tt) + 3 < NT) { WAIT_BAR(2); } else if ((tt) + 2 < NT) { WAIT_BAR(1); } else { WAIT_BAR(0); } } while (0)
  for (; t + 1 < NT; t += 2) {
    STEP(pB0, pB1, pA0, pA1, t, (t + 3 < NT), (t + 1 < NT), (t + 1 < NT));         ENDW(t);     RESC(); ROT();
    STEP(pA0, pA1, pB0, pB1, t + 1, (t + 4 < NT), (t + 2 < NT), (t + 2 < NT));     ENDW(t + 1); RESC(); ROT();
  }
  STEP(pB0, pB1, pA0, pA1, NT - 1, false, false, false); RESC();
  { float sacc = pB0[0] + pB0[1]; _Pragma("unroll") for (int r = 2; r < 16; ++r) sacc += pB0[r]; _Pragma("unroll") for (int r = 0; r < 16; ++r) sacc += pB1[r]; l_reg += sacc;
    pw0 = (u32x4){PKW(pB0, 0), PKW(pB0, 2), PKW(pB0, 4), PKW(pB0, 6)}; pw1 = (u32x4){PKW(pB0, 8), PKW(pB0, 10), PKW(pB0, 12), PKW(pB0, 14)}; pw2 = (u32x4){PKW(pB1, 0), PKW(pB1, 2), PKW(pB1, 4), PKW(pB1, 6)}; pw3 = (u32x4){PKW(pB1, 8), PKW(pB1, 10), PKW(pB1, 12), PKW(pB1, 14)};
    SBAR(); int lane_d = lane; asm volatile("" : "+v"(lane_d)); const int vb0 = (int)(lds0 + LDS_V) + ((lane_d >> 4) & 1) * 32 + (lane_d & 3) * 8 + (4 * (lane_d >> 5) + ((lane_d & 15) >> 2)) * 64; pv(o, vb0 + sl_cur, PAF(0), PAF(1), PAF(2), PAF(3)); }
  #undef PKW
  #undef PAF
  #undef VFR
  #undef PIN
  #undef MX3
  #undef GAPA
  #undef GAPB
  #undef EX
  #undef VRD
  #undef KRD
  #undef STEP
  #undef ENDW
  { auto rr = __builtin_amdgcn_permlane32_swap(__float_as_uint(l_reg), __float_as_uint(l_reg), false, false); l_reg = __uint_as_float(rr[0]) + __uint_as_float(rr[1]); }
  if (hi == 0) wsf[32 + r32] = l_reg; asm volatile("s_waitcnt lgkmcnt(0)" ::: "memory");
  float rli[16];
  #pragma unroll
  for (int r = 0; r < 16; ++r) rli[r] = __builtin_amdgcn_rcpf(wsf[32 + crow(r, hi)]);
  int lane_e = lane; asm volatile("" : "+v"(lane_e));
  hbf16* Ow = O + (rowbase + q0 + wid * QBLK) * DM + h * DH;
  const hbf16* Gw = Gt + (rowbase + q0 + wid * QBLK) * DM + h * DH;
  { hbf16* stg = (hbf16*)(shm + LDS_OST) + wid * 2048;
    #pragma unroll
    for (int r = 0; r < 16; ++r) { const int orow = crow(r, hi);
      #pragma unroll
      for (int d0 = 0; d0 < 2; ++d0) stg[orow * 64 + d0 * 32 + r32] = __float2bfloat16(o[d0][r] * rli[r]); }
    asm volatile("s_waitcnt lgkmcnt(0)" ::: "memory");
    #pragma unroll
    for (int i = 0; i < 4; ++i) { const int row = i * 8 + (lane_e >> 3), ch = lane_e & 7; const u32x4 v = *(const u32x4*)(stg + row * 64 + ch * 8);
      const u32x4 g = *(const u32x4*)(Gw + (long)row * DM + ch * 8);
      u32x4 w;
      #pragma unroll
      for (int j = 0; j < 4; ++j) w[j] = cvt_pk_bf16(bf_lo(v[j]) * fast_sigmoid(bf_lo(g[j])), bf_hi(v[j]) * fast_sigmoid(bf_hi(g[j])));
      *(u32x4*)(Ow + (long)row * DM + ch * 8) = w; } }
  asm volatile("s_waitcnt lgkmcnt(0)\n\ts_barrier" ::: "memory");
  #undef DMA_K
  #undef DMA_V
  #undef CMASK
  #undef START
  #undef RESC
  #undef ROT
}
#undef SBAR
#undef WAIT_BAR
#undef ADDBIAS
}

constexpr int RING_OFF = 0, RING_BYTES = 131072;
constexpr int LDSCTL_OFF = 149504, MISC_OFF = LDSCTL_OFF + 320;
constexpr int TB_OFF = MISC_OFF + 128;
constexpr int LDS_BYTES = 150528;
static_assert(attn_body::LDS_BYTES <= LDSCTL_OFF && TB_OFF + 128 <= LDS_BYTES, "LDS map");
constexpr int NWAVES = 8;

#define XB_TMO      128
#define XB_XCNT(j)  (256  + 64 * (j))
#define XB_XSUB(j)  (1280 + 64 * (j))
#define XB_XGEN(j)  (2304 + 64 * (j))
#define XB_TOP      3328
#define XB_TOPGEN   3392
#define XCD_BAR_WORDS 3456
#define XB_SPIN_CAP (1u << 18)
__device__ __forceinline__ unsigned xb_ld(unsigned* p)              { return __hip_atomic_load(p, __ATOMIC_RELAXED, __HIP_MEMORY_SCOPE_AGENT); }
__device__ __forceinline__ unsigned xb_add(unsigned* p, unsigned v) { return __hip_atomic_fetch_add(p, v, __ATOMIC_RELAXED, __HIP_MEMORY_SCOPE_AGENT); }
__device__ __forceinline__ unsigned xb_xcc_id() { return (unsigned)__builtin_amdgcn_s_getreg((3 << 11) | 20) & 0xFu; }
#define XB_SPIN(cond, bar) do { unsigned _sp = 0; while (cond) { __builtin_amdgcn_s_sleep(1); \
    if ((++_sp & 255u) == 0u) { if (xb_ld(&(bar)[XB_TMO])) break; if (_sp > XB_SPIN_CAP) { atomicAdd(&(bar)[XB_TMO], 1u); break; } } } } while (0)
struct XcdBarrier { unsigned* bar; unsigned x; volatile LAS unsigned* st; };
__device__ __forceinline__ XcdBarrier xcd_barrier_post(unsigned* bar, volatile LAS unsigned* st) {
    XcdBarrier b; b.bar = bar; b.x = xb_xcc_id(); b.st = st;
    if (threadIdx.x == 0) (void)xb_add(&bar[XB_XCNT(b.x)], 1u);
    return b;
}
__device__ __forceinline__ void xcd_barrier_complete(unsigned* bar, unsigned x, unsigned& nloc, unsigned& nx) {
    const unsigned G = gridDim.x * gridDim.y * gridDim.z;
    unsigned sum, cnt, mine, sp = 0u;
    for (;;) {
        sum = 0u; cnt = 0u; mine = 0u;
#pragma unroll
        for (unsigned j = 0; j < 16; ++j) { const unsigned c = xb_ld(&bar[XB_XCNT(j)]); sum += c; cnt += (c > 0u) ? 1u : 0u; mine = (j == x) ? c : mine; }
        if (sum == G) break;
        __builtin_amdgcn_s_sleep(1);
        if ((++sp & 255u) == 0u) { if (xb_ld(&bar[XB_TMO])) break; if (sp > XB_SPIN_CAP) { atomicAdd(&bar[XB_TMO], 1u); break; } }
    }
    nloc = mine > 0u ? mine : 1u; nx = cnt > 0u ? cnt : 1u;
}
__device__ __forceinline__ void xcd_barrier(const XcdBarrier& b, const int tid_) {
    asm volatile("s_waitcnt vmcnt(0)" ::: "memory");
    __syncthreads();
    if (tid_ == 0) {
        unsigned* bar = b.bar;
        __builtin_amdgcn_s_waitcnt(0);
        unsigned nloc = b.st[0], nx = b.st[1];
        if (nloc == 0u) { xcd_barrier_complete(bar, b.x, nloc, nx); b.st[0] = nloc; b.st[1] = nx; }
        const unsigned old = xb_add(&bar[XB_XSUB(b.x)], 1u);
        const unsigned gen = old / nloc;
        if (old + 1u == (gen + 1u) * nloc) {
            __builtin_amdgcn_fence(__ATOMIC_RELEASE, "agent");
            asm volatile("s_waitcnt vmcnt(0)" ::: "memory");
            const unsigned og = xb_add(&bar[XB_TOP], 1u);
            const unsigned tg = og / nx;
            if (og + 1u == (tg + 1u) * nx) xb_add(&bar[XB_TOPGEN], 1u);
            else XB_SPIN(xb_ld(&bar[XB_TOPGEN]) == tg, bar);
            __builtin_amdgcn_fence(__ATOMIC_ACQUIRE, "agent");
            xb_add(&bar[XB_XGEN(b.x)], 1u);
            asm volatile("s_waitcnt vmcnt(0)" ::: "memory");
        } else {
            XB_SPIN(xb_ld(&bar[XB_XGEN(b.x)]) == gen, bar);
            __builtin_amdgcn_fence(__ATOMIC_ACQUIRE, "agent");
            asm volatile("s_waitcnt vmcnt(0)" ::: "memory");
        }
    }
    __syncthreads();
}

struct Frame {
    LAS unsigned char* lds;
    volatile LAS unsigned* MISC;
    gu32* ctl;
    int tid, lane, wave;
    int vcu, G;
};
__device__ __forceinline__ float wave_sum(float v) {
#pragma unroll
    for (int o = 1; o < 64; o <<= 1) v += __shfl_xor(v, o);
    return v;
}

__device__ __forceinline__ void p0_transpose_item(const float* W, int K, int N, bf16* WT, int kb, int nb, int dst_row0, LAS float* scr, int lane) {
    const int k0 = 64 * kb, n0 = 32 * nb;
#pragma unroll 8
    for (int i = 0; i < 32; ++i) { const int kk = 2 * i + (lane >> 5); scr[kk * 33 + (lane & 31)] = W[(size_t)(k0 + kk) * N + n0 + (lane & 31)]; }
    LDS_WAIT(); asm volatile("" ::: "memory");
    const int c = lane & 7;
#pragma unroll
    for (int j = 0; j < 4; ++j) { const int n = (lane >> 3) + 8 * j; const LAS float* s = scr + (8 * c) * 33 + n;
        v4u o; o.x = cvt_pk_bf16(s[0 * 33], s[1 * 33]); o.y = cvt_pk_bf16(s[2 * 33], s[3 * 33]); o.z = cvt_pk_bf16(s[4 * 33], s[5 * 33]); o.w = cvt_pk_bf16(s[6 * 33], s[7 * 33]);
        *(GAS v4u*)(WT + (size_t)(dst_row0 + n) * K + k0 + 8 * c) = o; }
    LDS_WAIT(); asm volatile("" ::: "memory");
}
__device__ __forceinline__ bool conv_group(int& r, const float* src, int cnt, int K, int N, bf16* dst, size_t dstride, int mode, LAS float* scr, int lane) {
    const int per = (K / 64) * (N / 32), tot = per * cnt;
    if (r >= tot) { r -= tot; return false; }
    const int mi = r / per, it = r % per, nblk = N / 32, kb = it / nblk, nb = it % nblk, n0 = 32 * nb;
    const int drow = mode == 0 ? n0 : (256 * (n0 / 128) + (n0 % 128) + (mode == 2 ? 128 : 0));
    p0_transpose_item(src + (size_t)mi * K * N, K, N, dst + (size_t)mi * dstride, kb, nb, drow, scr, lane);
    return true;
}


template <int IDX> __device__ __forceinline__ const float* karg() { unsigned long long p; const unsigned long long ka = (unsigned long long)__builtin_amdgcn_kernarg_segment_ptr();
    asm volatile("s_load_dwordx2 %0, %1, %2\n\ts_waitcnt lgkmcnt(0)" : "=s"(p) : "s"(ka), "i"(IDX * 8) : "memory"); return (const float*)(const GAS float*)p; }
#define KIN(i) karg<(i)>()
#define KOUT ((float*)karg<26>())
#define KWS ((unsigned char*)karg<27>())
struct Args { const float* in[26]; float* out; unsigned char* ws; int ph_lo, ph_hi, li, pad; };

template <int MODE>
__device__ __forceinline__ void norm_phase(Frame& F, const float* src, const float* gain, const float* shift, const float* scale, int bstride, bf16* dst, float* dstf,
                                           const float* rw, const float* rb, gu32* moe_cnt, int2* list, const float* wf, const float* bfv, float* logf) {
    const int gw = F.vcu * NWAVES + F.wave, NGW = F.G * NWAVES, lane = F.lane;
    float wr_[MODE == 1 ? 16 : 1][8];
    if (MODE == 1) {
#pragma unroll
        for (int j = 0; j < 4; ++j)
#pragma unroll
            for (int i = 0; i < 4; ++i) { const int col = 256 * j + 4 * lane + i; const f32x4 a = *(const f32x4*)(rw + col * 8), b = *(const f32x4*)(rw + col * 8 + 4);
                wr_[MODE == 1 ? j * 4 + i : 0][0] = a[0]; wr_[MODE == 1 ? j * 4 + i : 0][1] = a[1]; wr_[MODE == 1 ? j * 4 + i : 0][2] = a[2]; wr_[MODE == 1 ? j * 4 + i : 0][3] = a[3];
                wr_[MODE == 1 ? j * 4 + i : 0][4] = b[0]; wr_[MODE == 1 ? j * 4 + i : 0][5] = b[1]; wr_[MODE == 1 ? j * 4 + i : 0][6] = b[2]; wr_[MODE == 1 ? j * 4 + i : 0][7] = b[3]; }
    }
    LAS float* wfl = (LAS float*)(F.lds + RING_OFF);
    if (MODE == 2) { for (int i = F.tid; i < D * FH / 4; i += NWAVES * 64) ((LAS f32x4*)wfl)[i] = ((const f32x4*)wf)[i]; __syncthreads(); }
    for (int b = 0; b < BATCH; ++b) {
        f32x4 ga[4], sh[4];
#pragma unroll
        for (int j = 0; j < 4; ++j) { const f32x4 g = *(const f32x4*)(gain + 256 * j + 4 * lane), sc = *(const f32x4*)(scale + (size_t)b * bstride + 256 * j + 4 * lane);
            ga[j] = g * (sc + 1.0f); sh[j] = *(const f32x4*)(shift + (size_t)b * bstride + 256 * j + 4 * lane); }
        for (int m = b * SEQ + gw; m < (b + 1) * SEQ; m += NGW) {
            const GAS f32x4* xr = (const GAS f32x4*)(src + (size_t)m * D) + lane;
            f32x4 v[4]; float s = 0.f;
#pragma unroll
            for (int j = 0; j < 4; ++j) { v[j] = xr[64 * j]; s += (v[j].x * v[j].x + v[j].y * v[j].y) + (v[j].z * v[j].z + v[j].w * v[j].w); }
            const float rstd = 1.0f / sqrtf(wave_sum(s) * (1.f / D) + EPS);
#pragma unroll
            for (int j = 0; j < 4; ++j) v[j] = (v[j] * rstd) * ga[j] + sh[j];
            if (MODE == 3) { GAS f32x4* o = (GAS f32x4*)(dstf + (size_t)m * D) + lane;
#pragma unroll
                for (int j = 0; j < 4; ++j) o[64 * j] = v[j]; }
            else { GAS unsigned long long* o8 = (GAS unsigned long long*)(dst + (size_t)m * D) + lane;
#pragma unroll
                for (int j = 0; j < 4; ++j) o8[64 * j] = (unsigned long long)cvt_pk_bf16(v[j].x, v[j].y) | ((unsigned long long)cvt_pk_bf16(v[j].z, v[j].w) << 32); }
            if (MODE == 1) {
                float lg[8];
#pragma unroll
                for (int e = 0; e < 8; ++e) { float a = 0.f;
#pragma unroll
                    for (int j = 0; j < 4; ++j)
#pragma unroll
                        for (int i = 0; i < 4; ++i) a += v[j][i] * wr_[MODE == 1 ? j * 4 + i : 0][e];
                    lg[e] = wave_sum(a) + rb[e]; }
                int i1 = 0; float v1 = lg[0];
#pragma unroll
                for (int e = 1; e < 8; ++e) if (lg[e] > v1) { v1 = lg[e]; i1 = e; }
                int i2 = -1; float v2 = -INFINITY;
#pragma unroll
                for (int e = 0; e < 8; ++e) if (e != i1 && lg[e] > v2) { v2 = lg[e]; i2 = e; }
                const float w1 = 1.0f / (1.0f + __expf(v2 - v1)), w2 = 1.0f - w1;
                if (lane == 0) {
                    const unsigned s1 = __hip_atomic_fetch_add(moe_cnt + 64 * i1, 1u, RLX_AGENT);
                    list[(size_t)i1 * T + s1] = make_int2(m, __float_as_int(w1));
                    const unsigned s2 = __hip_atomic_fetch_add(moe_cnt + 64 * (8 + i2), 1u, RLX_AGENT);
                    list[(size_t)(8 + i2) * T + s2] = make_int2(m, __float_as_int(w2));
                }
            }
            if (MODE == 2) {
                float z[16];
#pragma unroll
                for (int hh = 0; hh < 16; ++hh) z[hh] = 0.f;
#pragma unroll
                for (int j = 0; j < 4; ++j)
#pragma unroll
                    for (int i = 0; i < 4; ++i) { const LAS f32x4* wp = (const LAS f32x4*)(wfl + (256 * j + 4 * lane + i) * 16); const float xv = v[j][i];
#pragma unroll
                        for (int q = 0; q < 4; ++q) { const f32x4 w4 = wp[q]; z[4 * q] += xv * w4[0]; z[4 * q + 1] += xv * w4[1]; z[4 * q + 2] += xv * w4[2]; z[4 * q + 3] += xv * w4[3]; } }
                float mine = 0.f;
#pragma unroll
                for (int hh = 0; hh < 16; ++hh) { const float t = wave_sum(z[hh]); if (lane == hh) mine = t; }
                if (lane < 16) { const float zz = mine + bfv[lane];
                    const float ls = -__builtin_amdgcn_logf(1.0f + __builtin_amdgcn_exp2f(-zz * LOG2E));
                    logf[(size_t)m * FH + lane] = ls; }
            }
        }
    }
    if (MODE == 2) __syncthreads();
}

namespace ret {
constexpr int NG = 8, CG = SEQ / 64 / NG  , VS = 128;
constexpr int QSB = 528, VSB = 272, PSB = 144, OSB = 272;
constexpr int L_Q = 0, L_K = 64 * QSB, L_V = 2 * 64 * QSB, L_P = L_V + 64 * VSB, L_O = L_P + 64 * PSB, L_END = L_O + 64 * OSB;
static_assert(L_END <= RING_BYTES, "scan LDS");
__device__ __forceinline__ s16x4 trr(const LAS unsigned char* p) { return __builtin_bit_cast(s16x4, __builtin_amdgcn_ds_read_tr16_b64_v4i16((LAS attn_body::v4i16_t*)p)); }
template <bool OUT>
__device__ __forceinline__ void scan_unit(Frame& F, int u, bf16* proj, float* Lbuf) {
    const int vs = u & 3, grp = (u >> 2) & 7, h = (u >> 5) & 3, b = u >> 7;
    if (!OUT && grp == NG - 1) return;
    const int tid = F.tid, lane = F.lane, w = F.wave, c = lane & 15, g = lane >> 4;
    LAS unsigned char* L = F.lds + RING_OFF;
    const float l2g0 = __builtin_amdgcn_logf(1.0f - __builtin_amdgcn_exp2f(-5.0f - (float)h));
    f32x4 st[16];
#pragma unroll
    for (int t = 0; t < 16; ++t) st[t] = (f32x4){0.f, 0.f, 0.f, 0.f};
    if (OUT) {
        for (int gp = 0; gp < grp; ++gp) {
            const float wgt = __builtin_amdgcn_exp2f(l2g0 * 2048.0f * (float)(grp - 1 - gp));
            const int up = (u & ~(7 << 2)) | (gp << 2);
            const f32x4* lp = (const f32x4*)Lbuf + ((size_t)(up * 8 + w) * 16) * 64 + lane;
#pragma unroll
            for (int t = 0; t < 16; ++t) st[t] += lp[t * 64] * wgt;
        }
    }
    const size_t row0 = (size_t)b * SEQ + (size_t)grp * (CG * 64);
    const bf16* qg = proj + row0 * PROJW + h * RQK;
    const bf16* kg = proj + row0 * PROJW + D + h * RQK;
    bf16* vg = proj + row0 * PROJW + 2 * D + h * RV + vs * VS;
    v4u pq[4], pk[4], pvv[2];
#define LOADCH(cc) do { \
        _Pragma("unroll") for (int i = 0; i < 4; ++i) { const int p = tid + 512 * i, r = p >> 5, cp = p & 31; \
            if (OUT) pq[i] = *(const v4u*)(qg + ((size_t)(cc) * 64 + r) * PROJW + cp * 8); \
            pk[i] = *(const v4u*)(kg + ((size_t)(cc) * 64 + r) * PROJW + cp * 8); } \
        _Pragma("unroll") for (int i = 0; i < 2; ++i) { const int p = tid + 512 * i, r = p >> 4, cp = p & 15; \
            pvv[i] = *(const v4u*)(vg + ((size_t)(cc) * 64 + r) * PROJW + cp * 8); } } while (0)
    LOADCH(0);
    for (int cc = 0; cc < CG; ++cc) {
        float l2g = l2g0; asm volatile("" : "+v"(l2g));
#pragma unroll
        for (int i = 0; i < 4; ++i) { const int p = tid + 512 * i, r = p >> 5, cp = p & 31;
            if (OUT) *(LAS v4u*)(L + L_Q + r * QSB + cp * 16) = pq[i];
            *(LAS v4u*)(L + L_K + r * QSB + cp * 16) = pk[i]; }
#pragma unroll
        for (int i = 0; i < 2; ++i) { const int p = tid + 512 * i, r = p >> 4, cp = p & 15; const float kd = __builtin_amdgcn_exp2f(l2g * (float)(63 - r));
            v4u o;
#pragma unroll
            for (int j = 0; j < 4; ++j) o[j] = cvt_pk_bf16(bf_lo(pvv[i][j]) * kd, bf_hi(pvv[i][j]) * kd);
            *(LAS v4u*)(L + L_V + r * VSB + cp * 16) = o; }
        __syncthreads();
        if (cc + 1 < CG) LOADCH(cc + 1);
        if (OUT) {
#pragma unroll
            for (int ti = 0; ti < 2; ++ti) { const int idx = 2 * w + ti, mt = idx >> 2, ntl = idx & 3;
                f32x4 acc = (f32x4){0.f, 0.f, 0.f, 0.f};
#pragma unroll
                for (int ks = 0; ks < 8; ++ks) { const bf16x8 a = *(const LAS bf16x8*)(L + L_K + (16 * mt + c) * QSB + (32 * ks + 8 * g) * 2), bq = *(const LAS bf16x8*)(L + L_Q + (16 * ntl + c) * QSB + (32 * ks + 8 * g) * 2);
                    acc = __builtin_amdgcn_mfma_f32_16x16x32_bf16(a, bq, acc, 0, 0, 0); }
                const int n = 16 * ntl + c; float pvl[4];
#pragma unroll
                for (int i = 0; i < 4; ++i) { const int m = 16 * mt + 4 * g + i; const float e = (m <= n) ? -64.0f : (float)(2 * (m - n) - 64); pvl[i] = acc[i] * __builtin_amdgcn_exp2f(l2g * e); }
                v2u pw; pw.x = cvt_pk_bf16(pvl[0], pvl[1]); pw.y = cvt_pk_bf16(pvl[2], pvl[3]);
                *(LAS v2u*)(L + L_P + n * PSB + (16 * mt + 4 * g) * 2) = pw; }
            __syncthreads();
        }
        bf16x8 bv[2];
#pragma unroll
        for (int ks = 0; ks < 2; ++ks) { const LAS unsigned char* vp = L + L_V + (32 * ks + 8 * g + (c >> 2)) * VSB + (16 * w + 4 * (c & 3)) * 2;
            const s16x4 lo = trr(vp), hi = trr(vp + 4 * VSB); bv[ks] = (bf16x8){lo[0], lo[1], lo[2], lo[3], hi[0], hi[1], hi[2], hi[3]}; }
        if (OUT) {
            f32x4 ao[4];
#pragma unroll
            for (int nt_ = 0; nt_ < 4; ++nt_) ao[nt_] = (f32x4){0.f, 0.f, 0.f, 0.f};
#pragma unroll
            for (int ks = 0; ks < 2; ++ks)
#pragma unroll
                for (int nt_ = 0; nt_ < 4; ++nt_) { const bf16x8 a = *(const LAS bf16x8*)(L + L_P + (16 * nt_ + c) * PSB + (32 * ks + 8 * g) * 2); ao[nt_] = __builtin_amdgcn_mfma_f32_16x16x32_bf16(a, bv[ks], ao[nt_], 0, 0, 0); }
#pragma unroll
            for (int ks = 0; ks < 8; ++ks) { v4u sb; sb.x = cvt_pk_bf16(st[2 * ks][0], st[2 * ks][1]); sb.y = cvt_pk_bf16(st[2 * ks][2], st[2 * ks][3]); sb.z = cvt_pk_bf16(st[2 * ks + 1][0], st[2 * ks + 1][1]); sb.w = cvt_pk_bf16(st[2 * ks + 1][2], st[2 * ks + 1][3]);
                const bf16x8 sfrag = __builtin_bit_cast(bf16x8, sb);
#pragma unroll
                for (int nt_ = 0; nt_ < 4; ++nt_) { const bf16x8 a = *(const LAS bf16x8*)(L + L_Q + (16 * nt_ + c) * QSB + (32 * ks + 8 * g) * 2); ao[nt_] = __builtin_amdgcn_mfma_f32_16x16x32_bf16(a, sfrag, ao[nt_], 0, 0, 0); } }
#pragma unroll
            for (int nt_ = 0; nt_ < 4; ++nt_)
#pragma unroll
                for (int i = 0; i < 4; ++i) { const int n = 16 * nt_ + 4 * g + i; const float ov = ao[nt_][i] * __builtin_amdgcn_exp2f(l2g * (float)(n + 1));
                    *(LAS bf16*)(L + L_O + n * OSB + (16 * w + c) * 2) = (bf16)(cvt_pk_bf16(ov, 0.f) & 0xffffu); }
        }
        const float cdec = __builtin_amdgcn_exp2f(l2g * 64.0f);
#pragma unroll
        for (int t = 0; t < 16; ++t) { f32x4 a = st[t] * cdec;
#pragma unroll
            for (int ks = 0; ks < 2; ++ks) { const LAS unsigned char* kp = L + L_K + (32 * ks + 8 * g + (c >> 2)) * QSB + (32 * (t >> 1) + 4 * (t & 1) + 8 * (c & 3)) * 2;
                const s16x4 lo = trr(kp), hi = trr(kp + 4 * QSB); const bf16x8 kf = (bf16x8){lo[0], lo[1], lo[2], lo[3], hi[0], hi[1], hi[2], hi[3]};
                a = __builtin_amdgcn_mfma_f32_16x16x32_bf16(kf, bv[ks], a, 0, 0, 0); }
            st[t] = a; }
        __syncthreads();
        if (OUT) {
#pragma unroll
            for (int i = 0; i < 2; ++i) { const int p = tid + 512 * i, r = p >> 4, cp = p & 15;
                *(v4u*)(vg + ((size_t)cc * 64 + r) * PROJW + cp * 8) = *(const LAS v4u*)(L + L_O + r * OSB + cp * 16); }
        }
    }
#undef LOADCH
    if (!OUT) { f32x4* lp = (f32x4*)Lbuf + ((size_t)(u * 8 + w) * 16) * 64 + lane;
#pragma unroll
        for (int t = 0; t < 16; ++t) lp[t * 64] = st[t]; }
}
}

__device__ __forceinline__ int lane_id_opaque() { int l; asm volatile("v_mbcnt_lo_u32_b32 %0, -1, 0\n\tv_mbcnt_hi_u32_b32 %0, -1, %0" : "=v"(l)); return l; }
#define PHASE(k, sync, ...) do { if (lo <= (k) && (k) < hi) { F.lane = lane_id_opaque(); F.tid = F.wave * 64 + F.lane; __VA_ARGS__ if ((sync) && (k) + 1 < hi) xcd_barrier(bar, F.tid); } } while (0)
#define WSP(T_, off) ((T_*)(KWS + (off)))
#define MODP(l) (WSP(float, WS_MOD) + (l) * MOD_L)

__device__ __forceinline__ void moe_table(Frame& F, LAS int* TB, gu32* mcnt, int rk) {
    __syncthreads();
    if (F.tid == 0) { int acc = 0; for (int e = 0; e < 8; ++e) { const int cnt = (int)__hip_atomic_load(mcnt + 64 * (rk * 8 + e), RLX_AGENT); TB[e] = acc; TB[16 + e] = cnt; acc += (cnt + 255) >> 8; } TB[8] = acc; }
    __syncthreads();
}

template <int L, int P>
__device__ __forceinline__ void ffn_part(Frame& F, const XcdBarrier& bar, const int lo, const int hi) {
    constexpr int I = L >> 1;
    if constexpr ((L & 1) == 0) {
        PHASE(P, true, { norm_phase<0>(F, KOUT, KIN(4) + (L * 2 + 1) * D, MODP(L) + 3 * D, MODP(L) + 4 * D, 6 * D, WSP(bf16, WS_XN), nullptr, nullptr, nullptr, nullptr, nullptr, nullptr, nullptr, nullptr); });
        PHASE(P + 1, true, { pg8::DenseOrder S{WSP(bf16, WS_XN), WSP(bf16, W_FUP) + (size_t)I * 2 * DFF * D, D, D, T / 256, 2 * DFF / 256, F.G, (int)blockIdx.x};
              pg8::EpiSwiglu E{WSP(bf16, WS_HID), DFF};
              pg8::gemm_phase<pg8::EpiSwiglu, pg8::DenseOrder, false>(F.lds + RING_OFF, S, E, F.tid); });
        PHASE(P + 2, true, { pg8::DenseOrder S{WSP(bf16, WS_HID), WSP(bf16, W_FDN) + (size_t)I * DFF * D, DFF, DFF, T / 256, D / 256, F.G, (int)blockIdx.x};
              pg8::EpiResid E{KOUT, KOUT, MODP(L) + 5 * D, 6 * D};
              pg8::gemm_phase<pg8::EpiResid, pg8::DenseOrder, false>(F.lds + RING_OFF, S, E, F.tid); });
    } else {
        PHASE(P, true, { norm_phase<1>(F, KOUT, KIN(4) + (L * 2 + 1) * D, MODP(L) + 3 * D, MODP(L) + 4 * D, 6 * D, WSP(bf16, WS_XN), nullptr, KIN(18) + (size_t)I * D * NE, KIN(19) + I * NE,
                                       (gu32*)WSP(unsigned, WS_CTL) + CW_MOE + I * 16 * 64, WSP(int2, WS_LIST), nullptr, nullptr, nullptr); });
_Pragma("unroll")
        for (int rk = 0; rk < 2; ++rk) {
            PHASE(P + 1 + 2 * rk, true, { LAS int* TB = (LAS int*)(F.lds + TB_OFF); moe_table(F, TB, (gu32*)WSP(unsigned, WS_CTL) + CW_MOE + I * 16 * 64, rk);
                  pg8::MoeOrder S{WSP(bf16, WS_XN), WSP(bf16, W_MUP) + (size_t)I * 8 * 2 * DFE * D, D, D, 2 * DFE / 256, F.G, (int)blockIdx.x, (size_t)2 * DFE * D, WSP(int2, WS_LIST) + (size_t)rk * 8 * T, TB, true};
                  pg8::EpiSwiglu E{WSP(bf16, WS_HID), DFE};
                  pg8::gemm_phase<pg8::EpiSwiglu, pg8::MoeOrder, true>(F.lds + RING_OFF, S, E, F.tid); });
            PHASE(P + 2 + 2 * rk, true, { LAS int* TB = (LAS int*)(F.lds + TB_OFF); moe_table(F, TB, (gu32*)WSP(unsigned, WS_CTL) + CW_MOE + I * 16 * 64, rk);
                  pg8::MoeOrder S{WSP(bf16, WS_HID), WSP(bf16, W_MDN) + (size_t)I * 8 * DFE * D, DFE, DFE, D / 256, F.G, (int)blockIdx.x, (size_t)DFE * D, WSP(int2, WS_LIST) + (size_t)rk * 8 * T, TB, false};
                  pg8::EpiMoeDown E{KOUT, MODP(L) + 5 * D, 6 * D, WSP(int2, WS_LIST) + (size_t)rk * 8 * T, TB};
                  pg8::gemm_phase<pg8::EpiMoeDown, pg8::MoeOrder, false>(F.lds + RING_OFF, S, E, F.tid); });
        }
    }
}

template <int L, int P>
__device__ __forceinline__ void ret_layer(Frame& F, const XcdBarrier& bar, const int lo, const int hi) {
    PHASE(P, true, { norm_phase<0>(F, L == 0 ? KIN(0) : KOUT, KIN(4) + (L * 2 + 0) * D, MODP(L) + 0 * D, MODP(L) + 1 * D, 6 * D, WSP(bf16, WS_XN), nullptr, nullptr, nullptr, nullptr, nullptr, nullptr, nullptr, nullptr); });
    PHASE(P + 1, true, { pg8::DenseOrder S{WSP(bf16, WS_XN), WSP(bf16, W_RIN) + (size_t)L * 6 * D * D, D, D, T / 256, PROJW / 256, F.G, (int)blockIdx.x};
          pg8::EpiRetIn E{WSP(bf16, WS_PROJ), WSP(f32x2, WS_ROPE)};
          pg8::gemm_phase<pg8::EpiRetIn, pg8::DenseOrder, false>(F.lds + RING_OFF, S, E, F.tid); });
    PHASE(P + 2, true, { for (int u = blockIdx.x; u < 256; u += F.G) ret::scan_unit<false>(F, u, WSP(bf16, WS_PROJ), WSP(float, WS_LST)); });
    PHASE(P + 3, true, { for (int u = blockIdx.x; u < 256; u += F.G) ret::scan_unit<true>(F, u, WSP(bf16, WS_PROJ), WSP(float, WS_LST)); });
    PHASE(P + 4, true, {
          const int gw = F.vcu * NWAVES + F.wave, NGW = F.G * NWAVES; bf16* PROJ = WSP(bf16, WS_PROJ);
          for (int it = gw; it < T * RH; it += NGW) { const int row = it >> 2, hh = it & 3;
              bf16* op = PROJ + (size_t)row * PROJW + 2 * D + hh * RV + F.lane * 8; const bf16* gp = op + 2 * D;
              const v4u ov = *(const v4u*)op, gv = *(const v4u*)gp; float o[8], gg[8];
_Pragma("unroll")
              for (int j = 0; j < 4; ++j) { o[2 * j] = bf_lo(ov[j]); o[2 * j + 1] = bf_hi(ov[j]); gg[2 * j] = bf_lo(gv[j]); gg[2 * j + 1] = bf_hi(gv[j]); }
              float s = 0.f;
_Pragma("unroll")
              for (int j = 0; j < 8; ++j) s += o[j];
              const float mu = wave_sum(s) * (1.0f / RV); float q = 0.f;
_Pragma("unroll")
              for (int j = 0; j < 8; ++j) { o[j] -= mu; q += o[j] * o[j]; }
              const float rstd = 1.0f / sqrtf(wave_sum(q) * (1.0f / RV) + EPS);
              v4u w;
_Pragma("unroll")
              for (int j = 0; j < 4; ++j) w[j] = cvt_pk_bf16(o[2 * j] * rstd * fast_silu(gg[2 * j]), o[2 * j + 1] * rstd * fast_silu(gg[2 * j + 1]));
              *(v4u*)op = w; } });
    PHASE(P + 5, true, { pg8::DenseOrder S{WSP(bf16, WS_PROJ) + 2 * D, WSP(bf16, W_RO) + (size_t)L * 2 * D * D, PROJW, 2 * D, T / 256, D / 256, F.G, (int)blockIdx.x};
          pg8::EpiResid E{L == 0 ? KIN(0) : KOUT, KOUT, MODP(L) + 2 * D, 6 * D};
          pg8::gemm_phase<pg8::EpiResid, pg8::DenseOrder, false>(F.lds + RING_OFF, S, E, F.tid); });
    ffn_part<L, P + 6>(F, bar, lo, hi);
}

template <int L, int P>
__device__ __forceinline__ void fox_layer(Frame& F, const XcdBarrier& bar, const int lo, const int hi, unsigned char* ldsg) {
    constexpr int J = L - 2; constexpr int X = (L == 2) ? 2 : 0;
    PHASE(P, true, { norm_phase<0>(F, KOUT, KIN(4) + (L * 2 + 0) * D, MODP(L) + 0 * D, MODP(L) + 1 * D, 6 * D, WSP(bf16, WS_XN), nullptr, nullptr, nullptr, nullptr, nullptr, nullptr, nullptr, nullptr); });
    if constexpr (L == 2) {
        PHASE(P + 1, true, { norm_phase<2>(F, KOUT, KIN(9), WSP(float, WS_MOD) + MOD_KV, WSP(float, WS_MOD) + MOD_KV + D, 2 * D, WSP(bf16, WS_G), nullptr, nullptr, nullptr, nullptr, nullptr, KIN(11), KIN(12), WSP(float, WS_LOGF)); });
        PHASE(P + 2, true, {
            if (blockIdx.x < 32) {
                const int bb = blockIdx.x >> 4, hh = blockIdx.x & 15; const float* lf = WSP(float, WS_LOGF) + (size_t)bb * SEQ * FH + hh; float* fo = WSP(float, WS_FL2) + (size_t)blockIdx.x * SEQ;
                LAS double* sc = (LAS double*)(F.lds + RING_OFF);
                double s = 0.0;
                for (int i = 0; i < 32; ++i) s += (double)lf[(size_t)(F.tid * 32 + i) * FH];
                sc[F.tid] = s; __syncthreads();
                for (int off = 1; off < 512; off <<= 1) { double t = (F.tid >= off) ? sc[F.tid - off] : 0.0; __syncthreads(); sc[F.tid] += t; __syncthreads(); }
                double run = sc[F.tid] - s;
                for (int i = 0; i < 32; ++i) { run += (double)lf[(size_t)(F.tid * 32 + i) * FH]; fo[F.tid * 32 + i] = (float)run; }
                __syncthreads();
            }
            pg8::DenseOrder S{WSP(bf16, WS_G), WSP(bf16, W_KV), D, D, T / 256, 2 * D / 256, F.G, (int)blockIdx.x};
            pg8::EpiBf16 E{WSP(bf16, WS_K), D, D, (size_t)(WS_V - WS_K) / 2, 1.0f, WSP(unsigned, WS_CTL) + CW_NMAX};
            pg8::gemm_phase<pg8::EpiBf16, pg8::DenseOrder, false>(F.lds + RING_OFF, S, E, F.tid); });
    }
    PHASE(P + 1 + X, true, { pg8::DenseOrder S{WSP(bf16, WS_XN), WSP(bf16, W_QG) + (size_t)J * 2 * D * D, D, D, T / 256, 2 * D / 256, F.G, (int)blockIdx.x};
          pg8::EpiBf16 E{WSP(bf16, WS_Q), D, D, (size_t)(WS_G - WS_Q) / 2, QC2, WSP(unsigned, WS_CTL) + CW_NMAX + 64 * (1 + J)};
          pg8::gemm_phase<pg8::EpiBf16, pg8::DenseOrder, false>(F.lds + RING_OFF, S, E, F.tid); });
    PHASE(P + 2 + X, true, { const int vcu = F.vcu, s = vcu & 7, bh = vcu >> 3;
          if (F.G == 256) {
            for (int i = 0; i < 8; ++i) { const int base = 16 * (i >> 1); const int qb = (i & 1) ? base + 15 - s : base + s;
                attn_body::attn_unit<8>(bh / FH, bh % FH, qb, WSP(const attn_body::hbf16, WS_Q), WSP(const attn_body::hbf16, WS_K), WSP(const attn_body::hbf16, WS_V), WSP(const attn_body::hbf16, WS_G),
                                        WSP(const float, WS_FL2), WSP(const unsigned, WS_CTL) + CW_NMAX, J, WSP(attn_body::hbf16, WS_Q), (char*)ldsg + RING_OFF, F.tid); }
          } });
    PHASE(P + 3 + X, true, { pg8::DenseOrder S{WSP(bf16, WS_Q), WSP(bf16, W_FO) + (size_t)J * D * D, D, D, T / 256, D / 256, F.G, (int)blockIdx.x};
          pg8::EpiResid E{KOUT, KOUT, MODP(L) + 2 * D, 6 * D};
          pg8::gemm_phase<pg8::EpiResid, pg8::DenseOrder, false>(F.lds + RING_OFF, S, E, F.tid); });
    ffn_part<L, P + 4 + X>(F, bar, lo, hi);
}

__global__ void __launch_bounds__(NWAVES * 64, 2) yoco_fwd(Args args) {
    extern __shared__ __attribute__((aligned(16))) unsigned char lds[];
    Frame F;
    F.lds = (LAS unsigned char*)lds;
    F.MISC = (volatile LAS unsigned*)(F.lds + MISC_OFF);
    F.tid = threadIdx.x; F.lane = F.tid & 63; F.wave = __builtin_amdgcn_readfirstlane(F.tid >> 6);
    F.G = gridDim.x; { const int bx = blockIdx.x; F.vcu = (F.G % 8 == 0) ? (bx % 8) * (F.G / 8) + bx / 8 : bx; }
    F.ctl = (gu32*)(KWS + WS_CTL);
    for (int u = F.tid; u < (LDS_BYTES - LDSCTL_OFF) / 4; u += NWAVES * 64) ((LAS unsigned*)(F.lds + LDSCTL_OFF))[u] = 0u;
    __syncthreads();
    const XcdBarrier bar = xcd_barrier_post((unsigned*)(F.ctl + CW_BAR) + args.li * XCD_BAR_WORDS, F.MISC + 8);
    const int lo = args.ph_lo, hi = args.ph_hi;

    PHASE(0, true, {
    {
        LAS float* ca = (LAS float*)(F.lds + RING_OFF);
        LAS float* red = ca + 2048;
        { const float* cin = KIN(1); for (int i = F.tid; i < 2 * D; i += NWAVES * 64) ca[i] = fast_silu(cin[i]); }
        __syncthreads();
        constexpr int NCOLB = (4 * 6 * D + 2 * D + 2 * D) / 128;
        float* MOD = WSP(float, WS_MOD);
        for (int cb = blockIdx.x; cb < NCOLB; cb += F.G) {
            const int gc = cb * 128 + (F.tid & 127), kq = F.tid >> 7;
            const float* W; const float* bias; int ldw, n; float* outp; int ostride;
            if (gc < 4 * 6 * D) { const int l = gc / (6 * D); n = gc % (6 * D); W = KIN(2) + (size_t)l * D * 6 * D; ldw = 6 * D; bias = KIN(3) + l * 6 * D; outp = MOD + l * MOD_L; ostride = 6 * D; }
            else if (gc < 4 * 6 * D + 2 * D) { n = gc - 4 * 6 * D; W = KIN(7); ldw = 2 * D; bias = KIN(8); outp = MOD + MOD_KV; ostride = 2 * D; }
            else { n = gc - 4 * 6 * D - 2 * D; W = KIN(23); ldw = 2 * D; bias = KIN(24); outp = MOD + MOD_FIN; ostride = 2 * D; }
            float a0 = 0.f, a1 = 0.f; const float* wp = W + (size_t)(256 * kq) * ldw + n;
_Pragma("unroll 8")
            for (int k = 0; k < 256; ++k) { const float wv = wp[(size_t)k * ldw]; a0 += ca[256 * kq + k] * wv; a1 += ca[D + 256 * kq + k] * wv; }
            red[(kq * 2 + 0) * 128 + (F.tid & 127)] = a0; red[(kq * 2 + 1) * 128 + (F.tid & 127)] = a1;
            __syncthreads();
            if (F.tid < 256) { const int bb = F.tid >> 7, cl = F.tid & 127;
                const float s = (red[(0 * 2 + bb) * 128 + cl] + red[(1 * 2 + bb) * 128 + cl]) + (red[(2 * 2 + bb) * 128 + cl] + red[(3 * 2 + bb) * 128 + cl]);
                outp[(size_t)bb * ostride + n] = s + bias[n]; }
            __syncthreads();
        }
    }
    {
        f32x2* rope = WSP(f32x2, WS_ROPE);
        for (int i = blockIdx.x * (NWAVES * 64) + F.tid; i < SEQ * 128; i += F.G * NWAVES * 64) { const int pos = i >> 7, j = i & 127;
            const float inv = __builtin_amdgcn_exp2f(-(float)j * (13.287712379549449f / 128.0f));
            const float ang = (float)pos * inv;
            double tr = (double)ang * 0.15915494309189535; tr -= __builtin_rint(tr); const float tf = (float)tr;
            rope[i] = (f32x2){__builtin_amdgcn_cosf(tf), __builtin_amdgcn_sinf(tf)}; }
    }
    {
        LAS float* scr = (LAS float*)(F.lds + RING_OFF + 16384 + F.wave * 12288);
        const int gw = F.vcu * NWAVES + F.wave, NGW = F.G * NWAVES;
        constexpr int NIT = 2 * 16 * 192 + 2 * 32 * 32 + 16 * 64 + 2 * 16 * 64 + 2 * 16 * 32 + 2 * 2 * 16 * 88 + 2 * 44 * 32 + 2 * 16 * 16 * 112 + 16 * 56 * 32;
        for (int it = gw; it < NIT; it += NGW) { int r = it;
            if (conv_group(r, KIN(5), 2, D, 6 * D, WSP(bf16, W_RIN), (size_t)6 * D * D, 0, scr, F.lane)) continue;
            if (conv_group(r, KIN(6), 2, 2 * D, D, WSP(bf16, W_RO), (size_t)2 * D * D, 0, scr, F.lane)) continue;
            if (conv_group(r, KIN(10), 1, D, 2 * D, WSP(bf16, W_KV), 0, 0, scr, F.lane)) continue;
            if (conv_group(r, KIN(13), 2, D, 2 * D, WSP(bf16, W_QG), (size_t)2 * D * D, 0, scr, F.lane)) continue;
            if (conv_group(r, KIN(14), 2, D, D, WSP(bf16, W_FO), (size_t)D * D, 0, scr, F.lane)) continue;
            if (conv_group(r, KIN(15), 2, D, DFF, WSP(bf16, W_FUP), (size_t)2 * DFF * D, 1, scr, F.lane)) continue;
            if (conv_group(r, KIN(16), 2, D, DFF, WSP(bf16, W_FUP), (size_t)2 * DFF * D, 2, scr, F.lane)) continue;
            if (conv_group(r, KIN(17), 2, DFF, D, WSP(bf16, W_FDN), (size_t)DFF * D, 0, scr, F.lane)) continue;
            if (conv_group(r, KIN(20), 16, D, DFE, WSP(bf16, W_MUP), (size_t)2 * DFE * D, 1, scr, F.lane)) continue;
            if (conv_group(r, KIN(21), 16, D, DFE, WSP(bf16, W_MUP), (size_t)2 * DFE * D, 2, scr, F.lane)) continue;
            conv_group(r, KIN(22), 16, DFE, D, WSP(bf16, W_MDN), (size_t)DFE * D, 0, scr, F.lane);
        }
    }
    });
    ret_layer<0, 1>(F, bar, lo, hi);
    ret_layer<1, 10>(F, bar, lo, hi);
    fox_layer<2, 21>(F, bar, lo, hi, lds);
    fox_layer<3, 30>(F, bar, lo, hi, lds);
    PHASE(39, false, { norm_phase<3>(F, KOUT, KIN(25), WSP(float, WS_MOD) + MOD_FIN, WSP(float, WS_MOD) + MOD_FIN + D, 2 * D, nullptr, KOUT, nullptr, nullptr, nullptr, nullptr, nullptr, nullptr, nullptr); });
}

extern "C" void kernel_launch(void* const* d_in, const int* in_sizes, int n_in, void* d_out, int out_size, void* d_ws, size_t ws_size, hipStream_t stream) {
    static int grid = 0;
    if (grid == 0) {
        if (n_in != 26 || in_sizes[0] != T * D || out_size != T * D || ws_size < WS_END) { fprintf(stderr, "kernel_launch: unexpected shapes / workspace (n_in %d, ws %zu, need %zu)\n", n_in, ws_size, (size_t)WS_END); grid = -1; return; }
        int dev = 0, cus = 0;
        if (hipGetDevice(&dev) != hipSuccess || hipDeviceGetAttribute(&cus, hipDeviceAttributeMultiprocessorCount, dev) != hipSuccess) { grid = -1; return; }
        if (hipFuncSetAttribute((const void*)yoco_fwd, hipFuncAttributeMaxDynamicSharedMemorySize, LDS_BYTES) != hipSuccess) { fprintf(stderr, "kernel_launch: hipFuncSetAttribute failed\n"); grid = -1; return; }
        int per_cu = 0;
        if (hipOccupancyMaxActiveBlocksPerMultiprocessor(&per_cu, (const void*)yoco_fwd, NWAVES * 64, LDS_BYTES) != hipSuccess || per_cu < 1) { fprintf(stderr, "kernel_launch: occupancy query says %d\n", per_cu); }
        (void)hipGetLastError();
        grid = cus;
    }
    if (grid < 0) return;
    (void)hipMemsetAsync((char*)d_ws + WS_CTL, 0, CTL_ZERO_BYTES, stream);
    Args a{};
    for (int i = 0; i < 26; ++i) a.in[i] = (const float*)d_in[i];
    a.out = (float*)d_out; a.ws = (unsigned char*)d_ws;
    constexpr int NPH = 40;
#if MK_N_LAUNCHES == 1
    a.ph_lo = 0; a.ph_hi = NPH; a.li = 0; a.pad = 0;
    hipLaunchKernelGGL(yoco_fwd, dim3(grid), dim3(NWAVES * 64), LDS_BYTES, stream, a);
#else
    for (int p = 0; p < NPH; ++p) { a.ph_lo = p; a.ph_hi = p + 1; a.li = 0; a.pad = 0;
        hipLaunchKernelGGL(yoco_fwd, dim3(grid), dim3(NWAVES * 64), LDS_BYTES, stream, a); }
#endif
}
```

```cpp
#include <hip/hip_runtime.h>
#include <hip/hip_bf16.h>
#include <cstdio>
#include <cstdint>
#include <cmath>

#ifndef MK_N_LAUNCHES
#define MK_N_LAUNCHES 1
#endif

constexpr int BATCH = 2, SEQ = 16384, D = 1024, T = BATCH * SEQ;
constexpr int RH = 4, RQK = 256, RV = 512, PROJW = 6 * D;
constexpr int FH = 16, FD = 64;
constexpr int DFF = 2816, NE = 8, DFE = 3584;
constexpr float EPS = 1e-6f;
constexpr float LOG2E = 1.4426950408889634f;
#ifndef SKIP_LOG2
#define SKIP_LOG2 40.0f
#endif
constexpr float QS_X = 127.0f / 5.5f, QS_H = 127.0f / 9.5f, QS_WUP = 127.0f * 32.0f / 4.0f, QS_WDN_F = 127.0f * 53.066f / 4.0f  , QS_WDN_M = 127.0f * 59.867f / 4.0f  ;
constexpr float QC2 = 0.125f * 1.4426950408889634f;

#define GAS __attribute__((address_space(1)))
#define LAS __attribute__((address_space(3)))
typedef unsigned short bf16;
typedef unsigned v4u __attribute__((ext_vector_type(4)));
typedef unsigned v2u __attribute__((ext_vector_type(2)));
typedef float f32x4 __attribute__((ext_vector_type(4)));
typedef float f32x2 __attribute__((ext_vector_type(2)));
typedef short bf16x8 __attribute__((ext_vector_type(8)));
typedef short s16x4 __attribute__((ext_vector_type(4)));
typedef GAS unsigned gu32;
#define RLX_AGENT __ATOMIC_RELAXED, __HIP_MEMORY_SCOPE_AGENT
#define LDS_WAIT() asm volatile("s_waitcnt lgkmcnt(0)" ::: "memory")
#define VM_WAIT() asm volatile("s_waitcnt vmcnt(0)" ::: "memory")

__device__ __forceinline__ unsigned cvt_pk_bf16(float lo, float hi) { unsigned r; asm volatile("v_cvt_pk_bf16_f32 %0, %1, %2" : "=v"(r) : "v"(lo), "v"(hi)); return r; }
__device__ __forceinline__ float bf_lo(unsigned u) { return __uint_as_float(u << 16); }
__device__ __forceinline__ float bf_hi(unsigned u) { return __uint_as_float(u & 0xffff0000u); }
__device__ __forceinline__ float fast_sigmoid(float x) { return __builtin_amdgcn_rcpf(1.0f + __builtin_amdgcn_exp2f(-x * LOG2E)); }
__device__ __forceinline__ float fast_silu(float x) { return x * fast_sigmoid(x); }

constexpr size_t MiB = 1u << 20;
constexpr size_t WS_CTL = 0, CTL_ZERO_BYTES = 1 * MiB;
constexpr size_t WS_MOD = 1 * MiB;
constexpr size_t WS_LOGF = 2 * MiB;
constexpr size_t WS_FL2 = 4 * MiB;
constexpr size_t WS_LIST = 6 * MiB;
constexpr size_t WS_ROPE = 10 * MiB;
constexpr size_t WS_LST = 26 * MiB;
constexpr size_t WS_W = 64 * MiB;
constexpr size_t W_RIN = WS_W;
constexpr size_t W_RO = W_RIN + 2 * 12 * MiB;
constexpr size_t W_KV = W_RO + 2 * 4 * MiB;
constexpr size_t W_QG = W_KV + 4 * MiB;
constexpr size_t W_FO = W_QG + 2 * 4 * MiB;
constexpr size_t W_FUP = W_FO + 2 * 2 * MiB;
constexpr size_t W_FDN = W_FUP + 2 * 11 * MiB;
constexpr size_t W_MUP = W_FDN + 11 * MiB;
constexpr size_t W_MDN = W_MUP + 16 * 14 * MiB;
constexpr size_t WS_XN = W_MDN + 16 * 7 * MiB;
constexpr size_t WS_BIG = WS_XN + 64 * MiB;
constexpr size_t WS_PROJ = WS_BIG;
constexpr size_t WS_Q = WS_BIG, WS_G = WS_BIG + 64 * MiB, WS_K = WS_BIG + 256 * MiB, WS_V = WS_BIG + 320 * MiB;
constexpr size_t WS_XN8 = WS_BIG + 384 * MiB;
constexpr size_t WS_HID = WS_BIG;
constexpr int HID_ROWS = 2 * T + NE * 256;
constexpr size_t WS_H = WS_BIG + 462 * MiB;
constexpr size_t WS_END = WS_H + 64 * MiB;
static_assert(WS_XN == 481 * MiB && WS_END == 1071 * MiB && (size_t)HID_ROWS * DFE * 2 <= 462 * MiB, "ws map");

constexpr int MOD_L = 2 * 6 * D;
constexpr int MOD_KV = 4 * MOD_L, MOD_FIN = MOD_KV + 2 * 2 * D;
constexpr int CW_BAR = 4096;
constexpr int CW_MOE = 16384;
constexpr int CW_NMAX = 24576;
constexpr int CW_DBG = 32768;

namespace pg8 {
constexpr int BM = 256, BK = 64, HALF = 128, HTB = HALF * BK * 2, STAGE_BYTES = 8 * HTB, NXCD = 8, WGM = 2;
__host__ __device__ __forceinline__ int lds_byte(int r, int c) { const int st = (r >> 4) * 2 + (c >> 5), rr = r & 15, cc = c & 31, ob = rr * 64 + cc * 2; return st * 1024 + (ob ^ (((ob >> 9) & 1) << 5)); }
__host__ __device__ __forceinline__ void stage_rc(int b, int& R, int& C) { const int st = b / 1024, sb = b % 1024, swz = sb ^ (((sb >> 9) & 1) << 5); R = (st >> 1) * 16 + swz / 64; C = (st & 1) * 32 + (swz % 64) / 2; }
__host__ __device__ __forceinline__ int perm32(int rho) { const int n = rho >> 4, i = rho & 15; return 8 * (i >> 2) + 4 * n + (i & 3); }

__device__ __forceinline__ float acc_i2f(float bits);
struct Unit { int pm, pn, e, mt; };

__device__ __forceinline__ bool order_tile(int i, int G, int c, int nM, int nN, int& pm, int& pn) {
    const int nwg = nM * nN; const long L = (long)i * G + c; if (L >= nwg) return false;
    int wgid = (int)L; { const int q = nwg / NXCD, r = nwg % NXCD, xcd = wgid % NXCD, off = wgid / NXCD; wgid = (xcd < r ? xcd * (q + 1) : r * (q + 1) + (xcd - r) * q) + off; }
    const int nig = WGM * nN, gid = wgid / nig, fm = gid * WGM, gsz = (nM - fm) < WGM ? (nM - fm) : WGM;
    pm = fm + ((wgid % nig) % gsz); pn = (wgid % nig) / gsz; return true;
}
struct DenseOrder {
    const bf16* A; const bf16* Bt; int lda, K, nM, nN, G, c;
    __device__ __forceinline__ bool next(int i, Unit& u) const { u.e = 0; u.mt = 0; return order_tile(i, G, c, nM, nN, u.pm, u.pn); }
    __device__ __forceinline__ const char* a_tile(const Unit& u) const { return (const char*)A + (size_t)u.pm * BM * lda * 2; }
    __device__ __forceinline__ const char* b_tile(const Unit& u) const { return (const char*)Bt + (size_t)u.pn * BM * K * 2; }
    __device__ __forceinline__ int row_tok(const Unit&, int) const { return 0; }
    __device__ __forceinline__ const int* row_ptr(int, int, int) const { return nullptr; }
    __device__ __forceinline__ int row_fix(int, int, int, int) const { return 0; }
};
struct MoeOrder {
    const bf16* A; const bf16* Bt; int lda, K, nN, G, c; size_t bstride  ; const int2* list  ; const LAS int* tb; bool gather;
    __device__ __forceinline__ bool next(int i, Unit& u) const {
        const int ntile = tb[8]; const int nwg = ntile * nN; const long L = (long)i * G + c; if (L >= nwg) return false;
        int wgid = (int)L; { const int q = nwg / NXCD, r = nwg % NXCD, xcd = wgid % NXCD, off = wgid / NXCD; wgid = (xcd < r ? xcd * (q + 1) : r * (q + 1) + (xcd - r) * q) + off; }
        if (!gather) wgid = nwg - 1 - wgid;
        int e = 0;
#pragma unroll
        for (int j = 1; j < 8; ++j) if (wgid >= tb[j] * nN) e = j;
        const int tbase = tb[e], nM = tb[e + 1] - tbase, local = wgid - tbase * nN;
        const int nig = WGM * nN, gid = local / nig, fm = gid * WGM, gsz = (nM - fm) < WGM ? (nM - fm) : WGM;
        u.mt = fm + ((local % nig) % gsz); u.pn = (local % nig) / gsz; u.e = e; u.pm = tbase + u.mt; return true;
    }
    __device__ __forceinline__ const char* a_tile(const Unit& u) const { return gather ? (const char*)A : (const char*)A + (size_t)u.pm * BM * lda * 2; }
    __device__ __forceinline__ const char* b_tile(const Unit& u) const { return (const char*)Bt + ((size_t)u.e * bstride + (size_t)u.pn * BM * K) * 2; }
    __device__ __forceinline__ int row_tok(const Unit& u, int r) const { const int idx = u.mt * BM + r; const int cnt = tb[16 + u.e]; return idx < cnt ? (list[(size_t)u.e * T + idx].x & 0x3fffffff) : 0; }
    __device__ __forceinline__ const int* row_ptr(int e, int mt, int r) const { return &list[(size_t)e * T + mt * BM + r].x; }
    __device__ __forceinline__ int row_fix(int e, int mt, int r, int raw) const { return (mt * BM + r) < tb[16 + e] ? (raw & 0x3fffffff) : 0; }
};

struct EpiBf16 {
    static constexpr bool PERM = true;
    static constexpr int NSTORE = 0;
    bf16* O; int ldc; int split_cols; size_t split_stride; float scale0;
    unsigned* nmax;
    __device__ __forceinline__ void operator()(const f32x4 (&acc)[2][2][4][2], const Unit& u, int wr, int wc, int fr, int fq) const {
        const int row0 = u.pm * BM + wr * 64 + fr; int colt = u.pn * BM; bf16* base = O;
        float sc = 1.f; int t = 0; if (split_cols) { t = colt / split_cols; base += (size_t)t * split_stride; colt -= t * split_cols; if (t == 0) sc = scale0; }
        const int col0 = colt + wc * 32 + 8 * fq;
        const bool track = (nmax != nullptr) && (t == 0);
        float mx[2] = {0.f, 0.f};
#pragma unroll
        for (int ai = 0; ai < 2; ++ai)
#pragma unroll
            for (int m = 0; m < 4; ++m) { bf16* rowp = base + (size_t)(row0 + ai * HALF + m * 16) * ldc + col0;
#pragma unroll
                for (int bj = 0; bj < 2; ++bj) { const f32x4 v0 = acc[ai][bj][m][0] * sc, v1 = acc[ai][bj][m][1] * sc;
                    v4u w; w.x = cvt_pk_bf16(v0[0], v0[1]); w.y = cvt_pk_bf16(v0[2], v0[3]); w.z = cvt_pk_bf16(v1[0], v1[1]); w.w = cvt_pk_bf16(v1[2], v1[3]);
                    *(v4u*)(rowp + bj * HALF) = w;
                    if (track) { float s = 0.f;
#pragma unroll
                        for (int q = 0; q < 4; ++q) { const float a = bf_lo(w[q]), b = bf_hi(w[q]); s += a * a + b * b; }
                        s += __shfl_xor(s, 16); s += __shfl_xor(s, 32); mx[bj] = fmaxf(mx[bj], s); } } }
        if (track) {
#pragma unroll
            for (int bj = 0; bj < 2; ++bj) { float v = mx[bj];
#pragma unroll
                for (int o = 1; o < 16; o <<= 1) v = fmaxf(v, __shfl_xor(v, o));
                if (fr == 0 && fq == 0) { const int head = colt / 64 + 2 * bj + (wc >> 1), bb = (u.pm * BM) / SEQ;
                    __hip_atomic_fetch_max(nmax + ((bb * 16 + head) * 2 + (wc & 1)), __float_as_uint(v), __ATOMIC_RELAXED, __HIP_MEMORY_SCOPE_AGENT); } }
        }
    }
};
struct EpiI8Bf16 {
    static constexpr bool PERM = true;
    static constexpr int NSTORE = 0;
    bf16* O; int ldc; int coloff; float ascale;
    __device__ __forceinline__ void operator()(const f32x4 (&acc)[2][2][4][2], const Unit& u, int wr, int wc, int fr, int fq) const {
        const int row0 = u.pm * BM + wr * 64 + fr, col0 = coloff + u.pn * BM + wc * 32 + 8 * fq;
#pragma unroll
        for (int ai = 0; ai < 2; ++ai)
#pragma unroll
            for (int m = 0; m < 4; ++m) { bf16* rowp = O + (size_t)(row0 + ai * HALF + m * 16) * ldc + col0;
#pragma unroll
                for (int bj = 0; bj < 2; ++bj) { const f32x4 a0 = acc[ai][bj][m][0], a1 = acc[ai][bj][m][1];
                    v4u w; w.x = cvt_pk_bf16(acc_i2f(a0[0]) * ascale, acc_i2f(a0[1]) * ascale); w.y = cvt_pk_bf16(acc_i2f(a0[2]) * ascale, acc_i2f(a0[3]) * ascale);
                    w.z = cvt_pk_bf16(acc_i2f(a1[0]) * ascale, acc_i2f(a1[1]) * ascale); w.w = cvt_pk_bf16(acc_i2f(a1[2]) * ascale, acc_i2f(a1[3]) * ascale);
                    *(v4u*)(rowp + bj * HALF) = w; } }
    }
};
struct EpiRetIn {
    static constexpr bool PERM = true;
    static constexpr int NSTORE = 0;
    bf16* O; const f32x2* rope;
    __device__ __forceinline__ void operator()(const f32x4 (&acc)[2][2][4][2], const Unit& u, int wr, int wc, int fr, int fq) const {
        const int row0 = u.pm * BM + wr * 64 + fr; const int col0 = u.pn * BM + wc * 32 + 8 * fq;
        const bool rot = u.pn < 8; const float ksc = (u.pn >= 4 && u.pn < 8) ? 0.0625f : 1.0f;
#pragma unroll
        for (int ai = 0; ai < 2; ++ai)
#pragma unroll
            for (int m = 0; m < 4; ++m) { const int row = row0 + ai * HALF + m * 16; bf16* rowp = O + (size_t)row * PROJW + col0;
                f32x4 a0 = acc[ai][0][m][0], a1 = acc[ai][0][m][1], b0 = acc[ai][1][m][0], b1 = acc[ai][1][m][1];
                if (rot) { const f32x4* rp = (const f32x4*)(rope + (size_t)(row & (SEQ - 1)) * 128 + wc * 32 + 8 * fq);
                    const f32x4 r0 = rp[0], r1 = rp[1], r2 = rp[2], r3 = rp[3];
                    f32x4 x, y;
                    x = a0; y = b0; a0 = (f32x4){x[0] * r0[0] - y[0] * r0[1], x[1] * r0[2] - y[1] * r0[3], x[2] * r1[0] - y[2] * r1[1], x[3] * r1[2] - y[3] * r1[3]};
                                    b0 = (f32x4){y[0] * r0[0] + x[0] * r0[1], y[1] * r0[2] + x[1] * r0[3], y[2] * r1[0] + x[2] * r1[1], y[3] * r1[2] + x[3] * r1[3]};
                    x = a1; y = b1; a1 = (f32x4){x[0] * r2[0] - y[0] * r2[1], x[1] * r2[2] - y[1] * r2[3], x[2] * r3[0] - y[2] * r3[1], x[3] * r3[2] - y[3] * r3[3]};
                                    b1 = (f32x4){y[0] * r2[0] + x[0] * r2[1], y[1] * r2[2] + x[1] * r2[3], y[2] * r3[0] + x[2] * r3[1], y[3] * r3[2] + x[3] * r3[3]};
                    a0 = a0 * ksc; a1 = a1 * ksc; b0 = b0 * ksc; b1 = b1 * ksc; }
                v4u w; w.x = cvt_pk_bf16(a0[0], a0[1]); w.y = cvt_pk_bf16(a0[2], a0[3]); w.z = cvt_pk_bf16(a1[0], a1[1]); w.w = cvt_pk_bf16(a1[2], a1[3]);
                *(v4u*)(rowp) = w;
                w.x = cvt_pk_bf16(b0[0], b0[1]); w.y = cvt_pk_bf16(b0[2], b0[3]); w.z = cvt_pk_bf16(b1[0], b1[1]); w.w = cvt_pk_bf16(b1[2], b1[3]);
                *(v4u*)(rowp + HALF) = w; }
    }
};
template <bool BASE_BF> struct EpiResidT {
    static constexpr bool PERM = true;
    static constexpr int NSTORE = 0;
    const void* base; bf16* out; const float* gates; int gstride; float ascale = 1.0f; bool i8 = false;
    __device__ __forceinline__ void operator()(const f32x4 (&acc)[2][2][4][2], const Unit& u, int wr, int wc, int fr, int fq) const {
        const int row0 = u.pm * BM + wr * 64 + fr, col0 = u.pn * BM + wc * 32 + 8 * fq;
        const float* gp = gates + (size_t)((u.pm * BM) / SEQ) * gstride + col0;
        f32x4 gv[2][2];
#pragma unroll
        for (int bj = 0; bj < 2; ++bj)
#pragma unroll
            for (int n = 0; n < 2; ++n) gv[bj][n] = *(const f32x4*)(gp + bj * HALF + n * 4) * ascale;
#pragma unroll
        for (int ai = 0; ai < 2; ++ai)
#pragma unroll
            for (int m = 0; m < 4; ++m) { const size_t off = (size_t)(row0 + ai * HALF + m * 16) * D + col0;
#pragma unroll
                for (int bj = 0; bj < 2; ++bj) { f32x4 a0 = acc[ai][bj][m][0], a1 = acc[ai][bj][m][1];
                    if (i8) { a0 = (f32x4){acc_i2f(a0[0]), acc_i2f(a0[1]), acc_i2f(a0[2]), acc_i2f(a0[3])}; a1 = (f32x4){acc_i2f(a1[0]), acc_i2f(a1[1]), acc_i2f(a1[2]), acc_i2f(a1[3])}; }
                    f32x4 b0, b1;
                    if constexpr (BASE_BF) { const v4u w = *(const v4u*)((const bf16*)base + off + bj * HALF); b0 = (f32x4){bf_lo(w.x), bf_hi(w.x), bf_lo(w.y), bf_hi(w.y)}; b1 = (f32x4){bf_lo(w.z), bf_hi(w.z), bf_lo(w.w), bf_hi(w.w)}; }
                    else { b0 = *(const f32x4*)((const float*)base + off + bj * HALF); b1 = *(const f32x4*)((const float*)base + off + bj * HALF + 4); }
                    const f32x4 o0 = b0 + gv[bj][0] * a0, o1 = b1 + gv[bj][1] * a1;
                    v4u w; w.x = cvt_pk_bf16(o0[0], o0[1]); w.y = cvt_pk_bf16(o0[2], o0[3]); w.z = cvt_pk_bf16(o1[0], o1[1]); w.w = cvt_pk_bf16(o1[2], o1[3]);
                    *(v4u*)(out + off + bj * HALF) = w; } }
    }
};
__device__ __forceinline__ unsigned pk4_fp8(float a, float b, float c, float d) {
    const float M = 12582912.0f;
    const unsigned ua = __float_as_uint(__builtin_amdgcn_fmed3f(a, -127.f, 127.f) + M), ub = __float_as_uint(__builtin_amdgcn_fmed3f(b, -127.f, 127.f) + M);
    const unsigned uc = __float_as_uint(__builtin_amdgcn_fmed3f(c, -127.f, 127.f) + M), ud = __float_as_uint(__builtin_amdgcn_fmed3f(d, -127.f, 127.f) + M);
    const unsigned lo = __builtin_amdgcn_perm(ub, ua, 0x0c0c0400u), hi = __builtin_amdgcn_perm(ud, uc, 0x04000c0cu);
    return lo | hi;
}
__device__ __forceinline__ float clamp8(float x) { return x; }
__device__ __forceinline__ float acc_i2f(float bits) { return (float)__builtin_bit_cast(int, bits); }
template <bool OUT8> struct EpiSwigluT {
    static constexpr bool PERM = true;
    static constexpr int NSTORE = 16;
    bf16* O; int ldc; float ascale; float oscale;
    __device__ __forceinline__ void operator()(const f32x4 (&acc)[2][2][4][2], const Unit& u, int wr, int wc, int fr, int fq) const {
        const int row0 = u.pm * BM + wr * 64 + fr, col0 = u.pn * HALF + wc * 32 + 8 * fq;
#pragma unroll
        for (int ai = 0; ai < 2; ++ai)
#pragma unroll
            for (int m = 0; m < 4; ++m) {
                float h[8];
#pragma unroll
                for (int n = 0; n < 2; ++n)
#pragma unroll
                    for (int i = 0; i < 4; ++i) { const float gv_ = OUT8 ? acc_i2f(acc[ai][0][m][n][i]) : acc[ai][0][m][n][i], uv_ = OUT8 ? acc_i2f(acc[ai][1][m][n][i]) : acc[ai][1][m][n][i];
                        const float e_ = __builtin_amdgcn_exp2f(gv_ * (-ascale * LOG2E));
                        h[n * 4 + i] = (gv_ * uv_) * (__builtin_amdgcn_rcpf(1.0f + e_) * (ascale * ascale * oscale)); }
                if (OUT8) { unsigned char* rowp = (unsigned char*)O + (size_t)(row0 + ai * HALF + m * 16) * ldc + col0;
                    v2u w; w.x = pk4_fp8(clamp8(h[0]), clamp8(h[1]), clamp8(h[2]), clamp8(h[3])); w.y = pk4_fp8(clamp8(h[4]), clamp8(h[5]), clamp8(h[6]), clamp8(h[7])); *(v2u*)rowp = w; }
                else { bf16* rowp = O + (size_t)(row0 + ai * HALF + m * 16) * ldc + col0;
                    v4u w; w.x = cvt_pk_bf16(h[0], h[1]); w.y = cvt_pk_bf16(h[2], h[3]); w.z = cvt_pk_bf16(h[4], h[5]); w.w = cvt_pk_bf16(h[6], h[7]); *(v4u*)(rowp) = w; } }
    }
};
struct EpiMoeDown {
    static constexpr bool PERM = true;
    static constexpr int NSTORE = 0;
    bf16* H; bf16* Y1; const float* gates; int gstride; const int2* list; const LAS int* tb; float ascale;
    __device__ __forceinline__ void operator()(const f32x4 (&acc)[2][2][4][2], const Unit& u, int wr, int wc, int fr, int fq) const {
        const int col0 = u.pn * BM + wc * 32 + 8 * fq; const int cnt = tb[16 + u.e];
#pragma unroll
        for (int ai = 0; ai < 2; ++ai)
#pragma unroll
            for (int m = 0; m < 4; ++m) { const int idx = u.mt * BM + ai * HALF + wr * 64 + m * 16 + fr;
                if (idx < cnt) { const int2 tw = list[(size_t)u.e * T + idx]; const float w = __int_as_float(tw.y) * ascale; const int tok = tw.x & 0x3fffffff;
                    const float* gp = gates + (size_t)(tok / SEQ) * gstride + col0;
                    bf16* dp = ((tw.x >> 30) == 0 ? H : Y1) + (size_t)tok * D + col0; const bool rmw = (tw.x >> 30) == 0;
#pragma unroll
                    for (int bj = 0; bj < 2; ++bj) { const f32x4 g0 = *(const f32x4*)(gp + bj * HALF) * w, g1 = *(const f32x4*)(gp + bj * HALF + 4) * w;
                        const f32x4 a0 = (f32x4){acc_i2f(acc[ai][bj][m][0][0]), acc_i2f(acc[ai][bj][m][0][1]), acc_i2f(acc[ai][bj][m][0][2]), acc_i2f(acc[ai][bj][m][0][3])};
                        const f32x4 a1 = (f32x4){acc_i2f(acc[ai][bj][m][1][0]), acc_i2f(acc[ai][bj][m][1][1]), acc_i2f(acc[ai][bj][m][1][2]), acc_i2f(acc[ai][bj][m][1][3])};
                        f32x4 o0 = g0 * a0, o1 = g1 * a1;
                        if (rmw) { const v4u hw = *(const v4u*)(dp + bj * HALF);
                            o0 = o0 + (f32x4){bf_lo(hw.x), bf_hi(hw.x), bf_lo(hw.y), bf_hi(hw.y)}; o1 = o1 + (f32x4){bf_lo(hw.z), bf_hi(hw.z), bf_lo(hw.w), bf_hi(hw.w)}; }
                        v4u ow; ow.x = cvt_pk_bf16(o0[0], o0[1]); ow.y = cvt_pk_bf16(o0[2], o0[3]); ow.z = cvt_pk_bf16(o1[0], o1[1]); ow.w = cvt_pk_bf16(o1[2], o1[3]);
                        *(v4u*)(dp + bj * HALF) = ow; } } }
    }
};

template <class Epi, class Sched, bool GATHER, bool FP8 = false>
__device__ __forceinline__ void gemm_phase(LAS unsigned char* lds, const Sched& S, const Epi& E, const int tid) {
    const int wid = __builtin_amdgcn_readfirstlane(tid >> 6), lane = tid & 63, wr = wid >> 2, wc = wid & 3, fr = lane & 15, fq = lane >> 4;
    const int K = S.K, lda = S.lda, nt = K / BK;
    int RA[2], CA[2]; unsigned voffB[2];
#pragma unroll
    for (int i = 0; i < 2; ++i) { int R, C; stage_rc(tid * 16 + i * 8192, R, C); const int Rb = Epi::PERM ? ((R & ~31) + perm32(R & 31)) : R;
        RA[i] = R; CA[i] = C; voffB[i] = (unsigned)(Rb * K + C) * 2u; }
    const size_t kstep = (size_t)(BK * 2);
    const size_t hstepB = (size_t)HALF * K * 2;
    const unsigned ldsw = (unsigned)wid * 1024u;
    const int aoff = lds_byte(wr * 64 + fr, fq * 8), boff = lds_byte(wc * 32 + fr, fq * 8);
#define PG8_SA(b, h) (((b) * 2 + (h)) * HTB)
#define PG8_SB(b, h) ((4 + (b) * 2 + (h)) * HTB)
#define PG8_STAGE2(bufoff, gbase, v0, v1) do { \
        __builtin_amdgcn_global_load_lds((const unsigned*)((const char*)(gbase) + (v0)), (LAS unsigned*)(lds + (bufoff) + ldsw), 16, 0, 0); \
        __builtin_amdgcn_global_load_lds((const unsigned*)((const char*)(gbase) + (v1)), (LAS unsigned*)(lds + (bufoff) + ldsw + 8192), 16, 0, 0); } while (0)
#define PG8_STA(b, h, ptr, V) PG8_STAGE2(PG8_SA(b, h), ptr, V[h][0], V[h][1])
#define PG8_STB(b, h, ptr) PG8_STAGE2(PG8_SB(b, h), (ptr) + (h) * hstepB, voffB[0], voffB[1])
    typedef int v4i_ __attribute__((ext_vector_type(4)));
#define PG8_LDA(dst, b, h) do { _Pragma("unroll") for (int m = 0; m < 4; ++m) _Pragma("unroll") for (int k = 0; k < 2; ++k) dst[m][k] = *(const LAS bf16x8*)(lds + PG8_SA(b, h) + aoff + m * 2048 + k * 1024); } while (0)
#define PG8_LDB(dst, b, h) do { _Pragma("unroll") for (int n = 0; n < 2; ++n) _Pragma("unroll") for (int k = 0; k < 2; ++k) dst[n][k] = *(const LAS bf16x8*)(lds + PG8_SB(b, h) + boff + n * 2048 + k * 1024); } while (0)
#define PG8_MMA(ai, bj, At, Bt) do { __builtin_amdgcn_s_setprio(1); _Pragma("unroll") for (int m = 0; m < 4; ++m) _Pragma("unroll") for (int n = 0; n < 2; ++n) _Pragma("unroll") for (int k = 0; k < 2; ++k) { \
        if constexpr (FP8) acc[ai][bj][m][n] = __builtin_bit_cast(f32x4, __builtin_amdgcn_mfma_i32_16x16x64_i8(__builtin_bit_cast(v4i_, Bt[n][k]), __builtin_bit_cast(v4i_, At[m][k]), __builtin_bit_cast(v4i_, acc[ai][bj][m][n]), 0, 0, 0)); \
        else acc[ai][bj][m][n] = __builtin_amdgcn_mfma_f32_16x16x32_bf16(Bt[n][k], At[m][k], acc[ai][bj][m][n], 0, 0, 0); } \
        __builtin_amdgcn_s_setprio(0); } while (0)
#define PG8_WAIT_V(n) asm volatile("s_waitcnt vmcnt(" #n ")" ::: "memory")
#define PG8_WAIT_VN(rx, n) asm volatile("s_cmp_eq_u32 %0, 0\n\ts_cbranch_scc0 1f\n\ts_waitcnt vmcnt(8)\n1:\n\ts_waitcnt vmcnt(%1)" :: "s"(rx), "n"(n) : "memory", "scc")
#define PG8_WAIT_L(n) asm volatile("s_waitcnt lgkmcnt(" #n ")" ::: "memory")
#define PG8_BAR __builtin_amdgcn_s_barrier()
#define PG8_SCHED __builtin_amdgcn_sched_barrier(0)
    constexpr int NX = Epi::NSTORE + (GATHER ? 4 : 0);
    constexpr int IDS_OFF = 8 * HTB;
    const LAS int* idl = (const LAS int*)(lds + IDS_OFF + wid * 1024) + lane;
    Unit cur, nxt; int ui = 0;
    if (!S.next(0, cur)) return;
    unsigned cv[2][2], nv[2][2];
#pragma unroll
    for (int h = 0; h < 2; ++h)
#pragma unroll
        for (int i = 0; i < 2; ++i) { const int rr = RA[i] + HALF * h; cv[h][i] = (unsigned)((GATHER ? S.row_tok(cur, rr) : rr) * lda + CA[i]) * 2u; nv[h][i] = cv[h][i]; }
    if (GATHER) { asm volatile("s_waitcnt vmcnt(0)" : "+v"(cv[0][0]), "+v"(cv[0][1]), "+v"(cv[1][0]), "+v"(cv[1][1]) :: "memory"); }
    f32x4 acc[2][2][4][2];
#pragma unroll
    for (int a = 0; a < 2; ++a)
#pragma unroll
        for (int b = 0; b < 2; ++b)
#pragma unroll
            for (int m = 0; m < 4; ++m)
#pragma unroll
                for (int n = 0; n < 2; ++n) acc[a][b][m][n] = (f32x4){0.f, 0.f, 0.f, 0.f};
    bf16x8 At[4][2], B0[2][2], B1[2][2];
    const char* cA = S.a_tile(cur); const char* cB = S.b_tile(cur);
    PG8_STB(0, 0, cB); PG8_STB(0, 1, cB); PG8_STA(0, 0, cA, cv); PG8_STA(0, 1, cA, cv);
    if (wr == 1) PG8_BAR;
    PG8_WAIT_V(2); PG8_BAR;
    PG8_STB(1, 0, cB + kstep); PG8_STA(1, 0, cA + kstep, cv); PG8_STB(1, 1, cB + kstep);
    PG8_WAIT_V(6); PG8_BAR;
    for (;;) {
        const bool has_next = S.next(ui + 1, nxt);
        const char* nA = has_next ? S.a_tile(nxt) : cA; const char* nB = has_next ? S.b_tile(nxt) : cB;
        const int ie = has_next ? nxt.e : cur.e, imt = has_next ? nxt.mt : cur.mt;
        if (GATHER) {
#pragma unroll
            for (int h = 0; h < 2; ++h)
#pragma unroll
                for (int i = 0; i < 2; ++i) __builtin_amdgcn_global_load_lds((const unsigned*)S.row_ptr(ie, imt, RA[i] + HALF * h), (LAS unsigned*)(lds + IDS_OFF + wid * 1024 + (h * 2 + i) * 256), 4, 0, 0);
        }
        for (int t = 0; t < nt; t += 2) {
            const bool last = (t == nt - 2);
            const char* a1 = cA + (size_t)(t + 1) * kstep;
            const char* a2 = last ? nA : cA + (size_t)(t + 2) * kstep; const char* b2 = last ? nB : cB + (size_t)(t + 2) * kstep;
            const char* a3 = a2 + kstep; const char* b3 = b2 + kstep;
            if (GATHER) { if (last) {
#pragma unroll
                for (int h = 0; h < 2; ++h)
#pragma unroll
                    for (int i = 0; i < 2; ++i) nv[h][i] = (unsigned)(S.row_fix(ie, imt, RA[i] + HALF * h, idl[(h * 2 + i) * 64]) * lda + CA[i]) * 2u; } }
            const int relax = __builtin_amdgcn_readfirstlane(((NX > 0) && (t == 0) && (ui > 0)) ? 1 : 0);
            unsigned v2[2][2];
#pragma unroll
            for (int h = 0; h < 2; ++h)
#pragma unroll
                for (int i = 0; i < 2; ++i) v2[h][i] = GATHER ? (last ? nv[h][i] : cv[h][i]) : cv[h][i];
            PG8_LDB(B0, 0, 0); PG8_LDB(B1, 0, 1); PG8_SCHED; PG8_LDA(At, 0, 0); PG8_STA(1, 1, a1, cv);
            if constexpr (NX > 0) PG8_WAIT_VN(relax, 8 + NX); else PG8_WAIT_V(8);
            PG8_WAIT_L(0); PG8_BAR; PG8_MMA(0, 0, At, B0); PG8_MMA(0, 1, At, B1); PG8_BAR; PG8_SCHED;
            PG8_LDA(At, 0, 1); PG8_STB(0, 0, b2); PG8_STB(0, 1, b2); PG8_STA(0, 0, a2, v2);
            if constexpr (NX > 0) PG8_WAIT_VN(relax, 8 + NX); else PG8_WAIT_V(8);
            PG8_WAIT_L(0); PG8_BAR; PG8_MMA(1, 0, At, B0); PG8_MMA(1, 1, At, B1); PG8_BAR; PG8_SCHED;
            PG8_LDB(B0, 1, 0); PG8_LDB(B1, 1, 1); PG8_SCHED; PG8_LDA(At, 1, 0); PG8_STA(0, 1, a2, v2);
            PG8_WAIT_V(8); PG8_WAIT_L(0); PG8_BAR; PG8_MMA(0, 0, At, B0); PG8_MMA(0, 1, At, B1); PG8_BAR; PG8_SCHED;
            PG8_LDA(At, 1, 1); PG8_STB(1, 0, b3); PG8_STB(1, 1, b3); PG8_STA(1, 0, a3, v2);
            PG8_WAIT_V(8); PG8_WAIT_L(0); PG8_BAR; PG8_MMA(1, 0, At, B0); PG8_MMA(1, 1, At, B1); PG8_BAR; PG8_SCHED;
        }
        if (wr == 0) PG8_BAR;
        E(acc, cur, wr, wc, fr, fq);
        if (!has_next) break;
#pragma unroll
        for (int a = 0; a < 2; ++a)
#pragma unroll
            for (int b = 0; b < 2; ++b)
#pragma unroll
                for (int m = 0; m < 4; ++m)
#pragma unroll
                    for (int n = 0; n < 2; ++n) acc[a][b][m][n] = (f32x4){0.f, 0.f, 0.f, 0.f};
        cur = nxt; cA = nA; cB = nB; ++ui;
#pragma unroll
        for (int h = 0; h < 2; ++h)
#pragma unroll
            for (int i = 0; i < 2; ++i) cv[h][i] = nv[h][i];
        if (wr == 1) PG8_BAR;
    }
    PG8_WAIT_V(0);
    PG8_BAR;
#undef PG8_WAIT_VN
#undef PG8_SA
#undef PG8_SB
#undef PG8_STAGE2
#undef PG8_STA
#undef PG8_STB
#undef PG8_LDA
#undef PG8_LDB
#undef PG8_MMA
#undef PG8_WAIT_V
#undef PG8_WAIT_L
#undef PG8_BAR
#undef PG8_SCHED
}
}

namespace attn_body {
using hbf16 = __hip_bfloat16;
using f32x16 = __attribute__((ext_vector_type(16))) float;
using u32x4 = __attribute__((ext_vector_type(4))) unsigned;
constexpr int NHEAD = FH, DH = 64, DM = NHEAD * DH;
constexpr int NW = 8, QBLK = 32, QB = QBLK * NW, KVBLK = 64, NQB = SEQ / QB;
__device__ __forceinline__ int crow(int r, int hi) { return (r & 3) + 8 * (r >> 2) + 4 * hi; }
#define SBAR() __builtin_amdgcn_sched_barrier(0)
__device__ __forceinline__ void cmask(f32x16& p0, f32x16& p1, int jb, int qrel, int hi) {
  const float NEG = -INFINITY; int kb = 64 * jb + 4 * hi;
  #pragma unroll
  for (int r = 0; r < 16; ++r) { int kv = kb + (r & 3) + 8 * (r >> 2); if (kv > qrel) p0[r] = NEG; if (kv + 32 > qrel) p1[r] = NEG; }
}
constexpr int NSLOT = 3, SLOTB = 8192;
constexpr int LDS_K = 0, LDS_V = NSLOT * SLOTB, LDS_WS = 2 * NSLOT * SLOTB, LDS_OST = LDS_WS + NW * 64 * 4, LDS_BIAS = LDS_OST + NW * 4096, LDS_BYTES = LDS_BIAS + SEQ * 4;
__device__ __forceinline__ void glds16(const void* gsrc, unsigned lds_dst) { unsigned keep;
  asm volatile("s_mov_b32 %0, m0\n\ts_mov_b32 m0, %2\n\ts_nop 0\n\tglobal_load_lds_dwordx4 %1, off\n\ts_mov_b32 m0, %0" : "=&s"(keep) : "v"(gsrc), "s"(lds_dst) : "memory"); }
__device__ __forceinline__ float max3f(float a, float b, float c) { float r; asm("v_max3_f32 %0, %1, %2, %3" : "=v"(r) : "v"(a), "v"(b), "v"(c)); return r; }
__device__ __forceinline__ float max2f(float a, float b) { float r; asm("v_max_f32_e32 %0, %1, %2" : "=v"(r) : "v"(a), "v"(b)); return r; }
__device__ __forceinline__ float fadd_s(float a, float b) { float r; asm("v_add_f32_e32 %0, %1, %2" : "=v"(r) : "v"(a), "v"(b)); return r; }
__device__ __forceinline__ float fsub_s(float a, float b) { float r; asm("v_sub_f32_e32 %0, %1, %2" : "=v"(r) : "v"(a), "v"(b)); return r; }
typedef float f32x2_t __attribute__((ext_vector_type(2))); typedef __bf16 bf16x2_t __attribute__((ext_vector_type(2)));
__device__ __forceinline__ unsigned cvtpk_s(float lo, float hi) { f32x2_t v = {lo, hi}; bf16x2_t b = __builtin_convertvector(v, bf16x2_t); return __builtin_bit_cast(unsigned, b); }
#define WAIT_BAR(N) asm volatile("s_waitcnt vmcnt(" #N ") lgkmcnt(0)\n\ts_barrier" ::: "memory")

__device__ __forceinline__ void qkt(f32x16& p0, f32x16& p1, const char* Kslot, const bf16x8* qr, int r32, int hi) { const f32x16 zero16 = f32x16{};
  const char* kb = Kslot + hi * 1024 + r32 * 16;
  #pragma unroll
  for (int d0 = 0; d0 < 4; ++d0) {
    const bf16x8 b0 = *reinterpret_cast<const bf16x8*>(kb + d0 * 2048);
    const bf16x8 b1 = *reinterpret_cast<const bf16x8*>(kb + d0 * 2048 + 512);
    if (d0 == 0) { p0 = __builtin_amdgcn_mfma_f32_32x32x16_bf16(b0, qr[0], zero16, 0, 0, 0); p1 = __builtin_amdgcn_mfma_f32_32x32x16_bf16(b1, qr[0], zero16, 0, 0, 0); }
    else { p0 = __builtin_amdgcn_mfma_f32_32x32x16_bf16(b0, qr[d0], p0, 0, 0, 0); p1 = __builtin_amdgcn_mfma_f32_32x32x16_bf16(b1, qr[d0], p1, 0, 0, 0); } }
}
typedef __attribute__((address_space(3))) const char* lds_cptr;
typedef short v4i16_t __attribute__((ext_vector_type(4)));
__device__ __forceinline__ void kload8(bf16x8* kf, lds_cptr kp) {
  kf[0] = *(const LAS bf16x8*)(kp);        kf[1] = *(const LAS bf16x8*)(kp + 512);
  kf[2] = *(const LAS bf16x8*)(kp + 2048); kf[3] = *(const LAS bf16x8*)(kp + 2560);
  kf[4] = *(const LAS bf16x8*)(kp + 4096); kf[5] = *(const LAS bf16x8*)(kp + 4608);
  kf[6] = *(const LAS bf16x8*)(kp + 6144); kf[7] = *(const LAS bf16x8*)(kp + 6656);
}
__device__ __forceinline__ void kload2(bf16x8* kf, lds_cptr kp, int j) { kf[2 * j] = *(const LAS bf16x8*)(kp + j * 2048); kf[2 * j + 1] = *(const LAS bf16x8*)(kp + j * 2048 + 512); }
__device__ __forceinline__ s16x4 vtr(lds_cptr p) { return __builtin_bit_cast(s16x4, __builtin_amdgcn_ds_read_tr16_b64_v4i16((LAS v4i16_t*)p)); }
__device__ __forceinline__ float rowmax(const f32x16& p0, const f32x16& p1) {
  float a = max3f(p0[0], p0[1], p1[0]), b = max3f(p0[2], p0[3], p1[1]); a = max3f(a, p1[2], p1[3]);
  #pragma unroll
  for (int r = 4; r < 16; r += 4) { a = max3f(a, p0[r], p0[r + 1]); b = max3f(b, p0[r + 2], p0[r + 3]); a = max3f(a, p1[r], p1[r + 1]); b = max3f(b, p1[r + 2], p1[r + 3]); }
  const float m = max2f(a, b);
  auto rr = __builtin_amdgcn_permlane32_swap(__float_as_uint(m), __float_as_uint(m), false, false);
  return max2f(__uint_as_float(rr[0]), __uint_as_float(rr[1]));
}
__device__ __forceinline__ void pv(f32x16* o, int vb, bf16x8 pa0, bf16x8 pa1, bf16x8 pa2, bf16x8 pa3) {
  #pragma unroll
  for (int d0 = 0; d0 < 2; ++d0) { s16x4 lo[4], hi[4];
    #pragma unroll
    for (int ks = 0; ks < 4; ++ks) {
      asm volatile("ds_read_b64_tr_b16 %0,%1 offset:%c2" : "=&v"(lo[ks]) : "v"(vb), "i"(d0 * 4096 + ks * 1024) : "memory");
      asm volatile("ds_read_b64_tr_b16 %0,%1 offset:%c2" : "=&v"(hi[ks]) : "v"(vb), "i"(d0 * 4096 + ks * 1024 + 512) : "memory"); }
    asm volatile("s_waitcnt lgkmcnt(0)" ::: "memory"); SBAR();
    #define PK(k) (bf16x8){lo[k][0], lo[k][1], lo[k][2], lo[k][3], hi[k][0], hi[k][1], hi[k][2], hi[k][3]}
    o[d0] = __builtin_amdgcn_mfma_f32_32x32x16_bf16(pa0, PK(0), o[d0], 0, 0, 0);
    o[d0] = __builtin_amdgcn_mfma_f32_32x32x16_bf16(pa1, PK(1), o[d0], 0, 0, 0);
    o[d0] = __builtin_amdgcn_mfma_f32_32x32x16_bf16(pa2, PK(2), o[d0], 0, 0, 0);
    o[d0] = __builtin_amdgcn_mfma_f32_32x32x16_bf16(pa3, PK(3), o[d0], 0, 0, 0);
    #undef PK
  }
}
#define ADDBIAS(P0, P1, t) do { const LAS f32x4* bp_ = (const LAS f32x4*)((const LAS float*)((LAS char*)shm + LDS_BIAS) + (SEQ - 64 * ((t) + 1)) + 4 * hi); const float nm_ = -mhat; \
    _Pragma("unroll") for (int k_ = 0; k_ < 4; ++k_) { const f32x4 b0_ = bp_[2 * k_] + nm_, b1_ = bp_[8 + 2 * k_] + nm_; \
      P0[4 * k_] += b0_[0]; P0[4 * k_ + 1] += b0_[1]; P0[4 * k_ + 2] += b0_[2]; P0[4 * k_ + 3] += b0_[3]; \
      P1[4 * k_] += b1_[0]; P1[4 * k_ + 1] += b1_[1]; P1[4 * k_ + 2] += b1_[2]; P1[4 * k_ + 3] += b1_[3]; SBAR(); } } while (0)

#define LDBIAS(X0, X1, tt, k_) do { const LAS f32x4* bp_ = (const LAS f32x4*)((const LAS float*)((LAS char*)shm + LDS_BIAS) + (SEQ - 64 * ((tt) + 1)) + 4 * hi); const f32x4 b0_ = bp_[2 * (k_)], b1_ = bp_[8 + 2 * (k_)]; \
    X0[4 * (k_)] = b0_[0]; X0[4 * (k_) + 1] = b0_[1]; X0[4 * (k_) + 2] = b0_[2]; X0[4 * (k_) + 3] = b0_[3]; X1[4 * (k_)] = b1_[0]; X1[4 * (k_) + 1] = b1_[1]; X1[4 * (k_) + 2] = b1_[2]; X1[4 * (k_) + 3] = b1_[3]; } while (0)
#define SUBM8(X, B) do { X[B] -= mhat; X[B + 1] -= mhat; X[B + 2] -= mhat; X[B + 3] -= mhat; X[B + 4] -= mhat; X[B + 5] -= mhat; X[B + 6] -= mhat; X[B + 7] -= mhat; } while (0)

template <int THRL> __device__ __forceinline__ void attn_unit(int b, int h, int qb, const hbf16* Q, const hbf16* __restrict__ K, const hbf16* __restrict__ V, const hbf16* __restrict__ Gt, const float* __restrict__ FL, const unsigned* __restrict__ nmx, const int jq, hbf16* O, char* shm, const int tid_in) {
  int tid = tid_in; asm volatile("" : "+v"(tid));
  const int lane = tid & 63, r32 = lane & 31, hi = lane >> 5; const int wid = __builtin_amdgcn_readfirstlane(tid >> 6);
  const long rowbase = (long)b * SEQ; const int q0 = qb * QB;
  const hbf16* Qw = Q + (rowbase + q0 + wid * QBLK) * DM + h * DH;
  const unsigned lds0 = (unsigned)(uintptr_t)shm;
  float* wsf = (float*)(shm + LDS_WS) + wid * 64;
  const int NT0 = (q0 + QB) / KVBLK;
  const hbf16* Kh = K + rowbase * DM + h * DH, *Vh = V + rowbase * DM + h * DH;
  const hbf16* ksrc = Kh + (long)lane * DM + wid * 8;
  const hbf16* vsrc = Vh + (long)(16 * (wid & 3) + (lane >> 2)) * DM + (wid >> 2) * 32 + (lane & 3) * 8;
  const unsigned kdst = lds0 + LDS_K + wid * 1024, vdst = lds0 + LDS_V + wid * 1024;
  #define DMA_K(t, slot) glds16(ksrc + (long)(NT0 - 1 - (t)) * KVBLK * DM, (unsigned)__builtin_amdgcn_readfirstlane(kdst + (slot)))
  #define DMA_V(t, slot) glds16(vsrc + (long)(NT0 - 1 - (t)) * KVBLK * DM, (unsigned)__builtin_amdgcn_readfirstlane(vdst + (slot)))
  const char* Kbase = shm + LDS_K; bf16x8 kf[8];
  const lds_cptr shm3 = (lds_cptr)shm; const lds_cptr kp0 = shm3 + LDS_K + hi * 1024 + r32 * 16; const lds_cptr vp0 = shm3 + LDS_V + ((lane >> 4) & 1) * 32 + (lane & 3) * 8 + (4 * hi + ((lane & 15) >> 2)) * 64;
  DMA_K(0, 0); DMA_V(0, 0); DMA_K(1, SLOTB);
  bf16x8 qr[4];
  #pragma unroll
  for (int d0 = 0; d0 < 4; ++d0) qr[d0] = *reinterpret_cast<const bf16x8*>(&Qw[(long)r32 * DM + d0 * 16 + hi * 8]);
  DMA_K(2, 2 * SLOTB);
  const float* fl = FL + (size_t)(b * NHEAD + h) * SEQ; const float fref = fl[q0];
  int ts; float b2_;
  { const unsigned* nk = nmx + (b * 16 + h) * 2; const unsigned* nq = nmx + 64 * (1 + jq) + (b * 16 + h) * 2;
    const float kb = sqrtf(__uint_as_float(nk[0]) + __uint_as_float(nk[1])), qbn = sqrtf(__uint_as_float(nq[0]) + __uint_as_float(nq[1]));
    b2_ = kb * qbn * 1.001f; const float thr = fref + 2.0f * b2_ + SKIP_LOG2;
    int jstar = NT0 - 4;
    { float v4[4];
      #pragma unroll
      for (int k = 0; k < 4; ++k) { const int jj = 64 * k + lane; v4[k] = (jj < NT0) ? fl[64 * jj + 63] : -INFINITY; }
      #pragma unroll
      for (int k = 3; k >= 0; --k) { const unsigned long long bal = __ballot(v4[k] <= thr); if (bal) jstar = 64 * k + (int)__builtin_ctzll(bal); } }
    ts = jstar & ~1; if (ts > NT0 - 4) ts = NT0 - 4; ts = __builtin_amdgcn_readfirstlane(ts); }
  int NT = NT0 - ts;
  const float b2bound = b2_;
  { LAS float* bw = (LAS float*)((LAS char*)shm + LDS_BIAS) + (SEQ - (q0 + QB));
    for (int i = ts * KVBLK + tid; i < q0 + QB; i += NW * 64) bw[i] = fref - fl[i]; }
  float mhat = 0.f, l_reg = 0.f; f32x16 o[2]; o[0] = f32x16{}; o[1] = f32x16{}; const f32x16 zero16 = f32x16{};
  const int qrel = wid * QBLK + r32;
  #define CMASK(P0, P1, t) do { int jb_ = 3 - (t); if (jb_ >= 0) cmask(P0, P1, jb_, qrel, hi); } while (0)
  bool resc = false;
  #define START(P0, P1) do { const float rm = max2f(rowmax(P0, P1), -64.0f); resc = false; \
    { const float dl = rm; mhat = fadd_s(mhat, dl); \
      _Pragma("unroll") for (int r = 0; r < 16; ++r) { P0[r] = fsub_s(P0[r], dl); P1[r] = fsub_s(P1[r], dl); } \
      } \
    _Pragma("unroll") for (int r = 0; r < 16; ++r) P0[r] = __builtin_amdgcn_exp2f(P0[r]); } while (0)
  #define RESC() do { if (resc) { asm volatile("s_waitcnt lgkmcnt(0)" ::: "memory"); \
      _Pragma("unroll") for (int d_ = 0; d_ < 2; ++d_) _Pragma("unroll") for (int r = 0; r < 16; ++r) o[d_][r] *= wsf[crow(r, hi)]; } } while (0)
  f32x16 pA0, pA1, pB0, pB1;
  int sl_prev = 0, sl_cur = 0, sl_next = SLOTB;
  #define ROT() do { sl_prev = sl_cur; sl_cur = sl_next; sl_next = (sl_next == (NSLOT - 1) * SLOTB) ? 0 : sl_next + SLOTB; } while (0)
  WAIT_BAR(3);
  qkt(pA0, pA1, Kbase, qr, r32, hi); asm volatile("s_nop 15\n\ts_nop 7" : "+v"(pA0), "+v"(pA1)); ADDBIAS(pA0, pA1, 0); CMASK(pA0, pA1, 0);
  START(pA0, pA1);
  _Pragma("unroll") for (int r = 0; r < 16; ++r) pA1[r] = __builtin_amdgcn_exp2f(pA1[r]);
  WAIT_BAR(0);
  DMA_K(3, 0); DMA_V(1, SLOTB);
  ROT();
  kload8(kf, kp0 + sl_cur);
  LDBIAS(pB0, pB1, 1, 0); LDBIAS(pB0, pB1, 1, 1); LDBIAS(pB0, pB1, 1, 2); LDBIAS(pB0, pB1, 1, 3); SUBM8(pB0, 0); SUBM8(pB0, 8); SUBM8(pB1, 0); SUBM8(pB1, 8);
  WAIT_BAR(2);
  s16x4 vlo[8], vhi[8]; u32x4 pw0, pw1, pw2, pw3;
  #define PKW(P, B) cvtpk_s(P[B], P[B + 1])
  #define PAF(k) __builtin_bit_cast(bf16x8, pw##k)
  #define VFR(i) (bf16x8){vlo[i][0], vlo[i][1], vlo[i][2], vlo[i][3], vhi[i][0], vhi[i][1], vhi[i][2], vhi[i][3]}
  #define PIN(x) asm volatile("" : "+v"(x))
  #define MX3(a, b, c) __builtin_fmaxf(__builtin_fmaxf((a), (b)), (c))
  #define GAPA(MF, A0, A1, A2, A3, W0, W1, PW) do { MF; sacc += A0; sacc += A1; sacc += A2; sacc += A3; PIN(sacc); W0; W1; PIN(PW); SBAR(); } while (0)
  #define EX(v) __builtin_amdgcn_exp2f(v)
  #define GAPB(MF, X, B, EXTRA) do { MF; X[B] = EX(X[B]); X[B + 1] = EX(X[B + 1]); X[B + 2] = EX(X[B + 2]); X[B + 3] = EX(X[B + 3]); PIN(X); EXTRA; SBAR(); } while (0)
  #define VRD(i) do { vlo[i] = vtr(vp_ + (((i) >> 2) * 4096 + ((i) & 3) * 1024)); vhi[i] = vtr(vp_ + (((i) >> 2) * 4096 + ((i) & 3) * 1024 + 512)); } while (0)
  #define KRD(G, j) do { if (G) { kload2(kf, kp0 + sl_next, j); SBAR(); } } while (0)
  #define STEP(C0, C1, P0, P1, t, GK, GV, GL) do { SBAR(); \
    const lds_cptr vp_ = vp0 + sl_prev; \
    VRD(0); SBAR(); float sacc = (P0[0] + P0[1]); \
    GAPA(C0 = __builtin_amdgcn_mfma_f32_32x32x16_bf16(kf[0], qr[0], C0, 0, 0, 0), P0[2], P0[3], P0[4], P0[5],     pw0[0] = PKW(P0, 0), pw0[1] = PKW(P0, 2), pw0); \
    VRD(4); SBAR(); GAPA(C1 = __builtin_amdgcn_mfma_f32_32x32x16_bf16(kf[1], qr[0], C1, 0, 0, 0), P0[6], P0[7], P0[8], P0[9],     pw0[2] = PKW(P0, 4), pw0[3] = PKW(P0, 6), pw0); \
    VRD(1); SBAR(); GAPA(C0 = __builtin_amdgcn_mfma_f32_32x32x16_bf16(kf[2], qr[1], C0, 0, 0, 0),   P0[10], P0[11], P0[12], P0[13], pw1[0] = PKW(P0, 8), pw1[1] = PKW(P0, 10), pw1); \
    VRD(5); SBAR(); GAPA(C1 = __builtin_amdgcn_mfma_f32_32x32x16_bf16(kf[3], qr[1], C1, 0, 0, 0),   P0[14], P0[15], P1[0], P1[1],   pw1[2] = PKW(P0, 12), pw1[3] = PKW(P0, 14), pw1); \
    VRD(2); SBAR(); GAPA(C0 = __builtin_amdgcn_mfma_f32_32x32x16_bf16(kf[4], qr[2], C0, 0, 0, 0),   P1[2], P1[3], P1[4], P1[5],     pw2[0] = PKW(P1, 0), pw2[1] = PKW(P1, 2), pw2); \
    VRD(6); SBAR(); GAPA(C1 = __builtin_amdgcn_mfma_f32_32x32x16_bf16(kf[5], qr[2], C1, 0, 0, 0),   P1[6], P1[7], P1[8], P1[9],     pw2[2] = PKW(P1, 4), pw2[3] = PKW(P1, 6), pw2); \
    VRD(3); SBAR(); GAPA(C0 = __builtin_amdgcn_mfma_f32_32x32x16_bf16(kf[6], qr[3], C0, 0, 0, 0),   P1[10], P1[11], P1[12], P1[13], pw3[0] = PKW(P1, 8), pw3[1] = PKW(P1, 10), pw3); \
    VRD(7); SBAR(); GAPA(C1 = __builtin_amdgcn_mfma_f32_32x32x16_bf16(kf[7], qr[3], C1, 0, 0, 0),   P1[14], P1[15], 0.f, 0.f,       pw3[2] = PKW(P1, 12), pw3[3] = PKW(P1, 14), pw3); \
    l_reg += sacc; \
    if (GK) { DMA_K((t) + 3, sl_cur); } if (GV) { DMA_V((t) + 1, sl_next); } \
    CMASK(C0, C1, t); \
    { float a = MX3(C0[0], C0[1], C1[0]), b = MX3(C0[2], C0[3], C1[1]); a = MX3(a, C1[2], C1[3]); \
      _Pragma("unroll") for (int r = 4; r < 16; r += 4) { a = MX3(a, C0[r], C0[r + 1]); b = MX3(b, C0[r + 2], C0[r + 3]); a = MX3(a, C1[r], C1[r + 1]); b = MX3(b, C1[r + 2], C1[r + 3]); } \
      float rm = __builtin_fmaxf(a, b); { auto rr = __builtin_amdgcn_permlane32_swap(__float_as_uint(rm), __float_as_uint(rm), false, false); rm = __builtin_fmaxf(__uint_as_float(rr[0]), __uint_as_float(rr[1])); } \
      resc = false; \
      if (__builtin_expect(__any(rm > (float)THRL), 0)) { const float dl = __builtin_fmaxf(rm, 0.f); mhat += dl; \
        _Pragma("unroll") for (int r = 0; r < 16; ++r) { C0[r] -= dl; C1[r] -= dl; } \
        const float f = __builtin_amdgcn_exp2f(-dl); l_reg *= f; if (hi == 0) wsf[r32] = f; resc = true; } } \
    SBAR(); \
    GAPB(o[0] = __builtin_amdgcn_mfma_f32_32x32x16_bf16(PAF(0), VFR(0), o[0], 0, 0, 0), C0, 0, if (GL) LDBIAS(P0, P1, (t) + 1, 0)); \
    GAPB(o[1] = __builtin_amdgcn_mfma_f32_32x32x16_bf16(PAF(0), VFR(4), o[1], 0, 0, 0), C0, 4, if (GL) LDBIAS(P0, P1, (t) + 1, 1)); \
    KRD(GL, 0); GAPB(o[0] = __builtin_amdgcn_mfma_f32_32x32x16_bf16(PAF(1), VFR(1), o[0], 0, 0, 0), C0, 8, if (GL) LDBIAS(P0, P1, (t) + 1, 2)); \
    KRD(GL, 1); GAPB(o[1] = __builtin_amdgcn_mfma_f32_32x32x16_bf16(PAF(1), VFR(5), o[1], 0, 0, 0), C0, 12, if (GL) LDBIAS(P0, P1, (t) + 1, 3)); \
    KRD(GL, 2); GAPB(o[0] = __builtin_amdgcn_mfma_f32_32x32x16_bf16(PAF(2), VFR(2), o[0], 0, 0, 0), C1, 0, if (GL) SUBM8(P0, 0)); \
    KRD(GL, 3); GAPB(o[1] = __builtin_amdgcn_mfma_f32_32x32x16_bf16(PAF(2), VFR(6), o[1], 0, 0, 0), C1, 4, if (GL) SUBM8(P0, 8)); \
    GAPB(o[0] = __builtin_amdgcn_mfma_f32_32x32x16_bf16(PAF(3), VFR(3), o[0], 0, 0, 0), C1, 8, if (GL) SUBM8(P1, 0)); \
    GAPB(o[1] = __builtin_amdgcn_mfma_f32_32x32x16_bf16(PAF(3), VFR(7), o[1], 0, 0, 0), C1, 12, if (GL) SUBM8(P1, 8)); \
    } while (0)
  int t = 1;
  #define ENDW(tt) do { if ((tt) + 3 < NT) { WAIT_BAR(2); } else if ((tt) + 2 < NT) { WAIT_BAR(1); } else { WAIT_BAR(0); } } while (0)
  for (; t < 5 && t + 1 < NT; t += 2) {
    STEP(pB0, pB1, pA0, pA1, t, (t + 3 < NT), (t + 1 < NT), (t + 1 < NT));         ENDW(t);     RESC(); ROT();
    STEP(pA0, pA1, pB0, pB1, t + 1, (t + 4 < NT), (t + 2 < NT), (t + 2 < NT));     ENDW(t + 1); RESC(); ROT();
  }
  #undef CMASK
  #define CMASK(P0, P1, t) do {} while (0)
  float* xmin = (float*)(shm + LDS_OST);
  { float mw = mhat;
    #pragma unroll
    for (int o_ = 1; o_ < 32; o_ <<= 1) mw = fminf(mw, __shfl_xor(mw, o_));
    if (lane == 0) { xmin[wid] = mw; xmin[8 + wid] = mw; } }
  for (int trip = 0; t + 5 < NT; t += 2, ++trip) {
    STEP(pB0, pB1, pA0, pA1, t, true, true, true);     WAIT_BAR(2); RESC(); ROT();
    STEP(pA0, pA1, pB0, pB1, t + 1, true, true, true); WAIT_BAR(2); RESC(); ROT();
    { float mw = mhat;
      #pragma unroll
      for (int o_ = 1; o_ < 32; o_ <<= 1) mw = fminf(mw, __shfl_xor(mw, o_));
      if (lane == 0) xmin[8 * (trip & 1) + wid] = mw;
      const float* xr_ = xmin + 8 * ((trip & 1) ^ 1);
      float mall = fminf(fminf(fminf(xr_[0], xr_[1]), fminf(xr_[2], xr_[3])), fminf(fminf(xr_[4], xr_[5]), fminf(xr_[6], xr_[7])));
      const float blast = ((const LAS float*)((LAS char*)shm + LDS_BIAS))[SEQ - 64 * (t + 5) - 1];
      if (t + 5 < NT && blast + b2bound - mall < -SKIP_LOG2) NT = t + 5; }
  }
  for (; t + 1 < NT; t += 2) {
    STEP(pB0, pB1, pA0, pA1, t, (t + 3 < NT), (t + 1 < NT), (t + 1 < NT));         ENDW(t);     RESC(); ROT();
    STEP(pA0, pA1, pB0, pB1, t + 1, (t + 4 < NT), (t + 2 < NT), (t + 2 < NT));     ENDW(t + 1); RESC(); ROT();
  }
  #undef CMASK
  #define CMASK(P0, P1, t) do { int jb_ = 3 - (t); if (jb_ >= 0) cmask(P0, P1, jb_, qrel, hi); } while (0)
  STEP(pB0, pB1, pA0, pA1, NT - 1, false, false, false); RESC();
  { float sacc = pB0[0] + pB0[1]; _Pragma("unroll") for (int r = 2; r < 16; ++r) sacc += pB0[r]; _Pragma("unroll") for (int r = 0; r < 16; ++r) sacc += pB1[r]; l_reg += sacc;
    pw0 = (u32x4){PKW(pB0, 0), PKW(pB0, 2), PKW(pB0, 4), PKW(pB0, 6)}; pw1 = (u32x4){PKW(pB0, 8), PKW(pB0, 10), PKW(pB0, 12), PKW(pB0, 14)}; pw2 = (u32x4){PKW(pB1, 0), PKW(pB1, 2), PKW(pB1, 4), PKW(pB1, 6)}; pw3 = (u32x4){PKW(pB1, 8), PKW(pB1, 10), PKW(pB1, 12), PKW(pB1, 14)};
    SBAR(); int lane_d = lane; asm volatile("" : "+v"(lane_d)); const int vb0 = (int)(lds0 + LDS_V) + ((lane_d >> 4) & 1) * 32 + (lane_d & 3) * 8 + (4 * (lane_d >> 5) + ((lane_d & 15) >> 2)) * 64; pv(o, vb0 + sl_cur, PAF(0), PAF(1), PAF(2), PAF(3)); }
  #undef PKW
  #undef PAF
  #undef VFR
  #undef PIN
  #undef MX3
  #undef GAPA
  #undef GAPB
  #undef EX
  #undef VRD
  #undef KRD
  #undef STEP
  #undef ENDW
  { auto rr = __builtin_amdgcn_permlane32_swap(__float_as_uint(l_reg), __float_as_uint(l_reg), false, false); l_reg = __uint_as_float(rr[0]) + __uint_as_float(rr[1]); }
  if (hi == 0) wsf[32 + r32] = l_reg; asm volatile("s_waitcnt lgkmcnt(0)" ::: "memory");
  float rli[16];
  #pragma unroll
  for (int r = 0; r < 16; ++r) rli[r] = __builtin_amdgcn_rcpf(wsf[32 + crow(r, hi)]);
  int lane_e = lane; asm volatile("" : "+v"(lane_e));
  hbf16* Ow = O + (rowbase + q0 + wid * QBLK) * DM + h * DH;
  const hbf16* Gw = Gt + (rowbase + q0 + wid * QBLK) * DM + h * DH;
  { hbf16* stg = (hbf16*)(shm + LDS_OST) + wid * 2048;
    #pragma unroll
    for (int r = 0; r < 16; ++r) { const int orow = crow(r, hi);
      #pragma unroll
      for (int d0 = 0; d0 < 2; ++d0) stg[orow * 64 + d0 * 32 + r32] = __float2bfloat16(o[d0][r] * rli[r]); }
    asm volatile("s_waitcnt lgkmcnt(0)" ::: "memory");
    #pragma unroll
    for (int i = 0; i < 4; ++i) { const int row = i * 8 + (lane_e >> 3), ch = lane_e & 7; const u32x4 v = *(const u32x4*)(stg + row * 64 + ch * 8);
      const u32x4 g = *(const u32x4*)(Gw + (long)row * DM + ch * 8);
      u32x4 w;
      #pragma unroll
      for (int j = 0; j < 4; ++j) w[j] = cvt_pk_bf16(bf_lo(v[j]) * fast_sigmoid(bf_lo(g[j])), bf_hi(v[j]) * fast_sigmoid(bf_hi(g[j])));
      *(u32x4*)(Ow + (long)row * DM + ch * 8) = w; } }
  asm volatile("s_waitcnt lgkmcnt(0)\n\ts_barrier" ::: "memory");
  #undef DMA_K
  #undef DMA_V
  #undef CMASK
  #undef START
  #undef RESC
  #undef ROT
}
#undef SBAR
#undef WAIT_BAR
#undef ADDBIAS
}

constexpr int RING_OFF = 0, RING_BYTES = 131072;
constexpr int LDSCTL_OFF = 149504, MISC_OFF = LDSCTL_OFF + 320;
constexpr int TB_OFF = MISC_OFF + 128;
constexpr int LDS_BYTES = 150528;
static_assert(attn_body::LDS_BYTES <= LDSCTL_OFF && TB_OFF + 128 <= LDS_BYTES, "LDS map");
constexpr int NWAVES = 8;

#define XB_TMO      128
#define XB_XCNT(j)  (256  + 64 * (j))
#define XB_XSUB(j)  (1280 + 64 * (j))
#define XB_XGEN(j)  (2304 + 64 * (j))
#define XB_TOP      3328
#define XB_TOPGEN   3392
#define XCD_BAR_WORDS 3456
#define XB_SPIN_CAP (1u << 18)
__device__ __forceinline__ unsigned xb_ld(unsigned* p)              { return __hip_atomic_load(p, __ATOMIC_RELAXED, __HIP_MEMORY_SCOPE_AGENT); }
__device__ __forceinline__ unsigned xb_add(unsigned* p, unsigned v) { return __hip_atomic_fetch_add(p, v, __ATOMIC_RELAXED, __HIP_MEMORY_SCOPE_AGENT); }
__device__ __forceinline__ unsigned xb_xcc_id() { return (unsigned)__builtin_amdgcn_s_getreg((3 << 11) | 20) & 0xFu; }
#define XB_SPIN(cond, bar) do { unsigned _sp = 0; while (cond) { __builtin_amdgcn_s_sleep(1); \
    if ((++_sp & 255u) == 0u) { if (xb_ld(&(bar)[XB_TMO])) break; if (_sp > XB_SPIN_CAP) { atomicAdd(&(bar)[XB_TMO], 1u); break; } } } } while (0)
struct XcdBarrier { unsigned* bar; unsigned x; volatile LAS unsigned* st; };
__device__ __forceinline__ XcdBarrier xcd_barrier_post(unsigned* bar, volatile LAS unsigned* st) {
    XcdBarrier b; b.bar = bar; b.x = xb_xcc_id(); b.st = st;
    if (threadIdx.x == 0) (void)xb_add(&bar[XB_XCNT(b.x)], 1u);
    return b;
}
__device__ __forceinline__ void xcd_barrier_complete(unsigned* bar, unsigned x, unsigned& nloc, unsigned& nx) {
    const unsigned G = gridDim.x * gridDim.y * gridDim.z;
    unsigned sum, cnt, mine, sp = 0u;
    for (;;) {
        sum = 0u; cnt = 0u; mine = 0u;
#pragma unroll
        for (unsigned j = 0; j < 16; ++j) { const unsigned c = xb_ld(&bar[XB_XCNT(j)]); sum += c; cnt += (c > 0u) ? 1u : 0u; mine = (j == x) ? c : mine; }
        if (sum == G) break;
        __builtin_amdgcn_s_sleep(1);
        if ((++sp & 255u) == 0u) { if (xb_ld(&bar[XB_TMO])) break; if (sp > XB_SPIN_CAP) { atomicAdd(&bar[XB_TMO], 1u); break; } }
    }
    nloc = mine > 0u ? mine : 1u; nx = cnt > 0u ? cnt : 1u;
}
__device__ __forceinline__ void xcd_barrier(const XcdBarrier& b, const int tid_) {
    asm volatile("s_waitcnt vmcnt(0)" ::: "memory");
    __syncthreads();
    if (tid_ == 0) {
        unsigned* bar = b.bar;
        __builtin_amdgcn_s_waitcnt(0);
        unsigned nloc = b.st[0], nx = b.st[1];
        if (nloc == 0u) { xcd_barrier_complete(bar, b.x, nloc, nx); b.st[0] = nloc; b.st[1] = nx; }
        const unsigned old = xb_add(&bar[XB_XSUB(b.x)], 1u);
        const unsigned gen = old / nloc;
        if (old + 1u == (gen + 1u) * nloc) {
            __builtin_amdgcn_fence(__ATOMIC_RELEASE, "agent");
            asm volatile("s_waitcnt vmcnt(0)" ::: "memory");
            const unsigned og = xb_add(&bar[XB_TOP], 1u);
            const unsigned tg = og / nx;
            if (og + 1u == (tg + 1u) * nx) xb_add(&bar[XB_TOPGEN], 1u);
            else XB_SPIN(xb_ld(&bar[XB_TOPGEN]) == tg, bar);
            __builtin_amdgcn_fence(__ATOMIC_ACQUIRE, "agent");
            xb_add(&bar[XB_XGEN(b.x)], 1u);
            asm volatile("s_waitcnt vmcnt(0)" ::: "memory");
        } else {
            XB_SPIN(xb_ld(&bar[XB_XGEN(b.x)]) == gen, bar);
            __builtin_amdgcn_fence(__ATOMIC_ACQUIRE, "agent");
            asm volatile("s_waitcnt vmcnt(0)" ::: "memory");
        }
    }
    __syncthreads();
}

struct Frame {
    LAS unsigned char* lds;
    volatile LAS unsigned* MISC;
    gu32* ctl;
    int tid, lane, wave;
    int vcu, G;
};
__device__ __forceinline__ float wave_sum(float v) {
#pragma unroll
    for (int o = 1; o < 64; o <<= 1) v += __shfl_xor(v, o);
    return v;
}

__device__ __forceinline__ void p0_transpose_item(const float* W, int K, int N, bf16* WT, int kb, int nb, int dst_row0, LAS float* scr, int lane) {
    const int k0 = 64 * kb, n0 = 32 * nb;
    float tmp[32];
#pragma unroll
    for (int i = 0; i < 32; ++i) tmp[i] = W[(size_t)(k0 + 2 * i + (lane >> 5)) * N + n0 + (lane & 31)];
#pragma unroll
    for (int i = 0; i < 32; ++i) scr[(2 * i + (lane >> 5)) * 33 + (lane & 31)] = tmp[i];
    LDS_WAIT(); asm volatile("" ::: "memory");
    const int c = lane & 7;
#pragma unroll
    for (int j = 0; j < 4; ++j) { const int n = (lane >> 3) + 8 * j; const LAS float* s = scr + (8 * c) * 33 + n;
        v4u o; o.x = cvt_pk_bf16(s[0 * 33], s[1 * 33]); o.y = cvt_pk_bf16(s[2 * 33], s[3 * 33]); o.z = cvt_pk_bf16(s[4 * 33], s[5 * 33]); o.w = cvt_pk_bf16(s[6 * 33], s[7 * 33]);
        *(GAS v4u*)(WT + (size_t)(dst_row0 + n) * K + k0 + 8 * c) = o; }
    LDS_WAIT(); asm volatile("" ::: "memory");
}
__device__ __forceinline__ void p0_transpose_item8(const float* W, int K, int N, unsigned char* WT, int kb, int nb, int dst_row0, float wscale, LAS float* scr, int lane) {
    const int k0 = 64 * kb, n0 = 32 * nb;
    float tmp[32];
#pragma unroll
    for (int i = 0; i < 32; ++i) tmp[i] = W[(size_t)(k0 + 2 * i + (lane >> 5)) * N + n0 + (lane & 31)];
#pragma unroll
    for (int i = 0; i < 32; ++i) scr[(2 * i + (lane >> 5)) * 33 + (lane & 31)] = tmp[i] * wscale;
    LDS_WAIT(); asm volatile("" ::: "memory");
    const int c = lane & 7;
#pragma unroll
    for (int j = 0; j < 4; ++j) { const int n = (lane >> 3) + 8 * j; const LAS float* s = scr + (8 * c) * 33 + n;
        v2u o; o.x = pg8::pk4_fp8(s[0 * 33], s[1 * 33], s[2 * 33], s[3 * 33]); o.y = pg8::pk4_fp8(s[4 * 33], s[5 * 33], s[6 * 33], s[7 * 33]);
        *(GAS v2u*)(WT + (size_t)(dst_row0 + n) * K + k0 + 8 * c) = o; }
    LDS_WAIT(); asm volatile("" ::: "memory");
}
__device__ __forceinline__ bool conv_group(int& r, const float* src, int cnt, int K, int N, unsigned char* dst, size_t dstride, int mode, float wscale, LAS float* scr, int lane) {
    const int per = (K / 64) * (N / 32), tot = per * cnt;
    if (r >= tot) { r -= tot; return false; }
    const int mi = r / per, it = r % per, nblk = N / 32, kb = it / nblk, nb = it % nblk, n0 = 32 * nb;
    const int drow = mode == 0 ? n0 : (256 * (n0 / 128) + (n0 % 128) + (mode == 2 ? 128 : 0));
    if (wscale == 0.0f) p0_transpose_item(src + (size_t)mi * K * N, K, N, (bf16*)(dst + (size_t)mi * dstride), kb, nb, drow, scr, lane);
    else p0_transpose_item8(src + (size_t)mi * K * N, K, N, dst + (size_t)mi * dstride, kb, nb, drow, wscale, scr, lane);
    return true;
}

__device__ __forceinline__ void conv_tile(const float* W, int K, int N  , unsigned char* WT, int kb, int nb, int mode, float wscale, LAS float* tile, int tid) {
    const int k0 = 128 * kb, n0 = 256 * nb, lane = tid & 63, wv = tid >> 6;
    f32x4 t4[16];
#pragma unroll
    for (int r = 0; r < 16; ++r) t4[r] = *(const f32x4*)(W + (size_t)(k0 + 8 * r + wv) * N + n0 + 4 * lane);
    __syncthreads();
#pragma unroll
    for (int r = 0; r < 16; ++r) *(LAS f32x4*)(tile + (8 * r + wv) * 260 + 4 * lane) = t4[r];
    __syncthreads();
#pragma unroll
    for (int j = 0; j < 8; ++j) { const int n = lane + 64 * (j & 3), c = 2 * wv + (j >> 2);
        const LAS float* s = tile + (8 * c) * 260 + n; const int gn = n0 + n;
        const int drow = mode == 0 ? gn : (256 * (gn / 128) + (gn % 128) + (mode == 2 ? 128 : 0));
        if (wscale == 0.0f) { v4u o; o.x = cvt_pk_bf16(s[0 * 260], s[1 * 260]); o.y = cvt_pk_bf16(s[2 * 260], s[3 * 260]); o.z = cvt_pk_bf16(s[4 * 260], s[5 * 260]); o.w = cvt_pk_bf16(s[6 * 260], s[7 * 260]);
            *(GAS v4u*)((bf16*)WT + (size_t)drow * K + k0 + 8 * c) = o; }
        else { v2u o; o.x = pg8::pk4_fp8(s[0 * 260] * wscale, s[1 * 260] * wscale, s[2 * 260] * wscale, s[3 * 260] * wscale); o.y = pg8::pk4_fp8(s[4 * 260] * wscale, s[5 * 260] * wscale, s[6 * 260] * wscale, s[7 * 260] * wscale);
            *(GAS v2u*)(WT + (size_t)drow * K + k0 + 8 * c) = o; } }
}
__device__ __forceinline__ bool conv_group_t(int& r, const float* src, int cnt, int K, int N, unsigned char* dst, size_t dstride, int mode, float wscale, LAS float* tile, int tid, int ncols = 0) {
    if (ncols == 0) ncols = N;
    const int per = (K / 128) * (ncols / 256), tot = per * cnt;
    if (r >= tot) { r -= tot; return false; }
    const int mi = r / per, it = r % per, nblk = ncols / 256;
    conv_tile(src + (size_t)mi * K * N, K, N, dst + (size_t)mi * dstride, it / nblk, it % nblk, mode, wscale, tile, tid);
    return true;
}

template <int IDX> __device__ __forceinline__ const float* karg() { unsigned long long p; const unsigned long long ka = (unsigned long long)__builtin_amdgcn_kernarg_segment_ptr();
    asm volatile("s_load_dwordx2 %0, %1, %2\n\ts_waitcnt lgkmcnt(0)" : "=s"(p) : "s"(ka), "i"(IDX * 8) : "memory"); return (const float*)(const GAS float*)p; }
#define KIN(i) karg<(i)>()
#define KOUT ((float*)karg<26>())
#define KWS ((unsigned char*)karg<27>())
#define KH ((bf16*)(KWS + WS_H))
struct Args { const float* in[26]; float* out; unsigned char* ws; int ph_lo, ph_hi, li, pad; };

template <int MODE, bool HBF = true>
__device__ __forceinline__ void norm_phase(Frame& F, const void* src, const float* gain, const float* shift, const float* scale, int bstride, bf16* dst, float* dstf,
                                           const float* rw, const float* rb, gu32* moe_cnt, int2* list, const float* wf, const float* bfv, float* logf, const bf16* addy = nullptr, bf16* hback = nullptr, const bool out8 = false,
                                           const float* gain2 = nullptr, const float* shift2 = nullptr, const float* scale2 = nullptr, int bstride2 = 0, bf16* dst2 = nullptr, unsigned char* dst8 = nullptr) {
    const int gw = F.vcu * NWAVES + F.wave, NGW = F.G * NWAVES, lane = F.lane;
    float wr_[MODE == 1 ? 16 : 1][8];
    if (MODE == 1) {
#pragma unroll
        for (int j = 0; j < 4; ++j)
#pragma unroll
            for (int i = 0; i < 4; ++i) { const int col = 256 * j + 4 * lane + i; const f32x4 a = *(const f32x4*)(rw + col * 8), b = *(const f32x4*)(rw + col * 8 + 4);
                wr_[MODE == 1 ? j * 4 + i : 0][0] = a[0]; wr_[MODE == 1 ? j * 4 + i : 0][1] = a[1]; wr_[MODE == 1 ? j * 4 + i : 0][2] = a[2]; wr_[MODE == 1 ? j * 4 + i : 0][3] = a[3];
                wr_[MODE == 1 ? j * 4 + i : 0][4] = b[0]; wr_[MODE == 1 ? j * 4 + i : 0][5] = b[1]; wr_[MODE == 1 ? j * 4 + i : 0][6] = b[2]; wr_[MODE == 1 ? j * 4 + i : 0][7] = b[3]; }
    }
    int rcount = 0, r_tok = 0, r_e1 = 0, r_e2 = 0; float r_w1 = 0.f, r_w2 = 0.f;
    LAS unsigned* lcnt = (LAS unsigned*)(F.lds + RING_OFF);
    if (MODE == 1) { if (F.tid < 16) lcnt[F.tid] = 0u; __syncthreads(); }
    LAS float* wfl = (LAS float*)(F.lds + RING_OFF);
    if (MODE == 2) { for (int i = F.tid; i < D * FH; i += NWAVES * 64) wfl[(i & 15) * D + (i >> 4)] = wf[i]; __syncthreads(); }
    for (int b = 0; b < BATCH; ++b) {
        f32x4 ga[4], sh[4];
#pragma unroll
        for (int j = 0; j < 4; ++j) { const f32x4 g = *(const f32x4*)(gain + 256 * j + 4 * lane), sc = *(const f32x4*)(scale + (size_t)b * bstride + 256 * j + 4 * lane);
            ga[j] = g * (sc + 1.0f); sh[j] = *(const f32x4*)(shift + (size_t)b * bstride + 256 * j + 4 * lane); }
        f32x4 ga2[MODE == 2 ? 4 : 1], sh2[MODE == 2 ? 4 : 1];
        if (MODE == 2) {
#pragma unroll
            for (int j = 0; j < 4; ++j) { const f32x4 g = *(const f32x4*)(gain2 + 256 * j + 4 * lane), sc = *(const f32x4*)(scale2 + (size_t)b * bstride2 + 256 * j + 4 * lane);
                ga2[MODE == 2 ? j : 0] = g * (sc + 1.0f); sh2[MODE == 2 ? j : 0] = *(const f32x4*)(shift2 + (size_t)b * bstride2 + 256 * j + 4 * lane); } }
        v2u hy[4], ay[4];
#pragma unroll
        for (int j = 0; j < 4; ++j) { hy[j] = (v2u){0u, 0u}; ay[j] = (v2u){0u, 0u}; }
        if constexpr (HBF) { const int m0 = b * SEQ + gw;
            if (m0 < (b + 1) * SEQ) { const GAS v2u* hr = (const GAS v2u*)((const bf16*)src + (size_t)m0 * D) + lane;
#pragma unroll
                for (int j = 0; j < 4; ++j) hy[j] = hr[64 * j];
                if (addy) { const GAS v2u* yr = (const GAS v2u*)(addy + (size_t)m0 * D) + lane;
#pragma unroll
                    for (int j = 0; j < 4; ++j) ay[j] = yr[64 * j]; } } }
        for (int m = b * SEQ + gw; m < (b + 1) * SEQ; m += NGW) {
            f32x4 v[4]; float s = 0.f;
            if constexpr (HBF) {
                v2u cy[4], cay[4];
#pragma unroll
                for (int j = 0; j < 4; ++j) { cy[j] = hy[j]; cay[j] = ay[j]; }
                const int mn = m + NGW;
                if (mn < (b + 1) * SEQ) { const GAS v2u* hr = (const GAS v2u*)((const bf16*)src + (size_t)mn * D) + lane;
#pragma unroll
                    for (int j = 0; j < 4; ++j) hy[j] = hr[64 * j];
                    if (addy) { const GAS v2u* yr = (const GAS v2u*)(addy + (size_t)mn * D) + lane;
#pragma unroll
                        for (int j = 0; j < 4; ++j) ay[j] = yr[64 * j]; } }
#pragma unroll
                for (int j = 0; j < 4; ++j) v[j] = (f32x4){bf_lo(cy[j].x), bf_hi(cy[j].x), bf_lo(cy[j].y), bf_hi(cy[j].y)};
                if (addy) {
#pragma unroll
                    for (int j = 0; j < 4; ++j) { v[j].x += bf_lo(cay[j].x); v[j].y += bf_hi(cay[j].x); v[j].z += bf_lo(cay[j].y); v[j].w += bf_hi(cay[j].y); }
                    if (MODE != 3) { GAS v2u* hb = (GAS v2u*)(hback + (size_t)m * D) + lane;
#pragma unroll
                        for (int j = 0; j < 4; ++j) { v2u o; o.x = cvt_pk_bf16(v[j].x, v[j].y); o.y = cvt_pk_bf16(v[j].z, v[j].w); hb[64 * j] = o; } }
                }
            } else { const GAS f32x4* xr = (const GAS f32x4*)((const float*)src + (size_t)m * D) + lane;
#pragma unroll
                for (int j = 0; j < 4; ++j) v[j] = xr[64 * j]; }
#pragma unroll
            for (int j = 0; j < 4; ++j) s += (v[j].x * v[j].x + v[j].y * v[j].y) + (v[j].z * v[j].z + v[j].w * v[j].w);
            const float rstd = 1.0f / sqrtf(wave_sum(s) * (1.f / D) + EPS);
            if (MODE == 2) { GAS unsigned long long* o8 = (GAS unsigned long long*)(dst2 + (size_t)m * D) + lane;
#pragma unroll
                for (int j = 0; j < 4; ++j) { const f32x4 t = (v[j] * rstd) * ga2[MODE == 2 ? j : 0] + sh2[MODE == 2 ? j : 0]; o8[64 * j] = (unsigned long long)cvt_pk_bf16(t.x, t.y) | ((unsigned long long)cvt_pk_bf16(t.z, t.w) << 32); } }
#pragma unroll
            for (int j = 0; j < 4; ++j) v[j] = (v[j] * rstd) * ga[j] + sh[j];
            if (MODE == 3) { GAS f32x4* o = (GAS f32x4*)(dstf + (size_t)m * D) + lane;
#pragma unroll
                for (int j = 0; j < 4; ++j) o[64 * j] = v[j]; }
            else if (out8) { GAS unsigned* o4 = (GAS unsigned*)((unsigned char*)dst + (size_t)m * D) + lane;
#pragma unroll
                for (int j = 0; j < 4; ++j) o4[64 * j] = pg8::pk4_fp8(v[j].x * QS_X, v[j].y * QS_X, v[j].z * QS_X, v[j].w * QS_X); }
            else { GAS unsigned long long* o8 = (GAS unsigned long long*)(dst + (size_t)m * D) + lane;
#pragma unroll
                for (int j = 0; j < 4; ++j) o8[64 * j] = (unsigned long long)cvt_pk_bf16(v[j].x, v[j].y) | ((unsigned long long)cvt_pk_bf16(v[j].z, v[j].w) << 32); }
            if (dst8) { GAS unsigned* o4 = (GAS unsigned*)(dst8 + (size_t)m * D) + lane;
#pragma unroll
                for (int j = 0; j < 4; ++j) o4[64 * j] = pg8::pk4_fp8(v[j].x * QS_X, v[j].y * QS_X, v[j].z * QS_X, v[j].w * QS_X); }
            if (MODE == 1) {
                float lg[8];
#pragma unroll
                for (int e = 0; e < 8; ++e) { float a = 0.f;
#pragma unroll
                    for (int j = 0; j < 4; ++j)
#pragma unroll
                        for (int i = 0; i < 4; ++i) a += v[j][i] * wr_[MODE == 1 ? j * 4 + i : 0][e];
                    lg[e] = wave_sum(a) + rb[e]; }
                int i1 = 0; float v1 = lg[0];
#pragma unroll
                for (int e = 1; e < 8; ++e) if (lg[e] > v1) { v1 = lg[e]; i1 = e; }
                int i2 = -1; float v2 = -INFINITY;
#pragma unroll
                for (int e = 0; e < 8; ++e) if (e != i1 && lg[e] > v2) { v2 = lg[e]; i2 = e; }
                const float w1 = 1.0f / (1.0f + __expf(v2 - v1)), w2 = 1.0f - w1;
                if (lane == rcount) { r_tok = m; r_e1 = i1; r_e2 = i2; r_w1 = w1; r_w2 = w2; }
                ++rcount;
            }
            if (MODE == 2) {
                float z[16];
#pragma unroll
                for (int hh = 0; hh < 16; ++hh) z[hh] = 0.f;
#pragma unroll
                for (int hh = 0; hh < 16; ++hh)
#pragma unroll
                    for (int j = 0; j < 4; ++j) { const f32x4 w4 = *(const LAS f32x4*)(wfl + hh * D + 256 * j + 4 * lane); z[hh] += (v[j][0] * w4[0] + v[j][1] * w4[1]) + (v[j][2] * w4[2] + v[j][3] * w4[3]); }
                float mine = 0.f;
#pragma unroll
                for (int hh = 0; hh < 16; ++hh) { const float t = wave_sum(z[hh]); if (lane == hh) mine = t; }
                if (lane < 16) { const float zz = mine + bfv[lane];
                    const float ls = -__builtin_amdgcn_logf(1.0f + __builtin_amdgcn_exp2f(-zz * LOG2E));
                    logf[(size_t)m * FH + lane] = ls; }
            }
        }
    }
    if (MODE == 2) __syncthreads();
    if (MODE == 1) {
        unsigned s1 = 0u, s2 = 0u; const bool have = lane < rcount;
        if (have) { s1 = __hip_atomic_fetch_add(lcnt + r_e1, 1u, __ATOMIC_RELAXED, __HIP_MEMORY_SCOPE_WORKGROUP); s2 = __hip_atomic_fetch_add(lcnt + r_e2, 1u, __ATOMIC_RELAXED, __HIP_MEMORY_SCOPE_WORKGROUP); }
        __syncthreads();
        if (F.tid < 8) lcnt[8 + F.tid] = __hip_atomic_fetch_add(moe_cnt + 64 * F.tid, lcnt[F.tid], RLX_AGENT);
        __syncthreads();
        if (have) { list[(size_t)r_e1 * T + lcnt[8 + r_e1] + s1] = make_int2(r_tok, __float_as_int(r_w1));
                    list[(size_t)r_e2 * T + lcnt[8 + r_e2] + s2] = make_int2(r_tok | 0x40000000, __float_as_int(r_w2)); }
    }
}

namespace ret {
constexpr int NG = 8, CG = SEQ / 64 / NG  , VS = 128;
constexpr int QSB = 528, KSB = 512, VSB = 288, PSB = 144, OSB = 272;
constexpr int L_Q = 0, L_K = 64 * QSB, L_V = L_K + 64 * KSB, L_P = L_V + 64 * VSB, L_O = L_P + 64 * PSB, L_END = L_O + 64 * OSB;
static_assert(L_END <= RING_BYTES, "scan LDS");
__device__ __forceinline__ s16x4 trr(const LAS unsigned char* p) { return __builtin_bit_cast(s16x4, __builtin_amdgcn_ds_read_tr16_b64_v4i16((LAS attn_body::v4i16_t*)p)); }
__device__ __forceinline__ int hsw(int m) { return ((m & 3) << 3) | ((m >> 2) & 1); }
#define RSB() __builtin_amdgcn_sched_barrier(0)
template <bool OUT>
__device__ __forceinline__ void scan_unit(Frame& F, int u, bf16* proj, float* Lbuf) {
    const int vs = u & 3, grp = (u >> 2) & 7, h = (u >> 5) & 3, b = u >> 7;
    if (!OUT && grp == NG - 1) return;
    const int tid = F.tid, lane = F.lane, w = F.wave, c = lane & 15, g = lane >> 4;
    LAS unsigned char* L = F.lds + RING_OFF;
    const float l2g0 = __builtin_amdgcn_logf(1.0f - __builtin_amdgcn_exp2f(-5.0f - (float)h));
    f32x4 st[16];
#pragma unroll
    for (int t = 0; t < 16; ++t) st[t] = (f32x4){0.f, 0.f, 0.f, 0.f};
    if (OUT) {
        for (int gp = 0; gp < grp; ++gp) {
            const float wgt = __builtin_amdgcn_exp2f(l2g0 * 2048.0f * (float)(grp - 1 - gp));
            const int up = (u & ~(7 << 2)) | (gp << 2);
            const f32x4* lp = (const f32x4*)Lbuf + ((size_t)(up * 8 + w) * 16) * 64 + lane;
#pragma unroll
            for (int t = 0; t < 16; ++t) st[t] += lp[t * 64] * wgt;
        }
    }
    const size_t row0 = (size_t)b * SEQ + (size_t)grp * (CG * 64);
    const __amdgpu_buffer_rsrc_t rs = __builtin_amdgcn_make_buffer_rsrc((void*)(proj + row0 * PROJW), 0, CG * 64 * PROJW * 2, 0x00020000);
    const int qcol = h * RQK * 2, kcol = (D + h * RQK) * 2, vcol = (2 * D + h * RV + vs * VS) * 2;
    v4u pq[4], pk[4], pvv[2];
    int qoff[4], voff[2];
#pragma unroll
    for (int i = 0; i < 4; ++i) { const int p = tid + 512 * i, r = p >> 5, cp = p & 31; qoff[i] = (r * PROJW + cp * 8) * 2; }
#pragma unroll
    for (int i = 0; i < 2; ++i) { const int p = tid + 512 * i, r = p >> 4, cp = p & 15; voff[i] = (r * PROJW + cp * 8) * 2; }
#define LOADCH(cc) do { const int cb_ = (cc) * 64 * PROJW * 2; \
        _Pragma("unroll") for (int i = 0; i < 4; ++i) { if (OUT) pq[i] = __builtin_bit_cast(v4u, __builtin_amdgcn_raw_buffer_load_b128(rs, qoff[i], cb_ + qcol, 0)); pk[i] = __builtin_bit_cast(v4u, __builtin_amdgcn_raw_buffer_load_b128(rs, qoff[i], cb_ + kcol, 0)); } \
        _Pragma("unroll") for (int i = 0; i < 2; ++i) pvv[i] = __builtin_bit_cast(v4u, __builtin_amdgcn_raw_buffer_load_b128(rs, voff[i], cb_ + vcol, 0)); } while (0)
    LOADCH(0);
    int kbase[2][4];
#pragma unroll
    for (int f0 = 0; f0 < 2; ++f0)
#pragma unroll
        for (int f1 = 0; f1 < 4; ++f1) kbase[f0][f1] = (4 * g + (c >> 2)) * KSB + 8 * ((f0 ^ (g & 1)) + 2 * (c & 3) + 8 * (f1 ^ (c >> 2)));
    for (int cc = 0; cc < CG; ++cc) {
        float l2g = l2g0; asm volatile("" : "+v"(l2g));
#pragma unroll
        for (int i = 0; i < 4; ++i) { const int p = tid + 512 * i, r = p >> 5, cp = p & 31;
            if (OUT) *(LAS v4u*)(L + L_Q + r * QSB + cp * 16) = pq[i];
            const int hh = hsw(r);
            *(LAS v2u*)(L + L_K + r * KSB + 8 * ((2 * cp) ^ hh)) = (v2u){pk[i].x, pk[i].y};
            *(LAS v2u*)(L + L_K + r * KSB + 8 * ((2 * cp + 1) ^ hh)) = (v2u){pk[i].z, pk[i].w}; }
#pragma unroll
        for (int i = 0; i < 2; ++i) { const int p = tid + 512 * i, r = p >> 4, cp = p & 15; const float kd = __builtin_amdgcn_exp2f(l2g * (float)(63 - r));
            v4u o;
#pragma unroll
            for (int jj = 0; jj < 4; ++jj) o[jj] = cvt_pk_bf16(bf_lo(pvv[i][jj]) * kd, bf_hi(pvv[i][jj]) * kd);
            *(LAS v4u*)(L + L_V + r * VSB + cp * 16) = o; }
        __syncthreads();
        if (cc + 1 < CG) LOADCH(cc + 1);
        if (OUT) {
            const int mt = w >> 1, mrow = 16 * mt + c;
            f32x4 pacc[2] = {(f32x4){0.f, 0.f, 0.f, 0.f}, (f32x4){0.f, 0.f, 0.f, 0.f}};
#pragma unroll
            for (int kh = 0; kh < 2; ++kh) {
                bf16x8 ka[4], qb[2][4];
#pragma unroll
                for (int k4 = 0; k4 < 4; ++k4) { const int ks = 4 * kh + k4;
                    const int ub = 2 * g + 8 * (k4 ^ (c & 3)) + 32 * kh, b0 = (c >> 2) & 1;
                    const v2u a0 = *(const LAS v2u*)(L + L_K + mrow * KSB + 8 * (ub + b0)), a1 = *(const LAS v2u*)(L + L_K + mrow * KSB + 8 * (ub + 1 - b0));
                    ka[k4] = __builtin_bit_cast(bf16x8, (v4u){a0.x, a0.y, a1.x, a1.y});
#pragma unroll
                    for (int ti = 0; ti < 2; ++ti) qb[ti][k4] = *(const LAS bf16x8*)(L + L_Q + (16 * (2 * (w & 1) + ti) + c) * QSB + (32 * ks + 8 * g) * 2); }
                RSB();
#pragma unroll
                for (int k4 = 0; k4 < 4; ++k4)
#pragma unroll
                    for (int ti = 0; ti < 2; ++ti) pacc[ti] = __builtin_amdgcn_mfma_f32_16x16x32_bf16(ka[k4], qb[ti][k4], pacc[ti], 0, 0, 0);
            }
#pragma unroll
            for (int ti = 0; ti < 2; ++ti) { const int n = 16 * (2 * (w & 1) + ti) + c; float pvl[4];
#pragma unroll
                for (int i = 0; i < 4; ++i) { const int m = 16 * mt + 4 * g + i; const float e = (m <= n) ? -64.0f : (float)(2 * (m - n) - 64); pvl[i] = pacc[ti][i] * __builtin_amdgcn_exp2f(l2g * e); }
                v2u pw; pw.x = cvt_pk_bf16(pvl[0], pvl[1]); pw.y = cvt_pk_bf16(pvl[2], pvl[3]);
                *(LAS v2u*)(L + L_P + n * PSB + (32 * (mt >> 1) + 8 * g + 4 * (mt & 1)) * 2) = pw; }
            __syncthreads();
        }
        bf16x8 bv[2];
#pragma unroll
        for (int ks = 0; ks < 2; ++ks) { const LAS unsigned char* vp = L + L_V + (32 * ks + 4 * g + (c >> 2)) * VSB + (16 * w + 4 * (c & 3)) * 2;
            const s16x4 lo = trr(vp), hi = trr(vp + 16 * VSB); bv[ks] = (bf16x8){lo[0], lo[1], lo[2], lo[3], hi[0], hi[1], hi[2], hi[3]}; }
        if (OUT) {
            f32x4 ao[4];
#pragma unroll
            for (int nt_ = 0; nt_ < 4; ++nt_) ao[nt_] = (f32x4){0.f, 0.f, 0.f, 0.f};
            { bf16x8 pa[2][4];
#pragma unroll
              for (int ks = 0; ks < 2; ++ks)
#pragma unroll
                for (int nt_ = 0; nt_ < 4; ++nt_) pa[ks][nt_] = *(const LAS bf16x8*)(L + L_P + (16 * nt_ + c) * PSB + (32 * ks + 8 * g) * 2);
              RSB();
#pragma unroll
              for (int ks = 0; ks < 2; ++ks)
#pragma unroll
                for (int nt_ = 0; nt_ < 4; ++nt_) ao[nt_] = __builtin_amdgcn_mfma_f32_16x16x32_bf16(pa[ks][nt_], bv[ks], ao[nt_], 0, 0, 0); }
#pragma unroll
            for (int kp = 0; kp < 4; ++kp) { bf16x8 qa[2][4];
#pragma unroll
                for (int k2 = 0; k2 < 2; ++k2)
#pragma unroll
                    for (int nt_ = 0; nt_ < 4; ++nt_) qa[k2][nt_] = *(const LAS bf16x8*)(L + L_Q + (16 * nt_ + c) * QSB + (32 * (2 * kp + k2) + 8 * g) * 2);
                RSB();
#pragma unroll
                for (int k2 = 0; k2 < 2; ++k2) { const int ks = 2 * kp + k2;
                    v4u sb; sb.x = cvt_pk_bf16(st[2 * ks][0], st[2 * ks][1]); sb.y = cvt_pk_bf16(st[2 * ks][2], st[2 * ks][3]); sb.z = cvt_pk_bf16(st[2 * ks + 1][0], st[2 * ks + 1][1]); sb.w = cvt_pk_bf16(st[2 * ks + 1][2], st[2 * ks + 1][3]);
                    const bf16x8 sfrag = __builtin_bit_cast(bf16x8, sb);
#pragma unroll
                    for (int nt_ = 0; nt_ < 4; ++nt_) ao[nt_] = __builtin_amdgcn_mfma_f32_16x16x32_bf16(qa[k2][nt_], sfrag, ao[nt_], 0, 0, 0); } }
#pragma unroll
            for (int nt_ = 0; nt_ < 4; ++nt_)
#pragma unroll
                for (int i = 0; i < 4; ++i) { const int n = 16 * nt_ + 4 * g + i; const float ov = ao[nt_][i] * __builtin_amdgcn_exp2f(l2g * (float)(n + 1));
                    *(LAS bf16*)(L + L_O + n * OSB + (16 * w + c) * 2) = (bf16)(cvt_pk_bf16(ov, 0.f) & 0xffffu); }
        }
        const float cdec = __builtin_amdgcn_exp2f(l2g * 64.0f);
#pragma unroll
        for (int tb = 0; tb < 16; tb += 4) { s16x4 klo[4][2], khi[4][2];
#pragma unroll
            for (int tt = 0; tt < 4; ++tt)
#pragma unroll
                for (int ks = 0; ks < 2; ++ks) { const int t = tb + tt;
                    const LAS unsigned char* kp = L + L_K + kbase[t & 1][(t >> 1) & 3] + 256 * (t >> 3) + ks * 32 * KSB;
                    klo[tt][ks] = trr(kp); khi[tt][ks] = trr(kp + 16 * KSB); }
            RSB();
#pragma unroll
            for (int tt = 0; tt < 4; ++tt) { f32x4 a = st[tb + tt] * cdec;
#pragma unroll
                for (int ks = 0; ks < 2; ++ks) { const bf16x8 kf = (bf16x8){klo[tt][ks][0], klo[tt][ks][1], klo[tt][ks][2], klo[tt][ks][3], khi[tt][ks][0], khi[tt][ks][1], khi[tt][ks][2], khi[tt][ks][3]};
                    a = __builtin_amdgcn_mfma_f32_16x16x32_bf16(kf, bv[ks], a, 0, 0, 0); }
                st[tb + tt] = a; } }
        __syncthreads();
        if (OUT) {
#pragma unroll
            for (int i = 0; i < 2; ++i) { const int p = tid + 512 * i, r = p >> 4, cp = p & 15;
                __builtin_amdgcn_raw_buffer_store_b128(__builtin_bit_cast(__attribute__((ext_vector_type(4))) unsigned, *(const LAS v4u*)(L + L_O + r * OSB + cp * 16)), rs, voff[i], cc * 64 * PROJW * 2 + vcol, 0); }
        }
    }
#undef LOADCH
#undef RSB
    if (!OUT) { f32x4* lp = (f32x4*)Lbuf + ((size_t)(u * 8 + w) * 16) * 64 + lane;
#pragma unroll
        for (int t = 0; t < 16; ++t) lp[t * 64] = st[t]; }
}
}

__device__ __forceinline__ int lane_id_opaque() { int l; asm volatile("v_mbcnt_lo_u32_b32 %0, -1, 0\n\tv_mbcnt_hi_u32_b32 %0, -1, %0" : "=v"(l)); return l; }
#ifdef PROBE_LO
#define PROBE_T0(k) do { if ((k) == PROBE_LO && blockIdx.x == 0 && F.tid == 0) { const unsigned long long t_ = __builtin_amdgcn_s_memrealtime(); F.MISC[16] = (unsigned)t_; F.MISC[17] = (unsigned)(t_ >> 32); } } while (0)
#define PROBE_T1(k) do { if ((k) + 1 == PROBE_HI && blockIdx.x == 0 && F.tid == 0) { const unsigned long long t_ = __builtin_amdgcn_s_memrealtime(); F.MISC[18] = (unsigned)t_; F.MISC[19] = (unsigned)(t_ >> 32); } } while (0)
#else
#define PROBE_T0(k) do {} while (0)
#define PROBE_T1(k) do {} while (0)
#endif
#define PHASE(k, sync, ...) do { if (lo <= (k) && (k) < hi) { F.lane = lane_id_opaque(); F.tid = F.wave * 64 + F.lane; PROBE_T0(k); __VA_ARGS__ if ((sync) && (k) + 1 < hi) xcd_barrier(bar, F.tid); PROBE_T1(k); } } while (0)
#define WSP(T_, off) ((T_*)(KWS + (off)))
#define MODP(l) (WSP(float, WS_MOD) + (l) * MOD_L)

__device__ __forceinline__ void moe_table(Frame& F, LAS int* TB, gu32* mcnt) {
    __syncthreads();
    if (F.tid < 8) TB[16 + F.tid] = (int)__hip_atomic_load(mcnt + 64 * F.tid, RLX_AGENT);
    __syncthreads();
    if (F.tid == 0) { int acc = 0; for (int e = 0; e < 8; ++e) { TB[e] = acc; acc += (TB[16 + e] + 255) >> 8; } TB[8] = acc; }
    __syncthreads();
}

template <int L, int P>
__device__ __forceinline__ void ffn_part(Frame& F, const XcdBarrier& bar, const int lo, const int hi) {
    constexpr int I = L >> 1;
    if constexpr ((L & 1) == 0) {
        PHASE(P, true, { norm_phase<0>(F, KH, KIN(4) + (L * 2 + 1) * D, MODP(L) + 3 * D, MODP(L) + 4 * D, 6 * D, WSP(bf16, WS_XN), nullptr, nullptr, nullptr, nullptr, nullptr, nullptr, nullptr, nullptr, nullptr, nullptr, true); });
        PHASE(P + 1, true, { pg8::DenseOrder S{WSP(bf16, WS_XN), WSP(bf16, W_FUP) + (size_t)I * DFF * D, D / 2, D / 2, T / 256, 2 * DFF / 256, F.G, (int)blockIdx.x};
              pg8::EpiSwigluT<true> E{WSP(bf16, WS_HID), DFF, 1.0f / (QS_X * QS_WUP), QS_H};
              pg8::gemm_phase<pg8::EpiSwigluT<true>, pg8::DenseOrder, false, true>(F.lds + RING_OFF, S, E, F.tid); });
        PHASE(P + 2, true, { pg8::DenseOrder S{WSP(bf16, WS_HID), WSP(bf16, W_FDN) + (size_t)I * DFF * D / 2, DFF / 2, DFF / 2, T / 256, D / 256, F.G, (int)blockIdx.x};
              pg8::EpiResidT<true> E{KH, KH, MODP(L) + 5 * D, 6 * D, 1.0f / (QS_H * QS_WDN_F), true};
              pg8::gemm_phase<pg8::EpiResidT<true>, pg8::DenseOrder, false, true>(F.lds + RING_OFF, S, E, F.tid); });
    } else {
        PHASE(P, true, { norm_phase<1>(F, KH, KIN(4) + (L * 2 + 1) * D, MODP(L) + 3 * D, MODP(L) + 4 * D, 6 * D, WSP(bf16, WS_XN), nullptr, KIN(18) + (size_t)I * D * NE, KIN(19) + I * NE,
                                       (gu32*)WSP(unsigned, WS_CTL) + CW_MOE + I * 16 * 64, WSP(int2, WS_LIST), nullptr, nullptr, nullptr, nullptr, nullptr, true); });
        PHASE(P + 1, true, { LAS int* TB = (LAS int*)(F.lds + TB_OFF); moe_table(F, TB, (gu32*)WSP(unsigned, WS_CTL) + CW_MOE + I * 16 * 64);
              pg8::MoeOrder S{WSP(bf16, WS_XN), WSP(bf16, W_MUP) + (size_t)I * 8 * DFE * D, D / 2, D / 2, 2 * DFE / 256, F.G, (int)blockIdx.x, (size_t)DFE * D, WSP(int2, WS_LIST), TB, true};
              pg8::EpiSwigluT<true> E{WSP(bf16, WS_HID), DFE, 1.0f / (QS_X * QS_WUP), QS_H};
              pg8::gemm_phase<pg8::EpiSwigluT<true>, pg8::MoeOrder, true, true>(F.lds + RING_OFF, S, E, F.tid); });
        PHASE(P + 2, true, { LAS int* TB = (LAS int*)(F.lds + TB_OFF); moe_table(F, TB, (gu32*)WSP(unsigned, WS_CTL) + CW_MOE + I * 16 * 64);
              pg8::MoeOrder S{WSP(bf16, WS_HID), WSP(bf16, W_MDN) + (size_t)I * 8 * DFE * D / 2, DFE / 2, DFE / 2, D / 256, F.G, (int)blockIdx.x, (size_t)DFE * D / 2, WSP(int2, WS_LIST), TB, false};
              pg8::EpiMoeDown E{KH, WSP(bf16, WS_XN), MODP(L) + 5 * D, 6 * D, WSP(int2, WS_LIST), TB, 1.0f / (QS_H * QS_WDN_M)};
              pg8::gemm_phase<pg8::EpiMoeDown, pg8::MoeOrder, false, true>(F.lds + RING_OFF, S, E, F.tid); });
    }
}

template <int L, int P>
__device__ __forceinline__ void ret_layer(Frame& F, const XcdBarrier& bar, const int lo, const int hi) {
    PHASE(P, true, { norm_phase<0, (L != 0)>(F, L == 0 ? (const void*)KIN(0) : (const void*)KH, KIN(4) + (L * 2 + 0) * D, MODP(L) + 0 * D, MODP(L) + 1 * D, 6 * D, WSP(bf16, WS_XN), nullptr, nullptr, nullptr, nullptr, nullptr, nullptr, nullptr, nullptr,
                                   nullptr, nullptr, false, nullptr, nullptr, nullptr, 0, nullptr, WSP(unsigned char, WS_XN8)); });
    PHASE(P + 1, true, { { pg8::DenseOrder S{WSP(bf16, WS_XN), (const bf16*)(KWS + W_RIN + (size_t)L * 12 * MiB), D, D, T / 256, 2 * D / 256, F.G, (int)blockIdx.x};
            pg8::EpiRetIn E{WSP(bf16, WS_PROJ), WSP(f32x2, WS_ROPE)};
            pg8::gemm_phase<pg8::EpiRetIn, pg8::DenseOrder, false>(F.lds + RING_OFF, S, E, F.tid); }
          { pg8::DenseOrder S{WSP(bf16, WS_XN8), (const bf16*)(KWS + W_RIN + (size_t)L * 12 * MiB + 4 * MiB), D / 2, D / 2, T / 256, 4 * D / 256, F.G, (int)blockIdx.x};
            pg8::EpiI8Bf16 E{WSP(bf16, WS_PROJ), PROJW, 2 * D, 1.0f / (QS_X * QS_WUP)};
            pg8::gemm_phase<pg8::EpiI8Bf16, pg8::DenseOrder, false, true>(F.lds + RING_OFF, S, E, F.tid); } });
    PHASE(P + 2, true, { for (int u = F.vcu; u < 256; u += F.G) ret::scan_unit<false>(F, u, WSP(bf16, WS_PROJ), WSP(float, WS_LST)); });
    PHASE(P + 3, true, { for (int u = F.vcu; u < 256; u += F.G) ret::scan_unit<true>(F, u, WSP(bf16, WS_PROJ), WSP(float, WS_LST)); });
    PHASE(P + 4, true, {
          const int gw = F.vcu * NWAVES + F.wave, NGW = F.G * NWAVES; bf16* PROJ = WSP(bf16, WS_PROJ);
          for (int it = gw; it < T * RH; it += NGW) { const int row = it >> 2, hh = it & 3;
              bf16* op = PROJ + (size_t)row * PROJW + 2 * D + hh * RV + F.lane * 8; const bf16* gp = op + 2 * D;
              const v4u ov = *(const v4u*)op, gv = *(const v4u*)gp; float o[8], gg[8];
_Pragma("unroll")
              for (int j = 0; j < 4; ++j) { o[2 * j] = bf_lo(ov[j]); o[2 * j + 1] = bf_hi(ov[j]); gg[2 * j] = bf_lo(gv[j]); gg[2 * j + 1] = bf_hi(gv[j]); }
              float s = 0.f;
_Pragma("unroll")
              for (int j = 0; j < 8; ++j) s += o[j];
              const float mu = wave_sum(s) * (1.0f / RV); float q = 0.f;
_Pragma("unroll")
              for (int j = 0; j < 8; ++j) { o[j] -= mu; q += o[j] * o[j]; }
              const float rstd = 1.0f / sqrtf(wave_sum(q) * (1.0f / RV) + EPS);
              v4u w;
_Pragma("unroll")
              for (int j = 0; j < 4; ++j) w[j] = cvt_pk_bf16(o[2 * j] * rstd * fast_silu(gg[2 * j]), o[2 * j + 1] * rstd * fast_silu(gg[2 * j + 1]));
              *(v4u*)op = w; } });
    PHASE(P + 5, true, { pg8::DenseOrder S{WSP(bf16, WS_PROJ) + 2 * D, WSP(bf16, W_RO) + (size_t)L * 2 * D * D, PROJW, 2 * D, T / 256, D / 256, F.G, (int)blockIdx.x};
          pg8::EpiResidT<(L != 0)> E{L == 0 ? (const void*)KIN(0) : (const void*)KH, KH, MODP(L) + 2 * D, 6 * D};
          pg8::gemm_phase<pg8::EpiResidT<(L != 0)>, pg8::DenseOrder, false>(F.lds + RING_OFF, S, E, F.tid); });
    ffn_part<L, P + 6>(F, bar, lo, hi);
}

__device__ __forceinline__ void late_convert(Frame& F, int j) {
    int r = (int)blockIdx.x + 256 * j;
    if (r >= 3 * 8 * 112) return;
    LAS float* tile = (LAS float*)(F.lds + RING_OFF);
    if (!conv_group_t(r, KIN(20) + (size_t)8 * D * DFE, 8, D, DFE, WSP(unsigned char, W_MUP) + (size_t)8 * 2 * DFE * D, (size_t)2 * DFE * D, 1, QS_WUP, tile, F.tid))
    if (!conv_group_t(r, KIN(21) + (size_t)8 * D * DFE, 8, D, DFE, WSP(unsigned char, W_MUP) + (size_t)8 * 2 * DFE * D, (size_t)2 * DFE * D, 2, QS_WUP, tile, F.tid))
        conv_group_t(r, KIN(22) + (size_t)8 * DFE * D, 8, DFE, D, WSP(unsigned char, W_MDN) + (size_t)8 * DFE * D, (size_t)DFE * D, 0, QS_WDN_M, tile, F.tid);
    __syncthreads();
}

constexpr size_t WS_KVN = WS_BIG + 128 * MiB;
template <int L, int P>
__device__ __forceinline__ void fox_layer(Frame& F, const XcdBarrier& bar, const int lo, const int hi, unsigned char* ldsg) {
    constexpr int J = L - 2;
    if constexpr (L == 2) {
        PHASE(P, true, { norm_phase<2>(F, KH, KIN(9), WSP(float, WS_MOD) + MOD_KV, WSP(float, WS_MOD) + MOD_KV + D, 2 * D, WSP(bf16, WS_KVN), nullptr, nullptr, nullptr, nullptr, nullptr, KIN(11), KIN(12), WSP(float, WS_LOGF),
                                       WSP(bf16, WS_XN), KH, false, KIN(4) + (L * 2 + 0) * D, MODP(L) + 0 * D, MODP(L) + 1 * D, 6 * D, WSP(bf16, WS_XN)); });
    } else {
        PHASE(P, true, { norm_phase<0>(F, KH, KIN(4) + (L * 2 + 0) * D, MODP(L) + 0 * D, MODP(L) + 1 * D, 6 * D, WSP(bf16, WS_XN), nullptr, nullptr, nullptr, nullptr, nullptr, nullptr, nullptr, nullptr); });
    }
    PHASE(P + 1, true, {
        if constexpr (L == 2) {
            if (blockIdx.x < 32) {
                const int bb = blockIdx.x >> 4, hh = blockIdx.x & 15; const float* lf = WSP(float, WS_LOGF) + (size_t)bb * SEQ * FH + hh; float* fo = WSP(float, WS_FL2) + (size_t)blockIdx.x * SEQ;
                LAS double* sc = (LAS double*)(F.lds + RING_OFF);
                float vals[32]; double s = 0.0;
_Pragma("unroll")
                for (int i = 0; i < 32; ++i) vals[i] = lf[(size_t)(F.tid * 32 + i) * FH];
_Pragma("unroll")
                for (int i = 0; i < 32; ++i) s += (double)vals[i];
                sc[F.tid] = s; __syncthreads();
                for (int off = 1; off < 512; off <<= 1) { double t = (F.tid >= off) ? sc[F.tid - off] : 0.0; __syncthreads(); sc[F.tid] += t; __syncthreads(); }
                double run = sc[F.tid] - s;
_Pragma("unroll")
                for (int i = 0; i < 32; ++i) { run += (double)vals[i]; fo[F.tid * 32 + i] = (float)run; }
                __syncthreads();
            }
            pg8::DenseOrder S{WSP(bf16, WS_KVN), WSP(bf16, W_KV), D, D, T / 256, 2 * D / 256, F.G, (int)blockIdx.x};
            pg8::EpiBf16 E{WSP(bf16, WS_K), D, D, (size_t)(WS_V - WS_K) / 2, 1.0f, WSP(unsigned, WS_CTL) + CW_NMAX};
            pg8::gemm_phase<pg8::EpiBf16, pg8::DenseOrder, false>(F.lds + RING_OFF, S, E, F.tid);
        }
        { pg8::DenseOrder S{WSP(bf16, WS_XN), WSP(bf16, W_QG) + (size_t)J * 2 * D * D, D, D, T / 256, 2 * D / 256, F.G, (int)blockIdx.x};
          pg8::EpiBf16 E{WSP(bf16, WS_Q), D, D, (size_t)(WS_G - WS_Q) / 2, QC2, WSP(unsigned, WS_CTL) + CW_NMAX + 64 * (1 + J)};
          pg8::gemm_phase<pg8::EpiBf16, pg8::DenseOrder, false>(F.lds + RING_OFF, S, E, F.tid); } });
    PHASE(P + 2, true, { const int vcu = F.vcu, s = vcu & 7, bh = vcu >> 3;
          if (F.G == 256) {
            for (int i = 0; i < 8; ++i) { const int base = 16 * (i >> 1); const int qb = (i & 1) ? base + 15 - s : base + s;
                attn_body::attn_unit<8>(bh / FH, bh % FH, qb, WSP(const attn_body::hbf16, WS_Q), WSP(const attn_body::hbf16, WS_K), WSP(const attn_body::hbf16, WS_V), WSP(const attn_body::hbf16, WS_G),
                                        WSP(const float, WS_FL2), WSP(const unsigned, WS_CTL) + CW_NMAX, J, WSP(attn_body::hbf16, WS_Q), (char*)ldsg + RING_OFF, F.tid);
                if constexpr (L == 2) { late_convert(F, i); if (i < 3) late_convert(F, 8 + i); } }
          } });
    PHASE(P + 3, true, { pg8::DenseOrder S{WSP(bf16, WS_Q), WSP(bf16, W_FO) + (size_t)J * D * D, D, D, T / 256, D / 256, F.G, (int)blockIdx.x};
          pg8::EpiResidT<true> E{KH, KH, MODP(L) + 2 * D, 6 * D};
          pg8::gemm_phase<pg8::EpiResidT<true>, pg8::DenseOrder, false>(F.lds + RING_OFF, S, E, F.tid); });
    ffn_part<L, P + 4>(F, bar, lo, hi);
}

__global__ void __launch_bounds__(NWAVES * 64, 2) yoco_fwd(Args args) {
    extern __shared__ __attribute__((aligned(16))) unsigned char lds[];
    Frame F;
    F.lds = (LAS unsigned char*)lds;
    F.MISC = (volatile LAS unsigned*)(F.lds + MISC_OFF);
    F.tid = threadIdx.x; F.lane = F.tid & 63; F.wave = __builtin_amdgcn_readfirstlane(F.tid >> 6);
    F.G = gridDim.x; { const int bx = blockIdx.x; F.vcu = (F.G % 8 == 0) ? (bx % 8) * (F.G / 8) + bx / 8 : bx; }
    F.ctl = (gu32*)(KWS + WS_CTL);
    for (int u = F.tid; u < (LDS_BYTES - LDSCTL_OFF) / 4; u += NWAVES * 64) ((LAS unsigned*)(F.lds + LDSCTL_OFF))[u] = 0u;
    __syncthreads();
    const XcdBarrier bar = xcd_barrier_post((unsigned*)(F.ctl + CW_BAR) + args.li * XCD_BAR_WORDS, F.MISC + 8);
    const int lo = args.ph_lo, hi = args.ph_hi;

    PHASE(0, true, {
    {
        LAS float* ca = (LAS float*)(F.lds + RING_OFF);
        LAS float* red = ca + 2048;
        { const float* cin = KIN(1); for (int i = F.tid; i < 2 * D; i += NWAVES * 64) ca[i] = fast_silu(cin[i]); }
        __syncthreads();
        constexpr int NCOLB = (4 * 6 * D + 2 * D + 2 * D) / 128;
        float* MOD = WSP(float, WS_MOD);
        for (int cb = blockIdx.x; cb < NCOLB; cb += F.G) {
            const int gc = cb * 128 + (F.tid & 127), kq = F.tid >> 7;
            const float* W; const float* bias; int ldw, n; float* outp; int ostride;
            if (gc < 4 * 6 * D) { const int l = gc / (6 * D); n = gc % (6 * D); W = KIN(2) + (size_t)l * D * 6 * D; ldw = 6 * D; bias = KIN(3) + l * 6 * D; outp = MOD + l * MOD_L; ostride = 6 * D; }
            else if (gc < 4 * 6 * D + 2 * D) { n = gc - 4 * 6 * D; W = KIN(7); ldw = 2 * D; bias = KIN(8); outp = MOD + MOD_KV; ostride = 2 * D; }
            else { n = gc - 4 * 6 * D - 2 * D; W = KIN(23); ldw = 2 * D; bias = KIN(24); outp = MOD + MOD_FIN; ostride = 2 * D; }
            float a0 = 0.f, a1 = 0.f; const float* wp = W + (size_t)(256 * kq) * ldw + n;
_Pragma("unroll 32")
            for (int k = 0; k < 256; ++k) { const float wv = wp[(size_t)k * ldw]; a0 += ca[256 * kq + k] * wv; a1 += ca[D + 256 * kq + k] * wv; }
            red[(kq * 2 + 0) * 128 + (F.tid & 127)] = a0; red[(kq * 2 + 1) * 128 + (F.tid & 127)] = a1;
            __syncthreads();
            if (F.tid < 256) { const int bb = F.tid >> 7, cl = F.tid & 127;
                const float s = (red[(0 * 2 + bb) * 128 + cl] + red[(1 * 2 + bb) * 128 + cl]) + (red[(2 * 2 + bb) * 128 + cl] + red[(3 * 2 + bb) * 128 + cl]);
                outp[(size_t)bb * ostride + n] = s + bias[n]; }
            __syncthreads();
        }
    }
    {
        f32x2* rope = WSP(f32x2, WS_ROPE);
        for (int i = blockIdx.x * (NWAVES * 64) + F.tid; i < SEQ * 128; i += F.G * NWAVES * 64) { const int pos = i >> 7, j = i & 127;
            const float inv = __builtin_amdgcn_exp2f(-(float)j * (13.287712379549449f / 128.0f));
            const float ang = (float)pos * inv;
            double tr = (double)ang * 0.15915494309189535; tr -= __builtin_rint(tr); const float tf = (float)tr;
            rope[i] = (f32x2){__builtin_amdgcn_cosf(tf), __builtin_amdgcn_sinf(tf)}; }
    }
    {
        __syncthreads();
        LAS float* tile = (LAS float*)(F.lds + RING_OFF);
        constexpr int NIT = 2 * 8 * 24 + 2 * 16 * 4 + 8 * 8 + 2 * 8 * 8 + 2 * 8 * 4 + 2 * 2 * 8 * 11 + 2 * 22 * 4 + 2 * 8 * 8 * 14 + 8 * 28 * 4;
        for (int it = F.vcu; it < NIT; it += F.G) { int r = it;
            if (conv_group_t(r, KIN(5), 2, D, 6 * D, WSP(unsigned char, W_RIN), (size_t)12 * MiB, 0, 0.f, tile, F.tid, 2 * D)) continue;
            if (conv_group_t(r, KIN(5) + 2 * D, 2, D, 6 * D, WSP(unsigned char, W_RIN) + 4 * MiB, (size_t)12 * MiB, 0, QS_WUP, tile, F.tid, 4 * D)) continue;
            if (conv_group_t(r, KIN(6), 2, 2 * D, D, WSP(unsigned char, W_RO), (size_t)2 * D * D * 2, 0, 0.f, tile, F.tid)) continue;
            if (conv_group_t(r, KIN(10), 1, D, 2 * D, WSP(unsigned char, W_KV), 0, 0, 0.f, tile, F.tid)) continue;
            if (conv_group_t(r, KIN(13), 2, D, 2 * D, WSP(unsigned char, W_QG), (size_t)2 * D * D * 2, 0, 0.f, tile, F.tid)) continue;
            if (conv_group_t(r, KIN(14), 2, D, D, WSP(unsigned char, W_FO), (size_t)D * D * 2, 0, 0.f, tile, F.tid)) continue;
            if (conv_group_t(r, KIN(15), 2, D, DFF, WSP(unsigned char, W_FUP), (size_t)2 * DFF * D, 1, QS_WUP, tile, F.tid)) continue;
            if (conv_group_t(r, KIN(16), 2, D, DFF, WSP(unsigned char, W_FUP), (size_t)2 * DFF * D, 2, QS_WUP, tile, F.tid)) continue;
            if (conv_group_t(r, KIN(17), 2, DFF, D, WSP(unsigned char, W_FDN), (size_t)DFF * D, 0, QS_WDN_F, tile, F.tid)) continue;
            if (conv_group_t(r, KIN(20), 8, D, DFE, WSP(unsigned char, W_MUP), (size_t)2 * DFE * D, 1, QS_WUP, tile, F.tid)) continue;
            if (conv_group_t(r, KIN(21), 8, D, DFE, WSP(unsigned char, W_MUP), (size_t)2 * DFE * D, 2, QS_WUP, tile, F.tid)) continue;
            conv_group_t(r, KIN(22), 8, DFE, D, WSP(unsigned char, W_MDN), (size_t)DFE * D, 0, QS_WDN_M, tile, F.tid);
        }
    }
    });
    ret_layer<0, 1>(F, bar, lo, hi);
    ret_layer<1, 10>(F, bar, lo, hi);
    fox_layer<2, 19>(F, bar, lo, hi, lds);
    fox_layer<3, 26>(F, bar, lo, hi, lds);
    PHASE(33, false, { norm_phase<3>(F, KH, KIN(25), WSP(float, WS_MOD) + MOD_FIN, WSP(float, WS_MOD) + MOD_FIN + D, 2 * D, nullptr, KOUT, nullptr, nullptr, nullptr, nullptr, nullptr, nullptr, nullptr, WSP(bf16, WS_XN), nullptr); });
#ifdef PROBE_LO
    if (blockIdx.x == 0 && F.tid == 0) { const unsigned long long t0 = ((unsigned long long)F.MISC[17] << 32) | F.MISC[16], t1 = ((unsigned long long)F.MISC[19] << 32) | F.MISC[18];
        const unsigned long long span = (t1 - t0) * PROBE_K, te = __builtin_amdgcn_s_memrealtime();
        while (__builtin_amdgcn_s_memrealtime() - te < span) __builtin_amdgcn_s_sleep(8); }
#endif
}

extern "C" void kernel_launch(void* const* d_in, const int* in_sizes, int n_in, void* d_out, int out_size, void* d_ws, size_t ws_size, hipStream_t stream) {
    static int grid = 0;
    if (grid == 0) {
        if (n_in != 26 || in_sizes[0] != T * D || out_size != T * D || ws_size < WS_END) { fprintf(stderr, "kernel_launch: unexpected shapes / workspace (n_in %d, ws %zu, need %zu)\n", n_in, ws_size, (size_t)WS_END); grid = -1; return; }
        int dev = 0, cus = 0;
        if (hipGetDevice(&dev) != hipSuccess || hipDeviceGetAttribute(&cus, hipDeviceAttributeMultiprocessorCount, dev) != hipSuccess) { grid = -1; return; }
        if (hipFuncSetAttribute((const void*)yoco_fwd, hipFuncAttributeMaxDynamicSharedMemorySize, LDS_BYTES) != hipSuccess) { fprintf(stderr, "kernel_launch: hipFuncSetAttribute failed\n"); grid = -1; return; }
        int per_cu = 0;
        if (hipOccupancyMaxActiveBlocksPerMultiprocessor(&per_cu, (const void*)yoco_fwd, NWAVES * 64, LDS_BYTES) != hipSuccess || per_cu < 1) { fprintf(stderr, "kernel_launch: occupancy query says %d\n", per_cu); }
        (void)hipGetLastError();
        grid = cus;
    }
    if (grid < 0) return;
    (void)hipMemsetAsync((char*)d_ws + WS_CTL, 0, CTL_ZERO_BYTES, stream);
    Args a{};
    for (int i = 0; i < 26; ++i) a.in[i] = (const float*)d_in[i];
    a.out = (float*)d_out; a.ws = (unsigned char*)d_ws;
    constexpr int NPH = 34;
#if MK_N_LAUNCHES == 1
    a.ph_lo = 0; a.ph_hi = NPH; a.li = 0; a.pad = 0;
    hipLaunchKernelGGL(yoco_fwd, dim3(grid), dim3(NWAVES * 64), LDS_BYTES, stream, a);
#else
    for (int p = 0; p < NPH; ++p) { a.ph_lo = p; a.ph_hi = p + 1; a.li = 0; a.pad = 0;
        hipLaunchKernelGGL(yoco_fwd, dim3(grid), dim3(NWAVES * 64), LDS_BYTES, stream, a); }
#endif
}
```

```cpp
#include <hip/hip_runtime.h>
#include <hip/hip_bf16.h>
#include <cstdio>
#include <cstdint>
#include <cmath>

#ifndef MK_N_LAUNCHES
#define MK_N_LAUNCHES 1
#endif

constexpr int BATCH = 2, SEQ = 16384, D = 1024, T = BATCH * SEQ;
constexpr int RH = 4, RQK = 256, RV = 512, PROJW = 6 * D;
constexpr int FH = 16, FD = 64;
constexpr int DFF = 2816, NE = 8, DFE = 3584;
constexpr float EPS = 1e-6f;
constexpr float LOG2E = 1.4426950408889634f;
#ifndef SKIP_LOG2
#define SKIP_LOG2 40.0f
#endif
constexpr float QS_X = 127.0f / 5.5f, QS_H = 127.0f / 9.5f, QS_WUP = 127.0f * 32.0f / 4.0f, QS_WDN_F = 127.0f * 53.066f / 4.0f  , QS_WDN_M = 127.0f * 59.867f / 4.0f  ;
constexpr float QC2 = 0.125f * 1.4426950408889634f;

#define GAS __attribute__((address_space(1)))
#define LAS __attribute__((address_space(3)))
typedef unsigned short bf16;
typedef unsigned v4u __attribute__((ext_vector_type(4)));
typedef unsigned v2u __attribute__((ext_vector_type(2)));
typedef float f32x4 __attribute__((ext_vector_type(4)));
typedef float f32x2 __attribute__((ext_vector_type(2)));
typedef short bf16x8 __attribute__((ext_vector_type(8)));
typedef short s16x4 __attribute__((ext_vector_type(4)));
typedef GAS unsigned gu32;
#define RLX_AGENT __ATOMIC_RELAXED, __HIP_MEMORY_SCOPE_AGENT
#define LDS_WAIT() asm volatile("s_waitcnt lgkmcnt(0)" ::: "memory")
#define VM_WAIT() asm volatile("s_waitcnt vmcnt(0)" ::: "memory")

__device__ __forceinline__ unsigned cvt_pk_bf16(float lo, float hi) { unsigned r; asm volatile("v_cvt_pk_bf16_f32 %0, %1, %2" : "=v"(r) : "v"(lo), "v"(hi)); return r; }
__device__ __forceinline__ float bf_lo(unsigned u) { return __uint_as_float(u << 16); }
__device__ __forceinline__ float bf_hi(unsigned u) { return __uint_as_float(u & 0xffff0000u); }
__device__ __forceinline__ float fast_sigmoid(float x) { return __builtin_amdgcn_rcpf(1.0f + __builtin_amdgcn_exp2f(-x * LOG2E)); }
__device__ __forceinline__ float fast_silu(float x) { return x * fast_sigmoid(x); }

constexpr size_t MiB = 1u << 20;
constexpr size_t WS_CTL = 0, CTL_ZERO_BYTES = 1 * MiB;
constexpr size_t WS_MOD = 1 * MiB;
constexpr size_t WS_LOGF = 2 * MiB;
constexpr size_t WS_FL2 = 4 * MiB;
constexpr size_t WS_LIST = 6 * MiB;
constexpr size_t WS_ROPE = 10 * MiB;
constexpr size_t WS_LST = 26 * MiB;
constexpr size_t WS_W = 64 * MiB;
constexpr size_t W_RIN = WS_W;
constexpr size_t W_RO = W_RIN + 2 * 12 * MiB;
constexpr size_t W_KV = W_RO + 2 * 4 * MiB;
constexpr size_t W_QG = W_KV + 4 * MiB;
constexpr size_t W_FO = W_QG + 2 * 4 * MiB;
constexpr size_t W_FUP = W_FO + 2 * 2 * MiB;
constexpr size_t W_FDN = W_FUP + 2 * 11 * MiB;
constexpr size_t W_MUP = W_FDN + 11 * MiB;
constexpr size_t W_MDN = W_MUP + 16 * 14 * MiB;
constexpr size_t WS_XN = W_MDN + 16 * 7 * MiB;
constexpr size_t WS_BIG = WS_XN + 64 * MiB;
constexpr size_t WS_PROJ = WS_BIG;
constexpr size_t WS_Q = WS_BIG, WS_G = WS_BIG + 64 * MiB, WS_K = WS_BIG + 256 * MiB, WS_V = WS_BIG + 320 * MiB;
constexpr size_t WS_XN8 = WS_BIG + 384 * MiB;
constexpr size_t WS_HID = WS_BIG;
constexpr int HID_ROWS = 2 * T + NE * 256;
constexpr size_t WS_H = WS_BIG + 462 * MiB;
constexpr size_t WS_END = WS_H + 64 * MiB;
static_assert(WS_XN == 481 * MiB && WS_END == 1071 * MiB && (size_t)HID_ROWS * DFE * 2 <= 462 * MiB, "ws map");

constexpr int MOD_L = 2 * 6 * D;
constexpr int MOD_KV = 4 * MOD_L, MOD_FIN = MOD_KV + 2 * 2 * D;
constexpr int CW_BAR = 4096;
constexpr int CW_MOE = 16384;
constexpr int CW_NMAX = 24576;
constexpr int CW_DBG = 32768;

namespace pg8 {
constexpr int BM = 256, BK = 64, HALF = 128, HTB = HALF * BK * 2, STAGE_BYTES = 8 * HTB, NXCD = 8, WGM = 2;
__host__ __device__ __forceinline__ int lds_byte(int r, int c) { const int st = (r >> 4) * 2 + (c >> 5), rr = r & 15, cc = c & 31, ob = rr * 64 + cc * 2; return st * 1024 + (ob ^ (((ob >> 9) & 1) << 5)); }
__host__ __device__ __forceinline__ void stage_rc(int b, int& R, int& C) { const int st = b / 1024, sb = b % 1024, swz = sb ^ (((sb >> 9) & 1) << 5); R = (st >> 1) * 16 + swz / 64; C = (st & 1) * 32 + (swz % 64) / 2; }
__host__ __device__ __forceinline__ int perm32(int rho) { const int n = rho >> 4, i = rho & 15; return 8 * (i >> 2) + 4 * n + (i & 3); }

__device__ __forceinline__ float acc_i2f(float bits);
struct Unit { int pm, pn, e, mt; };

__device__ __forceinline__ bool order_tile(int i, int G, int c, int nM, int nN, int& pm, int& pn) {
    const int nwg = nM * nN; const long L = (long)i * G + c; if (L >= nwg) return false;
    int wgid = (int)L; { const int q = nwg / NXCD, r = nwg % NXCD, xcd = wgid % NXCD, off = wgid / NXCD; wgid = (xcd < r ? xcd * (q + 1) : r * (q + 1) + (xcd - r) * q) + off; }
    const int nig = WGM * nN, gid = wgid / nig, fm = gid * WGM, gsz = (nM - fm) < WGM ? (nM - fm) : WGM;
    pm = fm + ((wgid % nig) % gsz); pn = (wgid % nig) / gsz; return true;
}
struct DenseOrder {
    const bf16* A; const bf16* Bt; int lda, K, nM, nN, G, c;
    __device__ __forceinline__ bool next(int i, Unit& u) const { u.e = 0; u.mt = 0; return order_tile(i, G, c, nM, nN, u.pm, u.pn); }
    __device__ __forceinline__ const char* a_tile(const Unit& u) const { return (const char*)A + (size_t)u.pm * BM * lda * 2; }
    __device__ __forceinline__ const char* b_tile(const Unit& u) const { return (const char*)Bt + (size_t)u.pn * BM * K * 2; }
    __device__ __forceinline__ int row_tok(const Unit&, int) const { return 0; }
};
struct MoeOrder {
    const bf16* A; const bf16* Bt; int lda, K, nN, G, c; size_t bstride  ; const int2* list  ; const LAS int* tb; bool gather;
    __device__ __forceinline__ bool next(int i, Unit& u) const {
        const int ntile = tb[8]; const int nwg = ntile * nN; const long L = (long)i * G + c; if (L >= nwg) return false;
        int wgid = (int)L; { const int q = nwg / NXCD, r = nwg % NXCD, xcd = wgid % NXCD, off = wgid / NXCD; wgid = (xcd < r ? xcd * (q + 1) : r * (q + 1) + (xcd - r) * q) + off; }
        if (!gather) wgid = nwg - 1 - wgid;
        int e = 0;
#pragma unroll
        for (int j = 1; j < 8; ++j) if (wgid >= tb[j] * nN) e = j;
        const int tbase = tb[e], nM = tb[e + 1] - tbase, local = wgid - tbase * nN;
        const int nig = WGM * nN, gid = local / nig, fm = gid * WGM, gsz = (nM - fm) < WGM ? (nM - fm) : WGM;
        u.mt = fm + ((local % nig) % gsz); u.pn = (local % nig) / gsz; u.e = e; u.pm = tbase + u.mt; return true;
    }
    __device__ __forceinline__ const char* a_tile(const Unit& u) const { return gather ? (const char*)A : (const char*)A + (size_t)u.pm * BM * lda * 2; }
    __device__ __forceinline__ const char* b_tile(const Unit& u) const { return (const char*)Bt + ((size_t)u.e * bstride + (size_t)u.pn * BM * K) * 2; }
    __device__ __forceinline__ int row_tok(const Unit& u, int r) const { const int idx = u.mt * BM + r; const int cnt = tb[16 + u.e]; return idx < cnt ? (list[(size_t)u.e * T + idx].x & 0x3fffffff) : 0; }
};

struct EpiBf16 {
    static constexpr bool PERM = true;
    bf16* O; int ldc; int split_cols; size_t split_stride; float scale0;
    unsigned* nmax;
    __device__ __forceinline__ void operator()(const f32x4 (&acc)[2][2][4][2], const Unit& u, int wr, int wc, int fr, int fq) const {
        const int row0 = u.pm * BM + wr * 64 + fr; int colt = u.pn * BM; bf16* base = O;
        float sc = 1.f; int t = 0; if (split_cols) { t = colt / split_cols; base += (size_t)t * split_stride; colt -= t * split_cols; if (t == 0) sc = scale0; }
        const int col0 = colt + wc * 32 + 8 * fq;
        const bool track = (nmax != nullptr) && (t == 0);
        float mx[2] = {0.f, 0.f};
#pragma unroll
        for (int ai = 0; ai < 2; ++ai)
#pragma unroll
            for (int m = 0; m < 4; ++m) { bf16* rowp = base + (size_t)(row0 + ai * HALF + m * 16) * ldc + col0;
#pragma unroll
                for (int bj = 0; bj < 2; ++bj) { const f32x4 v0 = acc[ai][bj][m][0] * sc, v1 = acc[ai][bj][m][1] * sc;
                    v4u w; w.x = cvt_pk_bf16(v0[0], v0[1]); w.y = cvt_pk_bf16(v0[2], v0[3]); w.z = cvt_pk_bf16(v1[0], v1[1]); w.w = cvt_pk_bf16(v1[2], v1[3]);
                    *(v4u*)(rowp + bj * HALF) = w;
                    if (track) { float s = 0.f;
#pragma unroll
                        for (int q = 0; q < 4; ++q) { const float a = bf_lo(w[q]), b = bf_hi(w[q]); s += a * a + b * b; }
                        s += __shfl_xor(s, 16); s += __shfl_xor(s, 32); mx[bj] = fmaxf(mx[bj], s); } } }
        if (track) {
#pragma unroll
            for (int bj = 0; bj < 2; ++bj) { float v = mx[bj];
#pragma unroll
                for (int o = 1; o < 16; o <<= 1) v = fmaxf(v, __shfl_xor(v, o));
                if (fr == 0 && fq == 0) { const int head = colt / 64 + 2 * bj + (wc >> 1), bb = (u.pm * BM) / SEQ;
                    __hip_atomic_fetch_max(nmax + ((bb * 16 + head) * 2 + (wc & 1)), __float_as_uint(v), __ATOMIC_RELAXED, __HIP_MEMORY_SCOPE_AGENT); } }
        }
    }
};
struct EpiI8Bf16 {
    static constexpr bool PERM = true;
    bf16* O; int ldc; int coloff; float ascale;
    __device__ __forceinline__ void operator()(const f32x4 (&acc)[2][2][4][2], const Unit& u, int wr, int wc, int fr, int fq) const {
        const int row0 = u.pm * BM + wr * 64 + fr, col0 = coloff + u.pn * BM + wc * 32 + 8 * fq;
#pragma unroll
        for (int ai = 0; ai < 2; ++ai)
#pragma unroll
            for (int m = 0; m < 4; ++m) { bf16* rowp = O + (size_t)(row0 + ai * HALF + m * 16) * ldc + col0;
#pragma unroll
                for (int bj = 0; bj < 2; ++bj) { const f32x4 a0 = acc[ai][bj][m][0], a1 = acc[ai][bj][m][1];
                    v4u w; w.x = cvt_pk_bf16(acc_i2f(a0[0]) * ascale, acc_i2f(a0[1]) * ascale); w.y = cvt_pk_bf16(acc_i2f(a0[2]) * ascale, acc_i2f(a0[3]) * ascale);
                    w.z = cvt_pk_bf16(acc_i2f(a1[0]) * ascale, acc_i2f(a1[1]) * ascale); w.w = cvt_pk_bf16(acc_i2f(a1[2]) * ascale, acc_i2f(a1[3]) * ascale);
                    *(v4u*)(rowp + bj * HALF) = w; } }
    }
};
struct EpiRetIn {
    static constexpr bool PERM = true;
    bf16* O; const f32x2* rope; float ascale;
    __device__ __forceinline__ void operator()(const f32x4 (&acc)[2][2][4][2], const Unit& u, int wr, int wc, int fr, int fq) const {
        const int row0 = u.pm * BM + wr * 64 + fr; const int col0 = u.pn * BM + wc * 32 + 8 * fq;
        const bool rot = u.pn < 8; const float ksc = ((u.pn >= 4 && u.pn < 8) ? 0.0625f : 1.0f) * ascale;
#pragma unroll
        for (int ai = 0; ai < 2; ++ai)
#pragma unroll
            for (int m = 0; m < 4; ++m) { const int row = row0 + ai * HALF + m * 16; bf16* rowp = O + (size_t)row * PROJW + col0;
                f32x4 a0 = acc[ai][0][m][0], a1 = acc[ai][0][m][1], b0 = acc[ai][1][m][0], b1 = acc[ai][1][m][1];
                a0 = (f32x4){acc_i2f(a0[0]), acc_i2f(a0[1]), acc_i2f(a0[2]), acc_i2f(a0[3])} * ksc; a1 = (f32x4){acc_i2f(a1[0]), acc_i2f(a1[1]), acc_i2f(a1[2]), acc_i2f(a1[3])} * ksc;
                b0 = (f32x4){acc_i2f(b0[0]), acc_i2f(b0[1]), acc_i2f(b0[2]), acc_i2f(b0[3])} * ksc; b1 = (f32x4){acc_i2f(b1[0]), acc_i2f(b1[1]), acc_i2f(b1[2]), acc_i2f(b1[3])} * ksc;
                if (rot) { const f32x4* rp = (const f32x4*)(rope + (size_t)(row & (SEQ - 1)) * 128 + wc * 32 + 8 * fq);
                    const f32x4 r0 = rp[0], r1 = rp[1], r2 = rp[2], r3 = rp[3];
                    f32x4 x, y;
                    x = a0; y = b0; a0 = (f32x4){x[0] * r0[0] - y[0] * r0[1], x[1] * r0[2] - y[1] * r0[3], x[2] * r1[0] - y[2] * r1[1], x[3] * r1[2] - y[3] * r1[3]};
                                    b0 = (f32x4){y[0] * r0[0] + x[0] * r0[1], y[1] * r0[2] + x[1] * r0[3], y[2] * r1[0] + x[2] * r1[1], y[3] * r1[2] + x[3] * r1[3]};
                    x = a1; y = b1; a1 = (f32x4){x[0] * r2[0] - y[0] * r2[1], x[1] * r2[2] - y[1] * r2[3], x[2] * r3[0] - y[2] * r3[1], x[3] * r3[2] - y[3] * r3[3]};
                                    b1 = (f32x4){y[0] * r2[0] + x[0] * r2[1], y[1] * r2[2] + x[1] * r2[3], y[2] * r3[0] + x[2] * r3[1], y[3] * r3[2] + x[3] * r3[3]}; }
                v4u w; w.x = cvt_pk_bf16(a0[0], a0[1]); w.y = cvt_pk_bf16(a0[2], a0[3]); w.z = cvt_pk_bf16(a1[0], a1[1]); w.w = cvt_pk_bf16(a1[2], a1[3]);
                *(v4u*)(rowp) = w;
                w.x = cvt_pk_bf16(b0[0], b0[1]); w.y = cvt_pk_bf16(b0[2], b0[3]); w.z = cvt_pk_bf16(b1[0], b1[1]); w.w = cvt_pk_bf16(b1[2], b1[3]);
                *(v4u*)(rowp + HALF) = w; }
    }
};
template <bool BASE_BF> struct EpiResidT {
    static constexpr bool PERM = true;
    const void* base; bf16* out; const float* gates; int gstride; float ascale = 1.0f; bool i8 = false;
    __device__ __forceinline__ void operator()(const f32x4 (&acc)[2][2][4][2], const Unit& u, int wr, int wc, int fr, int fq) const {
        const int row0 = u.pm * BM + wr * 64 + fr, col0 = u.pn * BM + wc * 32 + 8 * fq;
        const float* gp = gates + (size_t)((u.pm * BM) / SEQ) * gstride + col0;
        f32x4 gv[2][2];
#pragma unroll
        for (int bj = 0; bj < 2; ++bj)
#pragma unroll
            for (int n = 0; n < 2; ++n) gv[bj][n] = *(const f32x4*)(gp + bj * HALF + n * 4) * ascale;
#pragma unroll
        for (int ai = 0; ai < 2; ++ai)
#pragma unroll
            for (int m = 0; m < 4; ++m) { const size_t off = (size_t)(row0 + ai * HALF + m * 16) * D + col0;
#pragma unroll
                for (int bj = 0; bj < 2; ++bj) { f32x4 a0 = acc[ai][bj][m][0], a1 = acc[ai][bj][m][1];
                    if (i8) { a0 = (f32x4){acc_i2f(a0[0]), acc_i2f(a0[1]), acc_i2f(a0[2]), acc_i2f(a0[3])}; a1 = (f32x4){acc_i2f(a1[0]), acc_i2f(a1[1]), acc_i2f(a1[2]), acc_i2f(a1[3])}; }
                    f32x4 b0, b1;
                    if constexpr (BASE_BF) { const v4u w = *(const v4u*)((const bf16*)base + off + bj * HALF); b0 = (f32x4){bf_lo(w.x), bf_hi(w.x), bf_lo(w.y), bf_hi(w.y)}; b1 = (f32x4){bf_lo(w.z), bf_hi(w.z), bf_lo(w.w), bf_hi(w.w)}; }
                    else { b0 = *(const f32x4*)((const float*)base + off + bj * HALF); b1 = *(const f32x4*)((const float*)base + off + bj * HALF + 4); }
                    const f32x4 o0 = b0 + gv[bj][0] * a0, o1 = b1 + gv[bj][1] * a1;
                    v4u w; w.x = cvt_pk_bf16(o0[0], o0[1]); w.y = cvt_pk_bf16(o0[2], o0[3]); w.z = cvt_pk_bf16(o1[0], o1[1]); w.w = cvt_pk_bf16(o1[2], o1[3]);
                    *(v4u*)(out + off + bj * HALF) = w; } }
    }
};
__device__ __forceinline__ unsigned pk4_fp8(float a, float b, float c, float d) {
    const float M = 12582912.0f;
    const unsigned ua = __float_as_uint(__builtin_amdgcn_fmed3f(a, -127.f, 127.f) + M), ub = __float_as_uint(__builtin_amdgcn_fmed3f(b, -127.f, 127.f) + M);
    const unsigned uc = __float_as_uint(__builtin_amdgcn_fmed3f(c, -127.f, 127.f) + M), ud = __float_as_uint(__builtin_amdgcn_fmed3f(d, -127.f, 127.f) + M);
    const unsigned lo = __builtin_amdgcn_perm(ub, ua, 0x0c0c0400u), hi = __builtin_amdgcn_perm(ud, uc, 0x04000c0cu);
    return lo | hi;
}
__device__ __forceinline__ float clamp8(float x) { return x; }
__device__ __forceinline__ float acc_i2f(float bits) { return (float)__builtin_bit_cast(int, bits); }
template <bool OUT8> struct EpiSwigluT {
    static constexpr bool PERM = true;
    bf16* O; int ldc; float ascale; float oscale;
    __device__ __forceinline__ void operator()(const f32x4 (&acc)[2][2][4][2], const Unit& u, int wr, int wc, int fr, int fq) const {
        const int row0 = u.pm * BM + wr * 64 + fr, col0 = u.pn * HALF + wc * 32 + 8 * fq;
#pragma unroll
        for (int ai = 0; ai < 2; ++ai)
#pragma unroll
            for (int m = 0; m < 4; ++m) {
                float h[8];
#pragma unroll
                for (int n = 0; n < 2; ++n)
#pragma unroll
                    for (int i = 0; i < 4; ++i) { const float gv_ = OUT8 ? acc_i2f(acc[ai][0][m][n][i]) : acc[ai][0][m][n][i], uv_ = OUT8 ? acc_i2f(acc[ai][1][m][n][i]) : acc[ai][1][m][n][i];
                        const float e_ = __builtin_amdgcn_exp2f(gv_ * (-ascale * LOG2E));
                        h[n * 4 + i] = (gv_ * uv_) * (__builtin_amdgcn_rcpf(1.0f + e_) * (ascale * ascale * oscale)); }
                if (OUT8) { unsigned char* rowp = (unsigned char*)O + (size_t)(row0 + ai * HALF + m * 16) * ldc + col0;
                    v2u w; w.x = pk4_fp8(clamp8(h[0]), clamp8(h[1]), clamp8(h[2]), clamp8(h[3])); w.y = pk4_fp8(clamp8(h[4]), clamp8(h[5]), clamp8(h[6]), clamp8(h[7])); *(v2u*)rowp = w; }
                else { bf16* rowp = O + (size_t)(row0 + ai * HALF + m * 16) * ldc + col0;
                    v4u w; w.x = cvt_pk_bf16(h[0], h[1]); w.y = cvt_pk_bf16(h[2], h[3]); w.z = cvt_pk_bf16(h[4], h[5]); w.w = cvt_pk_bf16(h[6], h[7]); *(v4u*)(rowp) = w; } }
    }
};
struct EpiMoeDown {
    static constexpr bool PERM = true;
    bf16* H; bf16* Y1; const float* gates; int gstride; const int2* list; const LAS int* tb; float ascale;
    __device__ __forceinline__ void operator()(const f32x4 (&acc)[2][2][4][2], const Unit& u, int wr, int wc, int fr, int fq) const {
        const int col0 = u.pn * BM + wc * 32 + 8 * fq; const int cnt = tb[16 + u.e];
#pragma unroll
        for (int ai = 0; ai < 2; ++ai)
#pragma unroll
            for (int m = 0; m < 4; ++m) { const int idx = u.mt * BM + ai * HALF + wr * 64 + m * 16 + fr;
                if (idx < cnt) { const int2 tw = list[(size_t)u.e * T + idx]; const float w = __int_as_float(tw.y) * ascale; const int tok = tw.x & 0x3fffffff;
                    const float* gp = gates + (size_t)(tok / SEQ) * gstride + col0;
                    bf16* dp = ((tw.x >> 30) == 0 ? H : Y1) + (size_t)tok * D + col0; const bool rmw = (tw.x >> 30) == 0;
#pragma unroll
                    for (int bj = 0; bj < 2; ++bj) { const f32x4 g0 = *(const f32x4*)(gp + bj * HALF) * w, g1 = *(const f32x4*)(gp + bj * HALF + 4) * w;
                        const f32x4 a0 = (f32x4){acc_i2f(acc[ai][bj][m][0][0]), acc_i2f(acc[ai][bj][m][0][1]), acc_i2f(acc[ai][bj][m][0][2]), acc_i2f(acc[ai][bj][m][0][3])};
                        const f32x4 a1 = (f32x4){acc_i2f(acc[ai][bj][m][1][0]), acc_i2f(acc[ai][bj][m][1][1]), acc_i2f(acc[ai][bj][m][1][2]), acc_i2f(acc[ai][bj][m][1][3])};
                        f32x4 o0 = g0 * a0, o1 = g1 * a1;
                        if (rmw) { const v4u hw = *(const v4u*)(dp + bj * HALF);
                            o0 = o0 + (f32x4){bf_lo(hw.x), bf_hi(hw.x), bf_lo(hw.y), bf_hi(hw.y)}; o1 = o1 + (f32x4){bf_lo(hw.z), bf_hi(hw.z), bf_lo(hw.w), bf_hi(hw.w)}; }
                        v4u ow; ow.x = cvt_pk_bf16(o0[0], o0[1]); ow.y = cvt_pk_bf16(o0[2], o0[3]); ow.z = cvt_pk_bf16(o1[0], o1[1]); ow.w = cvt_pk_bf16(o1[2], o1[3]);
                        *(v4u*)(dp + bj * HALF) = ow; } } }
    }
};

template <class Epi, class Sched, bool GATHER, bool FP8 = false>
__device__ __forceinline__ void gemm_phase(LAS unsigned char* lds, const Sched& S, const Epi& E, const int tid) {
    const int wid = __builtin_amdgcn_readfirstlane(tid >> 6), lane = tid & 63, wr = wid >> 2, wc = wid & 3, fr = lane & 15, fq = lane >> 4;
    const int K = S.K, lda = S.lda, nt = K / BK;
    int RA[2], CA[2]; unsigned voffB[2];
#pragma unroll
    for (int i = 0; i < 2; ++i) { int R, C; stage_rc(tid * 16 + i * 8192, R, C); const int Rb = Epi::PERM ? ((R & ~31) + perm32(R & 31)) : R;
        RA[i] = R; CA[i] = C; voffB[i] = (unsigned)(Rb * K + C) * 2u; }
    const size_t kstep = (size_t)(BK * 2);
    const size_t hstepB = (size_t)HALF * K * 2;
    const unsigned ldsw = (unsigned)wid * 1024u;
    const int aoff = lds_byte(wr * 64 + fr, fq * 8), boff = lds_byte(wc * 32 + fr, fq * 8);
#define PG8_SA(b, h) (((b) * 2 + (h)) * HTB)
#define PG8_SB(b, h) ((4 + (b) * 2 + (h)) * HTB)
#define PG8_STAGE2(bufoff, gbase, v0, v1) do { \
        __builtin_amdgcn_global_load_lds((const unsigned*)((const char*)(gbase) + (v0)), (LAS unsigned*)(lds + (bufoff) + ldsw), 16, 0, 0); \
        __builtin_amdgcn_global_load_lds((const unsigned*)((const char*)(gbase) + (v1)), (LAS unsigned*)(lds + (bufoff) + ldsw + 8192), 16, 0, 0); } while (0)
#define PG8_STA(b, h, ptr, V) PG8_STAGE2(PG8_SA(b, h), ptr, V[h][0], V[h][1])
#define PG8_STB(b, h, ptr) PG8_STAGE2(PG8_SB(b, h), (ptr) + (h) * hstepB, voffB[0], voffB[1])
    typedef int v4i_ __attribute__((ext_vector_type(4)));
#define PG8_LDA(dst, b, h) do { _Pragma("unroll") for (int m = 0; m < 4; ++m) _Pragma("unroll") for (int k = 0; k < 2; ++k) dst[m][k] = *(const LAS bf16x8*)(lds + PG8_SA(b, h) + aoff + m * 2048 + k * 1024); } while (0)
#define PG8_LDB(dst, b, h) do { _Pragma("unroll") for (int n = 0; n < 2; ++n) _Pragma("unroll") for (int k = 0; k < 2; ++k) dst[n][k] = *(const LAS bf16x8*)(lds + PG8_SB(b, h) + boff + n * 2048 + k * 1024); } while (0)
#define PG8_MMA(ai, bj, At, Bt) do { __builtin_amdgcn_s_setprio(1); _Pragma("unroll") for (int m = 0; m < 4; ++m) _Pragma("unroll") for (int n = 0; n < 2; ++n) _Pragma("unroll") for (int k = 0; k < 2; ++k) { \
        if constexpr (FP8) acc[ai][bj][m][n] = __builtin_bit_cast(f32x4, __builtin_amdgcn_mfma_i32_16x16x64_i8(__builtin_bit_cast(v4i_, Bt[n][k]), __builtin_bit_cast(v4i_, At[m][k]), __builtin_bit_cast(v4i_, acc[ai][bj][m][n]), 0, 0, 0)); \
        else acc[ai][bj][m][n] = __builtin_amdgcn_mfma_f32_16x16x32_bf16(Bt[n][k], At[m][k], acc[ai][bj][m][n], 0, 0, 0); } \
        __builtin_amdgcn_s_setprio(0); } while (0)
#define PG8_WAIT_V(n) asm volatile("s_waitcnt vmcnt(" #n ")" ::: "memory")
#define PG8_WAIT_L(n) asm volatile("s_waitcnt lgkmcnt(" #n ")" ::: "memory")
#define PG8_BAR __builtin_amdgcn_s_barrier()
#define PG8_SCHED __builtin_amdgcn_sched_barrier(0)
    Unit cur, nxt; int ui = 0;
    if (!S.next(0, cur)) return;
    unsigned cv[2][2], nv[2][2];
#pragma unroll
    for (int h = 0; h < 2; ++h)
#pragma unroll
        for (int i = 0; i < 2; ++i) { const int rr = RA[i] + HALF * h; cv[h][i] = (unsigned)((GATHER ? S.row_tok(cur, rr) : rr) * lda + CA[i]) * 2u; nv[h][i] = cv[h][i]; }
    if (GATHER) { asm volatile("s_waitcnt vmcnt(0)" : "+v"(cv[0][0]), "+v"(cv[0][1]), "+v"(cv[1][0]), "+v"(cv[1][1]) :: "memory"); }
    f32x4 acc[2][2][4][2];
#pragma unroll
    for (int a = 0; a < 2; ++a)
#pragma unroll
        for (int b = 0; b < 2; ++b)
#pragma unroll
            for (int m = 0; m < 4; ++m)
#pragma unroll
                for (int n = 0; n < 2; ++n) acc[a][b][m][n] = (f32x4){0.f, 0.f, 0.f, 0.f};
    bf16x8 At[4][2], B0[2][2], B1[2][2];
    const char* cA = S.a_tile(cur); const char* cB = S.b_tile(cur);
    PG8_STB(0, 0, cB); PG8_STB(0, 1, cB); PG8_STA(0, 0, cA, cv); PG8_STA(0, 1, cA, cv);
    if (wr == 1) PG8_BAR;
    PG8_WAIT_V(2); PG8_BAR;
    PG8_STB(1, 0, cB + kstep); PG8_STA(1, 0, cA + kstep, cv); PG8_STB(1, 1, cB + kstep);
    PG8_WAIT_V(6); PG8_BAR;
    for (;;) {
        const bool has_next = S.next(ui + 1, nxt);
        const char* nA = has_next ? S.a_tile(nxt) : cA; const char* nB = has_next ? S.b_tile(nxt) : cB;
        if (GATHER) {
            if (has_next) {
#pragma unroll
                for (int h = 0; h < 2; ++h)
#pragma unroll
                    for (int i = 0; i < 2; ++i) nv[h][i] = (unsigned)(S.row_tok(nxt, RA[i] + HALF * h) * lda + CA[i]) * 2u;
            }
            asm volatile("s_waitcnt vmcnt(0)" : "+v"(nv[0][0]), "+v"(nv[0][1]), "+v"(nv[1][0]), "+v"(nv[1][1]) :: "memory");
        }
        for (int t = 0; t < nt; t += 2) {
            const bool last = (t == nt - 2);
            const char* a1 = cA + (size_t)(t + 1) * kstep;
            const char* a2 = last ? nA : cA + (size_t)(t + 2) * kstep; const char* b2 = last ? nB : cB + (size_t)(t + 2) * kstep;
            const char* a3 = a2 + kstep; const char* b3 = b2 + kstep;
            unsigned v2[2][2];
#pragma unroll
            for (int h = 0; h < 2; ++h)
#pragma unroll
                for (int i = 0; i < 2; ++i) v2[h][i] = GATHER ? (last ? nv[h][i] : cv[h][i]) : cv[h][i];
            PG8_LDB(B0, 0, 0); PG8_LDB(B1, 0, 1); PG8_SCHED; PG8_LDA(At, 0, 0); PG8_STA(1, 1, a1, cv);
            PG8_WAIT_V(8); PG8_WAIT_L(0); PG8_BAR; PG8_MMA(0, 0, At, B0); PG8_MMA(0, 1, At, B1); PG8_BAR; PG8_SCHED;
            PG8_LDA(At, 0, 1); PG8_STB(0, 0, b2); PG8_STB(0, 1, b2); PG8_STA(0, 0, a2, v2);
            PG8_WAIT_V(8); PG8_WAIT_L(0); PG8_BAR; PG8_MMA(1, 0, At, B0); PG8_MMA(1, 1, At, B1); PG8_BAR; PG8_SCHED;
            PG8_LDB(B0, 1, 0); PG8_LDB(B1, 1, 1); PG8_SCHED; PG8_LDA(At, 1, 0); PG8_STA(0, 1, a2, v2);
            PG8_WAIT_V(8); PG8_WAIT_L(0); PG8_BAR; PG8_MMA(0, 0, At, B0); PG8_MMA(0, 1, At, B1); PG8_BAR; PG8_SCHED;
            PG8_LDA(At, 1, 1); PG8_STB(1, 0, b3); PG8_STB(1, 1, b3); PG8_STA(1, 0, a3, v2);
            PG8_WAIT_V(8); PG8_WAIT_L(0); PG8_BAR; PG8_MMA(1, 0, At, B0); PG8_MMA(1, 1, At, B1); PG8_BAR; PG8_SCHED;
        }
        if (wr == 0) PG8_BAR;
        E(acc, cur, wr, wc, fr, fq);
        if (!has_next) break;
#pragma unroll
        for (int a = 0; a < 2; ++a)
#pragma unroll
            for (int b = 0; b < 2; ++b)
#pragma unroll
                for (int m = 0; m < 4; ++m)
#pragma unroll
                    for (int n = 0; n < 2; ++n) acc[a][b][m][n] = (f32x4){0.f, 0.f, 0.f, 0.f};
        cur = nxt; cA = nA; cB = nB; ++ui;
#pragma unroll
        for (int h = 0; h < 2; ++h)
#pragma unroll
            for (int i = 0; i < 2; ++i) cv[h][i] = nv[h][i];
        if (wr == 1) PG8_BAR;
    }
    PG8_WAIT_V(0);
    PG8_BAR;
#undef PG8_SA
#undef PG8_SB
#undef PG8_STAGE2
#undef PG8_STA
#undef PG8_STB
#undef PG8_LDA
#undef PG8_LDB
#undef PG8_MMA
#undef PG8_WAIT_V
#undef PG8_WAIT_L
#undef PG8_BAR
#undef PG8_SCHED
}
}

namespace attn_body {
using hbf16 = __hip_bfloat16;
using f32x16 = __attribute__((ext_vector_type(16))) float;
using u32x4 = __attribute__((ext_vector_type(4))) unsigned;
constexpr int NHEAD = FH, DH = 64, DM = NHEAD * DH;
constexpr int NW = 8, QBLK = 32, QB = QBLK * NW, KVBLK = 64, NQB = SEQ / QB;
__device__ __forceinline__ int crow(int r, int hi) { return (r & 3) + 8 * (r >> 2) + 4 * hi; }
#define SBAR() __builtin_amdgcn_sched_barrier(0)
__device__ __forceinline__ void cmask(f32x16& p0, f32x16& p1, int jb, int qrel, int hi) {
  const float NEG = -INFINITY; int kb = 64 * jb + 4 * hi;
  #pragma unroll
  for (int r = 0; r < 16; ++r) { int kv = kb + (r & 3) + 8 * (r >> 2); if (kv > qrel) p0[r] = NEG; if (kv + 32 > qrel) p1[r] = NEG; }
}
constexpr int NSLOT = 3, SLOTB = 8192;
constexpr int LDS_K = 0, LDS_V = NSLOT * SLOTB, LDS_WS = 2 * NSLOT * SLOTB, LDS_OST = LDS_WS + NW * 64 * 4, LDS_BIAS = LDS_OST + NW * 4096, LDS_BYTES = LDS_BIAS + SEQ * 4;
__device__ __forceinline__ void glds16(const void* gsrc, unsigned lds_dst) { unsigned keep;
  asm volatile("s_mov_b32 %0, m0\n\ts_mov_b32 m0, %2\n\ts_nop 0\n\tglobal_load_lds_dwordx4 %1, off\n\ts_mov_b32 m0, %0" : "=&s"(keep) : "v"(gsrc), "s"(lds_dst) : "memory"); }
__device__ __forceinline__ float max3f(float a, float b, float c) { float r; asm("v_max3_f32 %0, %1, %2, %3" : "=v"(r) : "v"(a), "v"(b), "v"(c)); return r; }
__device__ __forceinline__ float max2f(float a, float b) { float r; asm("v_max_f32_e32 %0, %1, %2" : "=v"(r) : "v"(a), "v"(b)); return r; }
__device__ __forceinline__ float fadd_s(float a, float b) { float r; asm("v_add_f32_e32 %0, %1, %2" : "=v"(r) : "v"(a), "v"(b)); return r; }
__device__ __forceinline__ float fsub_s(float a, float b) { float r; asm("v_sub_f32_e32 %0, %1, %2" : "=v"(r) : "v"(a), "v"(b)); return r; }
typedef float f32x2_t __attribute__((ext_vector_type(2))); typedef __bf16 bf16x2_t __attribute__((ext_vector_type(2)));
__device__ __forceinline__ unsigned cvtpk_s(float lo, float hi) { f32x2_t v = {lo, hi}; bf16x2_t b = __builtin_convertvector(v, bf16x2_t); return __builtin_bit_cast(unsigned, b); }
#define WAIT_BAR(N) asm volatile("s_waitcnt vmcnt(" #N ") lgkmcnt(0)\n\ts_barrier" ::: "memory")

__device__ __forceinline__ void qkt(f32x16& p0, f32x16& p1, const char* Kslot, const bf16x8* qr, int r32, int hi) { const f32x16 zero16 = f32x16{};
  const char* kb = Kslot + hi * 1024 + r32 * 16;
  #pragma unroll
  for (int d0 = 0; d0 < 4; ++d0) {
    const bf16x8 b0 = *reinterpret_cast<const bf16x8*>(kb + d0 * 2048);
    const bf16x8 b1 = *reinterpret_cast<const bf16x8*>(kb + d0 * 2048 + 512);
    if (d0 == 0) { p0 = __builtin_amdgcn_mfma_f32_32x32x16_bf16(b0, qr[0], zero16, 0, 0, 0); p1 = __builtin_amdgcn_mfma_f32_32x32x16_bf16(b1, qr[0], zero16, 0, 0, 0); }
    else { p0 = __builtin_amdgcn_mfma_f32_32x32x16_bf16(b0, qr[d0], p0, 0, 0, 0); p1 = __builtin_amdgcn_mfma_f32_32x32x16_bf16(b1, qr[d0], p1, 0, 0, 0); } }
}
typedef __attribute__((address_space(3))) const char* lds_cptr;
typedef short v4i16_t __attribute__((ext_vector_type(4)));
__device__ __forceinline__ void kload8(bf16x8* kf, lds_cptr kp) {
  kf[0] = *(const LAS bf16x8*)(kp);        kf[1] = *(const LAS bf16x8*)(kp + 512);
  kf[2] = *(const LAS bf16x8*)(kp + 2048); kf[3] = *(const LAS bf16x8*)(kp + 2560);
  kf[4] = *(const LAS bf16x8*)(kp + 4096); kf[5] = *(const LAS bf16x8*)(kp + 4608);
  kf[6] = *(const LAS bf16x8*)(kp + 6144); kf[7] = *(const LAS bf16x8*)(kp + 6656);
}
__device__ __forceinline__ void kload2(bf16x8* kf, lds_cptr kp, int j) { kf[2 * j] = *(const LAS bf16x8*)(kp + j * 2048); kf[2 * j + 1] = *(const LAS bf16x8*)(kp + j * 2048 + 512); }
__device__ __forceinline__ s16x4 vtr(lds_cptr p) { return __builtin_bit_cast(s16x4, __builtin_amdgcn_ds_read_tr16_b64_v4i16((LAS v4i16_t*)p)); }
__device__ __forceinline__ float rowmax(const f32x16& p0, const f32x16& p1) {
  float a = max3f(p0[0], p0[1], p1[0]), b = max3f(p0[2], p0[3], p1[1]); a = max3f(a, p1[2], p1[3]);
  #pragma unroll
  for (int r = 4; r < 16; r += 4) { a = max3f(a, p0[r], p0[r + 1]); b = max3f(b, p0[r + 2], p0[r + 3]); a = max3f(a, p1[r], p1[r + 1]); b = max3f(b, p1[r + 2], p1[r + 3]); }
  const float m = max2f(a, b);
  auto rr = __builtin_amdgcn_permlane32_swap(__float_as_uint(m), __float_as_uint(m), false, false);
  return max2f(__uint_as_float(rr[0]), __uint_as_float(rr[1]));
}
__device__ __forceinline__ void pv(f32x16* o, int vb, bf16x8 pa0, bf16x8 pa1, bf16x8 pa2, bf16x8 pa3) {
  #pragma unroll
  for (int d0 = 0; d0 < 2; ++d0) { s16x4 lo[4], hi[4];
    #pragma unroll
    for (int ks = 0; ks < 4; ++ks) {
      asm volatile("ds_read_b64_tr_b16 %0,%1 offset:%c2" : "=&v"(lo[ks]) : "v"(vb), "i"(d0 * 4096 + ks * 1024) : "memory");
      asm volatile("ds_read_b64_tr_b16 %0,%1 offset:%c2" : "=&v"(hi[ks]) : "v"(vb), "i"(d0 * 4096 + ks * 1024 + 512) : "memory"); }
    asm volatile("s_waitcnt lgkmcnt(0)" ::: "memory"); SBAR();
    #define PK(k) (bf16x8){lo[k][0], lo[k][1], lo[k][2], lo[k][3], hi[k][0], hi[k][1], hi[k][2], hi[k][3]}
    o[d0] = __builtin_amdgcn_mfma_f32_32x32x16_bf16(pa0, PK(0), o[d0], 0, 0, 0);
    o[d0] = __builtin_amdgcn_mfma_f32_32x32x16_bf16(pa1, PK(1), o[d0], 0, 0, 0);
    o[d0] = __builtin_amdgcn_mfma_f32_32x32x16_bf16(pa2, PK(2), o[d0], 0, 0, 0);
    o[d0] = __builtin_amdgcn_mfma_f32_32x32x16_bf16(pa3, PK(3), o[d0], 0, 0, 0);
    #undef PK
  }
}
#define ADDBIAS(P0, P1, t) do { const LAS f32x4* bp_ = (const LAS f32x4*)((const LAS float*)((LAS char*)shm + LDS_BIAS) + (SEQ - 64 * ((t) + 1)) + 4 * hi); const float nm_ = -mhat; \
    _Pragma("unroll") for (int k_ = 0; k_ < 4; ++k_) { const f32x4 b0_ = bp_[2 * k_] + nm_, b1_ = bp_[8 + 2 * k_] + nm_; \
      P0[4 * k_] += b0_[0]; P0[4 * k_ + 1] += b0_[1]; P0[4 * k_ + 2] += b0_[2]; P0[4 * k_ + 3] += b0_[3]; \
      P1[4 * k_] += b1_[0]; P1[4 * k_ + 1] += b1_[1]; P1[4 * k_ + 2] += b1_[2]; P1[4 * k_ + 3] += b1_[3]; SBAR(); } } while (0)

#define LDBIAS(X0, X1, tt, k_) do { const LAS f32x4* bp_ = (const LAS f32x4*)((const LAS float*)((LAS char*)shm + LDS_BIAS) + (SEQ - 64 * ((tt) + 1)) + 4 * hi); const f32x4 b0_ = bp_[2 * (k_)], b1_ = bp_[8 + 2 * (k_)]; \
    X0[4 * (k_)] = b0_[0]; X0[4 * (k_) + 1] = b0_[1]; X0[4 * (k_) + 2] = b0_[2]; X0[4 * (k_) + 3] = b0_[3]; X1[4 * (k_)] = b1_[0]; X1[4 * (k_) + 1] = b1_[1]; X1[4 * (k_) + 2] = b1_[2]; X1[4 * (k_) + 3] = b1_[3]; } while (0)
#define SUBM8(X, B) do { X[B] -= mhat; X[B + 1] -= mhat; X[B + 2] -= mhat; X[B + 3] -= mhat; X[B + 4] -= mhat; X[B + 5] -= mhat; X[B + 6] -= mhat; X[B + 7] -= mhat; } while (0)

template <int THRL> __device__ __forceinline__ void attn_unit(int b, int h, int qb, const hbf16* Q, const hbf16* __restrict__ K, const hbf16* __restrict__ V, const hbf16* __restrict__ Gt, const float* __restrict__ FL, const unsigned* __restrict__ nmx, const int jq, hbf16* O, char* shm, const int tid_in) {
  int tid = tid_in; asm volatile("" : "+v"(tid));
  const int lane = tid & 63, r32 = lane & 31, hi = lane >> 5; const int wid = __builtin_amdgcn_readfirstlane(tid >> 6);
  const long rowbase = (long)b * SEQ; const int q0 = qb * QB;
  const hbf16* Qw = Q + (rowbase + q0 + wid * QBLK) * DM + h * DH;
  const unsigned lds0 = (unsigned)(uintptr_t)shm;
  float* wsf = (float*)(shm + LDS_WS) + wid * 64;
  const int NT0 = (q0 + QB) / KVBLK;
  const hbf16* Kh = K + rowbase * DM + h * DH, *Vh = V + rowbase * DM + h * DH;
  const hbf16* ksrc = Kh + (long)lane * DM + wid * 8;
  const hbf16* vsrc = Vh + (long)(16 * (wid & 3) + (lane >> 2)) * DM + (wid >> 2) * 32 + (lane & 3) * 8;
  const unsigned kdst = lds0 + LDS_K + wid * 1024, vdst = lds0 + LDS_V + wid * 1024;
  #define DMA_K(t, slot) glds16(ksrc + (long)(NT0 - 1 - (t)) * KVBLK * DM, (unsigned)__builtin_amdgcn_readfirstlane(kdst + (slot)))
  #define DMA_V(t, slot) glds16(vsrc + (long)(NT0 - 1 - (t)) * KVBLK * DM, (unsigned)__builtin_amdgcn_readfirstlane(vdst + (slot)))
  const char* Kbase = shm + LDS_K; bf16x8 kf[8];
  const lds_cptr shm3 = (lds_cptr)shm; const lds_cptr kp0 = shm3 + LDS_K + hi * 1024 + r32 * 16; const lds_cptr vp0 = shm3 + LDS_V + ((lane >> 4) & 1) * 32 + (lane & 3) * 8 + (4 * hi + ((lane & 15) >> 2)) * 64;
  DMA_K(0, 0); DMA_V(0, 0); DMA_K(1, SLOTB);
  bf16x8 qr[4];
  #pragma unroll
  for (int d0 = 0; d0 < 4; ++d0) qr[d0] = *reinterpret_cast<const bf16x8*>(&Qw[(long)r32 * DM + d0 * 16 + hi * 8]);
  DMA_K(2, 2 * SLOTB);
  const float* fl = FL + (size_t)(b * NHEAD + h) * SEQ; const float fref = fl[q0];
  int ts; float b2_;
  { const unsigned* nk = nmx + (b * 16 + h) * 2; const unsigned* nq = nmx + 64 * (1 + jq) + (b * 16 + h) * 2;
    const float kb = sqrtf(__uint_as_float(nk[0]) + __uint_as_float(nk[1])), qbn = sqrtf(__uint_as_float(nq[0]) + __uint_as_float(nq[1]));
    b2_ = kb * qbn * 1.001f; const float thr = fref + 2.0f * b2_ + SKIP_LOG2;
    int jstar = NT0 - 4;
    { float v4[4];
      #pragma unroll
      for (int k = 0; k < 4; ++k) { const int jj = 64 * k + lane; v4[k] = (jj < NT0) ? fl[64 * jj + 63] : -INFINITY; }
      #pragma unroll
      for (int k = 3; k >= 0; --k) { const unsigned long long bal = __ballot(v4[k] <= thr); if (bal) jstar = 64 * k + (int)__builtin_ctzll(bal); } }
    ts = jstar & ~1; if (ts > NT0 - 4) ts = NT0 - 4; ts = __builtin_amdgcn_readfirstlane(ts); }
  int NT = NT0 - ts;
  const float b2bound = b2_;
  { LAS float* bw = (LAS float*)((LAS char*)shm + LDS_BIAS) + (SEQ - (q0 + QB));
    for (int i = ts * KVBLK + tid; i < q0 + QB; i += NW * 64) bw[i] = fref - fl[i]; }
  float mhat = 0.f, l_reg = 0.f; f32x16 o[2]; o[0] = f32x16{}; o[1] = f32x16{}; const f32x16 zero16 = f32x16{};
  const int qrel = wid * QBLK + r32;
  #define CMASK(P0, P1, t) do { int jb_ = 3 - (t); if (jb_ >= 0) cmask(P0, P1, jb_, qrel, hi); } while (0)
  bool resc = false;
  #define START(P0, P1) do { const float rm = max2f(rowmax(P0, P1), -64.0f); resc = false; \
    { const float dl = rm; mhat = fadd_s(mhat, dl); \
      _Pragma("unroll") for (int r = 0; r < 16; ++r) { P0[r] = fsub_s(P0[r], dl); P1[r] = fsub_s(P1[r], dl); } \
      } \
    _Pragma("unroll") for (int r = 0; r < 16; ++r) P0[r] = __builtin_amdgcn_exp2f(P0[r]); } while (0)
  #define RESC() do { if (resc) { asm volatile("s_waitcnt lgkmcnt(0)" ::: "memory"); \
      _Pragma("unroll") for (int d_ = 0; d_ < 2; ++d_) _Pragma("unroll") for (int r = 0; r < 16; ++r) o[d_][r] *= wsf[crow(r, hi)]; } } while (0)
  f32x16 pA0, pA1, pB0, pB1;
  int sl_prev = 0, sl_cur = 0, sl_next = SLOTB;
  #define ROT() do { sl_prev = sl_cur; sl_cur = sl_next; sl_next = (sl_next == (NSLOT - 1) * SLOTB) ? 0 : sl_next + SLOTB; } while (0)
  WAIT_BAR(3);
  qkt(pA0, pA1, Kbase, qr, r32, hi); asm volatile("s_nop 15\n\ts_nop 7" : "+v"(pA0), "+v"(pA1)); ADDBIAS(pA0, pA1, 0); CMASK(pA0, pA1, 0);
  START(pA0, pA1);
  _Pragma("unroll") for (int r = 0; r < 16; ++r) pA1[r] = __builtin_amdgcn_exp2f(pA1[r]);
  WAIT_BAR(0);
  DMA_K(3, 0); DMA_V(1, SLOTB);
  ROT();
  kload8(kf, kp0 + sl_cur);
  LDBIAS(pB0, pB1, 1, 0); LDBIAS(pB0, pB1, 1, 1); LDBIAS(pB0, pB1, 1, 2); LDBIAS(pB0, pB1, 1, 3); SUBM8(pB0, 0); SUBM8(pB0, 8); SUBM8(pB1, 0); SUBM8(pB1, 8);
  WAIT_BAR(2);
  s16x4 vlo[8], vhi[8]; u32x4 pw0, pw1, pw2, pw3;
  #define PKW(P, B) cvtpk_s(P[B], P[B + 1])
  #define PAF(k) __builtin_bit_cast(bf16x8, pw##k)
  #define VFR(i) (bf16x8){vlo[i][0], vlo[i][1], vlo[i][2], vlo[i][3], vhi[i][0], vhi[i][1], vhi[i][2], vhi[i][3]}
  #define PIN(x) asm volatile("" : "+v"(x))
  #define MX3(a, b, c) __builtin_fmaxf(__builtin_fmaxf((a), (b)), (c))
  #define GAPA(MF, A0, A1, A2, A3, W0, W1, PW) do { MF; sacc += A0; sacc += A1; sacc += A2; sacc += A3; PIN(sacc); W0; W1; PIN(PW); SBAR(); } while (0)
  #define EX(v) __builtin_amdgcn_exp2f(v)
  #define GAPB(MF, X, B, EXTRA) do { MF; X[B] = EX(X[B]); X[B + 1] = EX(X[B + 1]); X[B + 2] = EX(X[B + 2]); X[B + 3] = EX(X[B + 3]); PIN(X); EXTRA; SBAR(); } while (0)
  #define VRD(i) do { vlo[i] = vtr(vp_ + (((i) >> 2) * 4096 + ((i) & 3) * 1024)); vhi[i] = vtr(vp_ + (((i) >> 2) * 4096 + ((i) & 3) * 1024 + 512)); } while (0)
  #define KRD(G, j) do { if (G) { kload2(kf, kp0 + sl_next, j); SBAR(); } } while (0)
  #define STEP(C0, C1, P0, P1, t, GK, GV, GL) do { SBAR(); \
    const lds_cptr vp_ = vp0 + sl_prev; \
    VRD(0); SBAR(); float sacc = (P0[0] + P0[1]); \
    GAPA(C0 = __builtin_amdgcn_mfma_f32_32x32x16_bf16(kf[0], qr[0], C0, 0, 0, 0), P0[2], P0[3], P0[4], P0[5],     pw0[0] = PKW(P0, 0), pw0[1] = PKW(P0, 2), pw0); \
    VRD(4); SBAR(); GAPA(C1 = __builtin_amdgcn_mfma_f32_32x32x16_bf16(kf[1], qr[0], C1, 0, 0, 0), P0[6], P0[7], P0[8], P0[9],     pw0[2] = PKW(P0, 4), pw0[3] = PKW(P0, 6), pw0); \
    VRD(1); SBAR(); GAPA(C0 = __builtin_amdgcn_mfma_f32_32x32x16_bf16(kf[2], qr[1], C0, 0, 0, 0),   P0[10], P0[11], P0[12], P0[13], pw1[0] = PKW(P0, 8), pw1[1] = PKW(P0, 10), pw1); \
    VRD(5); SBAR(); GAPA(C1 = __builtin_amdgcn_mfma_f32_32x32x16_bf16(kf[3], qr[1], C1, 0, 0, 0),   P0[14], P0[15], P1[0], P1[1],   pw1[2] = PKW(P0, 12), pw1[3] = PKW(P0, 14), pw1); \
    VRD(2); SBAR(); GAPA(C0 = __builtin_amdgcn_mfma_f32_32x32x16_bf16(kf[4], qr[2], C0, 0, 0, 0),   P1[2], P1[3], P1[4], P1[5],     pw2[0] = PKW(P1, 0), pw2[1] = PKW(P1, 2), pw2); \
    VRD(6); SBAR(); GAPA(C1 = __builtin_amdgcn_mfma_f32_32x32x16_bf16(kf[5], qr[2], C1, 0, 0, 0),   P1[6], P1[7], P1[8], P1[9],     pw2[2] = PKW(P1, 4), pw2[3] = PKW(P1, 6), pw2); \
    VRD(3); SBAR(); GAPA(C0 = __builtin_amdgcn_mfma_f32_32x32x16_bf16(kf[6], qr[3], C0, 0, 0, 0),   P1[10], P1[11], P1[12], P1[13], pw3[0] = PKW(P1, 8), pw3[1] = PKW(P1, 10), pw3); \
    VRD(7); SBAR(); GAPA(C1 = __builtin_amdgcn_mfma_f32_32x32x16_bf16(kf[7], qr[3], C1, 0, 0, 0),   P1[14], P1[15], 0.f, 0.f,       pw3[2] = PKW(P1, 12), pw3[3] = PKW(P1, 14), pw3); \
    l_reg += sacc; \
    if (GK) { DMA_K((t) + 3, sl_cur); } if (GV) { DMA_V((t) + 1, sl_next); } \
    CMASK(C0, C1, t); \
    { float a = MX3(C0[0], C0[1], C1[0]), b = MX3(C0[2], C0[3], C1[1]); a = MX3(a, C1[2], C1[3]); \
      _Pragma("unroll") for (int r = 4; r < 16; r += 4) { a = MX3(a, C0[r], C0[r + 1]); b = MX3(b, C0[r + 2], C0[r + 3]); a = MX3(a, C1[r], C1[r + 1]); b = MX3(b, C1[r + 2], C1[r + 3]); } \
      float rm = __builtin_fmaxf(a, b); { auto rr = __builtin_amdgcn_permlane32_swap(__float_as_uint(rm), __float_as_uint(rm), false, false); rm = __builtin_fmaxf(__uint_as_float(rr[0]), __uint_as_float(rr[1])); } \
      resc = false; \
      if (__builtin_expect(__any(rm > (float)THRL), 0)) { const float dl = __builtin_fmaxf(rm, 0.f); mhat += dl; \
        _Pragma("unroll") for (int r = 0; r < 16; ++r) { C0[r] -= dl; C1[r] -= dl; } \
        const float f = __builtin_amdgcn_exp2f(-dl); l_reg *= f; if (hi == 0) wsf[r32] = f; resc = true; } } \
    SBAR(); \
    GAPB(o[0] = __builtin_amdgcn_mfma_f32_32x32x16_bf16(PAF(0), VFR(0), o[0], 0, 0, 0), C0, 0, if (GL) LDBIAS(P0, P1, (t) + 1, 0)); \
    GAPB(o[1] = __builtin_amdgcn_mfma_f32_32x32x16_bf16(PAF(0), VFR(4), o[1], 0, 0, 0), C0, 4, if (GL) LDBIAS(P0, P1, (t) + 1, 1)); \
    KRD(GL, 0); GAPB(o[0] = __builtin_amdgcn_mfma_f32_32x32x16_bf16(PAF(1), VFR(1), o[0], 0, 0, 0), C0, 8, if (GL) LDBIAS(P0, P1, (t) + 1, 2)); \
    KRD(GL, 1); GAPB(o[1] = __builtin_amdgcn_mfma_f32_32x32x16_bf16(PAF(1), VFR(5), o[1], 0, 0, 0), C0, 12, if (GL) LDBIAS(P0, P1, (t) + 1, 3)); \
    KRD(GL, 2); GAPB(o[0] = __builtin_amdgcn_mfma_f32_32x32x16_bf16(PAF(2), VFR(2), o[0], 0, 0, 0), C1, 0, if (GL) SUBM8(P0, 0)); \
    KRD(GL, 3); GAPB(o[1] = __builtin_amdgcn_mfma_f32_32x32x16_bf16(PAF(2), VFR(6), o[1], 0, 0, 0), C1, 4, if (GL) SUBM8(P0, 8)); \
    GAPB(o[0] = __builtin_amdgcn_mfma_f32_32x32x16_bf16(PAF(3), VFR(3), o[0], 0, 0, 0), C1, 8, if (GL) SUBM8(P1, 0)); \
    GAPB(o[1] = __builtin_amdgcn_mfma_f32_32x32x16_bf16(PAF(3), VFR(7), o[1], 0, 0, 0), C1, 12, if (GL) SUBM8(P1, 8)); \
    } while (0)
  int t = 1;
  #define ENDW(tt) do { if ((tt) + 3 < NT) { WAIT_BAR(2); } else if ((tt) + 2 < NT) { WAIT_BAR(1); } else { WAIT_BAR(0); } } while (0)
  for (; t < 5 && t + 1 < NT; t += 2) {
    STEP(pB0, pB1, pA0, pA1, t, (t + 3 < NT), (t + 1 < NT), (t + 1 < NT));         ENDW(t);     RESC(); ROT();
    STEP(pA0, pA1, pB0, pB1, t + 1, (t + 4 < NT), (t + 2 < NT), (t + 2 < NT));     ENDW(t + 1); RESC(); ROT();
  }
  #undef CMASK
  #define CMASK(P0, P1, t) do {} while (0)
  float* xmin = (float*)(shm + LDS_OST);
  { float mw = mhat;
    #pragma unroll
    for (int o_ = 1; o_ < 32; o_ <<= 1) mw = fminf(mw, __shfl_xor(mw, o_));
    if (lane == 0) { xmin[wid] = mw; xmin[8 + wid] = mw; } }
  for (int trip = 0; t + 5 < NT; t += 2, ++trip) {
    STEP(pB0, pB1, pA0, pA1, t, true, true, true);     WAIT_BAR(2); RESC(); ROT();
    STEP(pA0, pA1, pB0, pB1, t + 1, true, true, true); WAIT_BAR(2); RESC(); ROT();
    { float mw = mhat;
      #pragma unroll
      for (int o_ = 1; o_ < 32; o_ <<= 1) mw = fminf(mw, __shfl_xor(mw, o_));
      if (lane == 0) xmin[8 * (trip & 1) + wid] = mw;
      const float* xr_ = xmin + 8 * ((trip & 1) ^ 1);
      float mall = fminf(fminf(fminf(xr_[0], xr_[1]), fminf(xr_[2], xr_[3])), fminf(fminf(xr_[4], xr_[5]), fminf(xr_[6], xr_[7])));
      const float blast = ((const LAS float*)((LAS char*)shm + LDS_BIAS))[SEQ - 64 * (t + 5) - 1];
      if (t + 5 < NT && blast + b2bound - mall < -SKIP_LOG2) NT = t + 5; }
  }
  for (; t + 1 < NT; t += 2) {
    STEP(pB0, pB1, pA0, pA1, t, (t + 3 < NT), (t + 1 < NT), (t + 1 < NT));         ENDW(t);     RESC(); ROT();
    STEP(pA0, pA1, pB0, pB1, t + 1, (t + 4 < NT), (t + 2 < NT), (t + 2 < NT));     ENDW(t + 1); RESC(); ROT();
  }
  #undef CMASK
  #define CMASK(P0, P1, t) do { int jb_ = 3 - (t); if (jb_ >= 0) cmask(P0, P1, jb_, qrel, hi); } while (0)
  STEP(pB0, pB1, pA0, pA1, NT - 1, false, false, false); RESC();
  { float sacc = pB0[0] + pB0[1]; _Pragma("unroll") for (int r = 2; r < 16; ++r) sacc += pB0[r]; _Pragma("unroll") for (int r = 0; r < 16; ++r) sacc += pB1[r]; l_reg += sacc;
    pw0 = (u32x4){PKW(pB0, 0), PKW(pB0, 2), PKW(pB0, 4), PKW(pB0, 6)}; pw1 = (u32x4){PKW(pB0, 8), PKW(pB0, 10), PKW(pB0, 12), PKW(pB0, 14)}; pw2 = (u32x4){PKW(pB1, 0), PKW(pB1, 2), PKW(pB1, 4), PKW(pB1, 6)}; pw3 = (u32x4){PKW(pB1, 8), PKW(pB1, 10), PKW(pB1, 12), PKW(pB1, 14)};
    SBAR(); int lane_d = lane; asm volatile("" : "+v"(lane_d)); const int vb0 = (int)(lds0 + LDS_V) + ((lane_d >> 4) & 1) * 32 + (lane_d & 3) * 8 + (4 * (lane_d >> 5) + ((lane_d & 15) >> 2)) * 64; pv(o, vb0 + sl_cur, PAF(0), PAF(1), PAF(2), PAF(3)); }
  #undef PKW
  #undef PAF
  #undef VFR
  #undef PIN
  #undef MX3
  #undef GAPA
  #undef GAPB
  #undef EX
  #undef VRD
  #undef KRD
  #undef STEP
  #undef ENDW
  { auto rr = __builtin_amdgcn_permlane32_swap(__float_as_uint(l_reg), __float_as_uint(l_reg), false, false); l_reg = __uint_as_float(rr[0]) + __uint_as_float(rr[1]); }
  if (hi == 0) wsf[32 + r32] = l_reg; asm volatile("s_waitcnt lgkmcnt(0)" ::: "memory");
  float rli[16];
  #pragma unroll
  for (int r = 0; r < 16; ++r) rli[r] = __builtin_amdgcn_rcpf(wsf[32 + crow(r, hi)]);
  int lane_e = lane; asm volatile("" : "+v"(lane_e));
  hbf16* Ow = O + (rowbase + q0 + wid * QBLK) * DM + h * DH;
  const hbf16* Gw = Gt + (rowbase + q0 + wid * QBLK) * DM + h * DH;
  { hbf16* stg = (hbf16*)(shm + LDS_OST) + wid * 2048;
    #pragma unroll
    for (int r = 0; r < 16; ++r) { const int orow = crow(r, hi);
      #pragma unroll
      for (int d0 = 0; d0 < 2; ++d0) stg[orow * 64 + d0 * 32 + r32] = __float2bfloat16(o[d0][r] * rli[r]); }
    asm volatile("s_waitcnt lgkmcnt(0)" ::: "memory");
    #pragma unroll
    for (int i = 0; i < 4; ++i) { const int row = i * 8 + (lane_e >> 3), ch = lane_e & 7; const u32x4 v = *(const u32x4*)(stg + row * 64 + ch * 8);
      const u32x4 g = *(const u32x4*)(Gw + (long)row * DM + ch * 8);
      u32x4 w;
      #pragma unroll
      for (int j = 0; j < 4; ++j) w[j] = cvt_pk_bf16(bf_lo(v[j]) * fast_sigmoid(bf_lo(g[j])), bf_hi(v[j]) * fast_sigmoid(bf_hi(g[j])));
      *(u32x4*)(Ow + (long)row * DM + ch * 8) = w; } }
  asm volatile("s_waitcnt lgkmcnt(0)\n\ts_barrier" ::: "memory");
  #undef DMA_K
  #undef DMA_V
  #undef CMASK
  #undef START
  #undef RESC
  #undef ROT
}
#undef SBAR
#undef WAIT_BAR
#undef ADDBIAS
}

constexpr int RING_OFF = 0, RING_BYTES = 131072;
constexpr int LDSCTL_OFF = 149504, MISC_OFF = LDSCTL_OFF + 320;
constexpr int TB_OFF = MISC_OFF + 128;
constexpr int LDS_BYTES = 150528;
static_assert(attn_body::LDS_BYTES <= LDSCTL_OFF && TB_OFF + 128 <= LDS_BYTES, "LDS map");
constexpr int NWAVES = 8;

#define XB_TMO      128
#define XB_XCNT(j)  (256  + 64 * (j))
#define XB_XSUB(j)  (1280 + 64 * (j))
#define XB_XGEN(j)  (2304 + 64 * (j))
#define XB_TOP      3328
#define XB_TOPGEN   3392
#define XCD_BAR_WORDS 3456
#define XB_SPIN_CAP (1u << 18)
__device__ __forceinline__ unsigned xb_ld(unsigned* p)              { return __hip_atomic_load(p, __ATOMIC_RELAXED, __HIP_MEMORY_SCOPE_AGENT); }
__device__ __forceinline__ unsigned xb_add(unsigned* p, unsigned v) { return __hip_atomic_fetch_add(p, v, __ATOMIC_RELAXED, __HIP_MEMORY_SCOPE_AGENT); }
__device__ __forceinline__ unsigned xb_xcc_id() { return (unsigned)__builtin_amdgcn_s_getreg((3 << 11) | 20) & 0xFu; }
#define XB_SPIN(cond, bar) do { unsigned _sp = 0; while (cond) { __builtin_amdgcn_s_sleep(1); \
    if ((++_sp & 255u) == 0u) { if (xb_ld(&(bar)[XB_TMO])) break; if (_sp > XB_SPIN_CAP) { atomicAdd(&(bar)[XB_TMO], 1u); break; } } } } while (0)
struct XcdBarrier { unsigned* bar; unsigned x; volatile LAS unsigned* st; };
__device__ __forceinline__ XcdBarrier xcd_barrier_post(unsigned* bar, volatile LAS unsigned* st) {
    XcdBarrier b; b.bar = bar; b.x = xb_xcc_id(); b.st = st;
    if (threadIdx.x == 0) (void)xb_add(&bar[XB_XCNT(b.x)], 1u);
    return b;
}
__device__ __forceinline__ void xcd_barrier_complete(unsigned* bar, unsigned x, unsigned& nloc, unsigned& nx) {
    const unsigned G = gridDim.x * gridDim.y * gridDim.z;
    unsigned sum, cnt, mine, sp = 0u;
    for (;;) {
        sum = 0u; cnt = 0u; mine = 0u;
#pragma unroll
        for (unsigned j = 0; j < 16; ++j) { const unsigned c = xb_ld(&bar[XB_XCNT(j)]); sum += c; cnt += (c > 0u) ? 1u : 0u; mine = (j == x) ? c : mine; }
        if (sum == G) break;
        __builtin_amdgcn_s_sleep(1);
        if ((++sp & 255u) == 0u) { if (xb_ld(&bar[XB_TMO])) break; if (sp > XB_SPIN_CAP) { atomicAdd(&bar[XB_TMO], 1u); break; } }
    }
    nloc = mine > 0u ? mine : 1u; nx = cnt > 0u ? cnt : 1u;
}
__device__ __forceinline__ void xcd_barrier(const XcdBarrier& b, const int tid_) {
    asm volatile("s_waitcnt vmcnt(0)" ::: "memory");
    __syncthreads();
    if (tid_ == 0) {
        unsigned* bar = b.bar;
        __builtin_amdgcn_s_waitcnt(0);
        unsigned nloc = b.st[0], nx = b.st[1];
        if (nloc == 0u) { xcd_barrier_complete(bar, b.x, nloc, nx); b.st[0] = nloc; b.st[1] = nx; }
        const unsigned old = xb_add(&bar[XB_XSUB(b.x)], 1u);
        const unsigned gen = old / nloc;
        if (old + 1u == (gen + 1u) * nloc) {
            __builtin_amdgcn_fence(__ATOMIC_RELEASE, "agent");
            asm volatile("s_waitcnt vmcnt(0)" ::: "memory");
            const unsigned og = xb_add(&bar[XB_TOP], 1u);
            const unsigned tg = og / nx;
            if (og + 1u == (tg + 1u) * nx) xb_add(&bar[XB_TOPGEN], 1u);
            else XB_SPIN(xb_ld(&bar[XB_TOPGEN]) == tg, bar);
            __builtin_amdgcn_fence(__ATOMIC_ACQUIRE, "agent");
            xb_add(&bar[XB_XGEN(b.x)], 1u);
            asm volatile("s_waitcnt vmcnt(0)" ::: "memory");
        } else {
            XB_SPIN(xb_ld(&bar[XB_XGEN(b.x)]) == gen, bar);
            __builtin_amdgcn_fence(__ATOMIC_ACQUIRE, "agent");
            asm volatile("s_waitcnt vmcnt(0)" ::: "memory");
        }
    }
    __syncthreads();
}

struct Frame {
    LAS unsigned char* lds;
    volatile LAS unsigned* MISC;
    gu32* ctl;
    int tid, lane, wave;
    int vcu, G;
};
__device__ __forceinline__ float wave_sum(float v) {
#pragma unroll
    for (int o = 1; o < 64; o <<= 1) v += __shfl_xor(v, o);
    return v;
}

__device__ __forceinline__ void p0_transpose_item(const float* W, int K, int N, bf16* WT, int kb, int nb, int dst_row0, LAS float* scr, int lane) {
    const int k0 = 64 * kb, n0 = 32 * nb;
    float tmp[32];
#pragma unroll
    for (int i = 0; i < 32; ++i) tmp[i] = W[(size_t)(k0 + 2 * i + (lane >> 5)) * N + n0 + (lane & 31)];
#pragma unroll
    for (int i = 0; i < 32; ++i) scr[(2 * i + (lane >> 5)) * 33 + (lane & 31)] = tmp[i];
    LDS_WAIT(); asm volatile("" ::: "memory");
    const int c = lane & 7;
#pragma unroll
    for (int j = 0; j < 4; ++j) { const int n = (lane >> 3) + 8 * j; const LAS float* s = scr + (8 * c) * 33 + n;
        v4u o; o.x = cvt_pk_bf16(s[0 * 33], s[1 * 33]); o.y = cvt_pk_bf16(s[2 * 33], s[3 * 33]); o.z = cvt_pk_bf16(s[4 * 33], s[5 * 33]); o.w = cvt_pk_bf16(s[6 * 33], s[7 * 33]);
        *(GAS v4u*)(WT + (size_t)(dst_row0 + n) * K + k0 + 8 * c) = o; }
    LDS_WAIT(); asm volatile("" ::: "memory");
}
__device__ __forceinline__ void p0_transpose_item8(const float* W, int K, int N, unsigned char* WT, int kb, int nb, int dst_row0, float wscale, LAS float* scr, int lane) {
    const int k0 = 64 * kb, n0 = 32 * nb;
    float tmp[32];
#pragma unroll
    for (int i = 0; i < 32; ++i) tmp[i] = W[(size_t)(k0 + 2 * i + (lane >> 5)) * N + n0 + (lane & 31)];
#pragma unroll
    for (int i = 0; i < 32; ++i) scr[(2 * i + (lane >> 5)) * 33 + (lane & 31)] = tmp[i] * wscale;
    LDS_WAIT(); asm volatile("" ::: "memory");
    const int c = lane & 7;
#pragma unroll
    for (int j = 0; j < 4; ++j) { const int n = (lane >> 3) + 8 * j; const LAS float* s = scr + (8 * c) * 33 + n;
        v2u o; o.x = pg8::pk4_fp8(s[0 * 33], s[1 * 33], s[2 * 33], s[3 * 33]); o.y = pg8::pk4_fp8(s[4 * 33], s[5 * 33], s[6 * 33], s[7 * 33]);
        *(GAS v2u*)(WT + (size_t)(dst_row0 + n) * K + k0 + 8 * c) = o; }
    LDS_WAIT(); asm volatile("" ::: "memory");
}
__device__ __forceinline__ bool conv_group(int& r, const float* src, int cnt, int K, int N, unsigned char* dst, size_t dstride, int mode, float wscale, LAS float* scr, int lane) {
    const int per = (K / 64) * (N / 32), tot = per * cnt;
    if (r >= tot) { r -= tot; return false; }
    const int mi = r / per, it = r % per, nblk = N / 32, kb = it / nblk, nb = it % nblk, n0 = 32 * nb;
    const int drow = mode == 0 ? n0 : (256 * (n0 / 128) + (n0 % 128) + (mode == 2 ? 128 : 0));
    if (wscale == 0.0f) p0_transpose_item(src + (size_t)mi * K * N, K, N, (bf16*)(dst + (size_t)mi * dstride), kb, nb, drow, scr, lane);
    else p0_transpose_item8(src + (size_t)mi * K * N, K, N, dst + (size_t)mi * dstride, kb, nb, drow, wscale, scr, lane);
    return true;
}

__device__ __forceinline__ void conv_tile(const float* W, int K, int N  , unsigned char* WT, int kb, int nb, int mode, float wscale, LAS float* tile, int tid) {
    const int k0 = 128 * kb, n0 = 256 * nb, lane = tid & 63, wv = tid >> 6;
    f32x4 t4[16];
#pragma unroll
    for (int r = 0; r < 16; ++r) t4[r] = *(const f32x4*)(W + (size_t)(k0 + 8 * r + wv) * N + n0 + 4 * lane);
    __syncthreads();
#pragma unroll
    for (int r = 0; r < 16; ++r) *(LAS f32x4*)(tile + (8 * r + wv) * 260 + 4 * lane) = t4[r];
    __syncthreads();
#pragma unroll
    for (int j = 0; j < 8; ++j) { const int n = lane + 64 * (j & 3), c = 2 * wv + (j >> 2);
        const LAS float* s = tile + (8 * c) * 260 + n; const int gn = n0 + n;
        const int drow = mode == 0 ? gn : (256 * (gn / 128) + (gn % 128) + (mode == 2 ? 128 : 0));
        if (wscale == 0.0f) { v4u o; o.x = cvt_pk_bf16(s[0 * 260], s[1 * 260]); o.y = cvt_pk_bf16(s[2 * 260], s[3 * 260]); o.z = cvt_pk_bf16(s[4 * 260], s[5 * 260]); o.w = cvt_pk_bf16(s[6 * 260], s[7 * 260]);
            *(GAS v4u*)((bf16*)WT + (size_t)drow * K + k0 + 8 * c) = o; }
        else { v2u o; o.x = pg8::pk4_fp8(s[0 * 260] * wscale, s[1 * 260] * wscale, s[2 * 260] * wscale, s[3 * 260] * wscale); o.y = pg8::pk4_fp8(s[4 * 260] * wscale, s[5 * 260] * wscale, s[6 * 260] * wscale, s[7 * 260] * wscale);
            *(GAS v2u*)(WT + (size_t)drow * K + k0 + 8 * c) = o; } }
}
__device__ __forceinline__ bool conv_group_t(int& r, const float* src, int cnt, int K, int N, unsigned char* dst, size_t dstride, int mode, float wscale, LAS float* tile, int tid, int ncols = 0) {
    if (ncols == 0) ncols = N;
    const int per = (K / 128) * (ncols / 256), tot = per * cnt;
    if (r >= tot) { r -= tot; return false; }
    const int mi = r / per, it = r % per, nblk = ncols / 256;
    conv_tile(src + (size_t)mi * K * N, K, N, dst + (size_t)mi * dstride, it / nblk, it % nblk, mode, wscale, tile, tid);
    return true;
}

template <int IDX> __device__ __forceinline__ const float* karg() { unsigned long long p; const unsigned long long ka = (unsigned long long)__builtin_amdgcn_kernarg_segment_ptr();
    asm volatile("s_load_dwordx2 %0, %1, %2\n\ts_waitcnt lgkmcnt(0)" : "=s"(p) : "s"(ka), "i"(IDX * 8) : "memory"); return (const float*)(const GAS float*)p; }
#define KIN(i) karg<(i)>()
#define KOUT ((float*)karg<26>())
#define KWS ((unsigned char*)karg<27>())
#define KH ((bf16*)(KWS + WS_H))
struct Args { const float* in[26]; float* out; unsigned char* ws; int ph_lo, ph_hi, li, pad; };

template <int MODE, bool HBF = true>
__device__ __forceinline__ void norm_phase(Frame& F, const void* src, const float* gain, const float* shift, const float* scale, int bstride, bf16* dst, float* dstf,
                                           const float* rw, const float* rb, gu32* moe_cnt, int2* list, const float* wf, const float* bfv, float* logf, const bf16* addy = nullptr, bf16* hback = nullptr, const bool out8 = false,
                                           const float* gain2 = nullptr, const float* shift2 = nullptr, const float* scale2 = nullptr, int bstride2 = 0, bf16* dst2 = nullptr, unsigned char* dst8 = nullptr) {
    const int gw = F.vcu * NWAVES + F.wave, NGW = F.G * NWAVES, lane = F.lane;
    float wr_[MODE == 1 ? 16 : 1][8];
    if (MODE == 1) {
#pragma unroll
        for (int j = 0; j < 4; ++j)
#pragma unroll
            for (int i = 0; i < 4; ++i) { const int col = 256 * j + 4 * lane + i; const f32x4 a = *(const f32x4*)(rw + col * 8), b = *(const f32x4*)(rw + col * 8 + 4);
                wr_[MODE == 1 ? j * 4 + i : 0][0] = a[0]; wr_[MODE == 1 ? j * 4 + i : 0][1] = a[1]; wr_[MODE == 1 ? j * 4 + i : 0][2] = a[2]; wr_[MODE == 1 ? j * 4 + i : 0][3] = a[3];
                wr_[MODE == 1 ? j * 4 + i : 0][4] = b[0]; wr_[MODE == 1 ? j * 4 + i : 0][5] = b[1]; wr_[MODE == 1 ? j * 4 + i : 0][6] = b[2]; wr_[MODE == 1 ? j * 4 + i : 0][7] = b[3]; }
    }
    int rcount = 0, r_tok = 0, r_e1 = 0, r_e2 = 0; float r_w1 = 0.f, r_w2 = 0.f;
    LAS unsigned* lcnt = (LAS unsigned*)(F.lds + RING_OFF);
    if (MODE == 1) { if (F.tid < 16) lcnt[F.tid] = 0u; __syncthreads(); }
    LAS float* wfl = (LAS float*)(F.lds + RING_OFF);
    if (MODE == 2) { for (int i = F.tid; i < D * FH; i += NWAVES * 64) wfl[(i & 15) * D + (i >> 4)] = wf[i]; __syncthreads(); }
    for (int b = 0; b < BATCH; ++b) {
        f32x4 ga[4], sh[4];
#pragma unroll
        for (int j = 0; j < 4; ++j) { const f32x4 g = *(const f32x4*)(gain + 256 * j + 4 * lane), sc = *(const f32x4*)(scale + (size_t)b * bstride + 256 * j + 4 * lane);
            ga[j] = g * (sc + 1.0f); sh[j] = *(const f32x4*)(shift + (size_t)b * bstride + 256 * j + 4 * lane); }
        f32x4 ga2[MODE == 2 ? 4 : 1], sh2[MODE == 2 ? 4 : 1];
        if (MODE == 2) {
#pragma unroll
            for (int j = 0; j < 4; ++j) { const f32x4 g = *(const f32x4*)(gain2 + 256 * j + 4 * lane), sc = *(const f32x4*)(scale2 + (size_t)b * bstride2 + 256 * j + 4 * lane);
                ga2[MODE == 2 ? j : 0] = g * (sc + 1.0f); sh2[MODE == 2 ? j : 0] = *(const f32x4*)(shift2 + (size_t)b * bstride2 + 256 * j + 4 * lane); } }
        for (int m = b * SEQ + gw; m < (b + 1) * SEQ; m += NGW) {
            f32x4 v[4]; float s = 0.f;
            if constexpr (HBF) { const GAS v2u* hr = (const GAS v2u*)((const bf16*)src + (size_t)m * D) + lane;
#pragma unroll
                for (int j = 0; j < 4; ++j) { const v2u y = hr[64 * j]; v[j] = (f32x4){bf_lo(y.x), bf_hi(y.x), bf_lo(y.y), bf_hi(y.y)}; } }
            else { const GAS f32x4* xr = (const GAS f32x4*)((const float*)src + (size_t)m * D) + lane;
#pragma unroll
                for (int j = 0; j < 4; ++j) v[j] = xr[64 * j]; }
            if (addy) {
                const GAS v2u* yr = (const GAS v2u*)(addy + (size_t)m * D) + lane;
#pragma unroll
                for (int j = 0; j < 4; ++j) { const v2u y = yr[64 * j]; v[j].x += bf_lo(y.x); v[j].y += bf_hi(y.x); v[j].z += bf_lo(y.y); v[j].w += bf_hi(y.y); }
                if (MODE != 3) { GAS v2u* hb = (GAS v2u*)(hback + (size_t)m * D) + lane;
#pragma unroll
                    for (int j = 0; j < 4; ++j) { v2u o; o.x = cvt_pk_bf16(v[j].x, v[j].y); o.y = cvt_pk_bf16(v[j].z, v[j].w); hb[64 * j] = o; } }
            }
#pragma unroll
            for (int j = 0; j < 4; ++j) s += (v[j].x * v[j].x + v[j].y * v[j].y) + (v[j].z * v[j].z + v[j].w * v[j].w);
            const float rstd = 1.0f / sqrtf(wave_sum(s) * (1.f / D) + EPS);
            if (MODE == 2) { GAS unsigned long long* o8 = (GAS unsigned long long*)(dst2 + (size_t)m * D) + lane;
#pragma unroll
                for (int j = 0; j < 4; ++j) { const f32x4 t = (v[j] * rstd) * ga2[MODE == 2 ? j : 0] + sh2[MODE == 2 ? j : 0]; o8[64 * j] = (unsigned long long)cvt_pk_bf16(t.x, t.y) | ((unsigned long long)cvt_pk_bf16(t.z, t.w) << 32); } }
#pragma unroll
            for (int j = 0; j < 4; ++j) v[j] = (v[j] * rstd) * ga[j] + sh[j];
            if (MODE == 3) { GAS f32x4* o = (GAS f32x4*)(dstf + (size_t)m * D) + lane;
#pragma unroll
                for (int j = 0; j < 4; ++j) o[64 * j] = v[j]; }
            else if (out8) { GAS unsigned* o4 = (GAS unsigned*)((unsigned char*)dst + (size_t)m * D) + lane;
#pragma unroll
                for (int j = 0; j < 4; ++j) o4[64 * j] = pg8::pk4_fp8(v[j].x * QS_X, v[j].y * QS_X, v[j].z * QS_X, v[j].w * QS_X); }
            else { GAS unsigned long long* o8 = (GAS unsigned long long*)(dst + (size_t)m * D) + lane;
#pragma unroll
                for (int j = 0; j < 4; ++j) o8[64 * j] = (unsigned long long)cvt_pk_bf16(v[j].x, v[j].y) | ((unsigned long long)cvt_pk_bf16(v[j].z, v[j].w) << 32); }
            if (dst8) { GAS unsigned* o4 = (GAS unsigned*)(dst8 + (size_t)m * D) + lane;
#pragma unroll
                for (int j = 0; j < 4; ++j) o4[64 * j] = pg8::pk4_fp8(v[j].x * QS_X, v[j].y * QS_X, v[j].z * QS_X, v[j].w * QS_X); }
            if (MODE == 1) {
                float lg[8];
#pragma unroll
                for (int e = 0; e < 8; ++e) { float a = 0.f;
#pragma unroll
                    for (int j = 0; j < 4; ++j)
#pragma unroll
                        for (int i = 0; i < 4; ++i) a += v[j][i] * wr_[MODE == 1 ? j * 4 + i : 0][e];
                    lg[e] = wave_sum(a) + rb[e]; }
                int i1 = 0; float v1 = lg[0];
#pragma unroll
                for (int e = 1; e < 8; ++e) if (lg[e] > v1) { v1 = lg[e]; i1 = e; }
                int i2 = -1; float v2 = -INFINITY;
#pragma unroll
                for (int e = 0; e < 8; ++e) if (e != i1 && lg[e] > v2) { v2 = lg[e]; i2 = e; }
                const float w1 = 1.0f / (1.0f + __expf(v2 - v1)), w2 = 1.0f - w1;
                if (lane == rcount) { r_tok = m; r_e1 = i1; r_e2 = i2; r_w1 = w1; r_w2 = w2; }
                ++rcount;
            }
            if (MODE == 2) {
                float z[16];
#pragma unroll
                for (int hh = 0; hh < 16; ++hh) z[hh] = 0.f;
#pragma unroll
                for (int hh = 0; hh < 16; ++hh)
#pragma unroll
                    for (int j = 0; j < 4; ++j) { const f32x4 w4 = *(const LAS f32x4*)(wfl + hh * D + 256 * j + 4 * lane); z[hh] += (v[j][0] * w4[0] + v[j][1] * w4[1]) + (v[j][2] * w4[2] + v[j][3] * w4[3]); }
                float mine = 0.f;
#pragma unroll
                for (int hh = 0; hh < 16; ++hh) { const float t = wave_sum(z[hh]); if (lane == hh) mine = t; }
                if (lane < 16) { const float zz = mine + bfv[lane];
                    const float ls = -__builtin_amdgcn_logf(1.0f + __builtin_amdgcn_exp2f(-zz * LOG2E));
                    logf[(size_t)m * FH + lane] = ls; }
            }
        }
    }
    if (MODE == 2) __syncthreads();
    if (MODE == 1) {
        unsigned s1 = 0u, s2 = 0u; const bool have = lane < rcount;
        if (have) { s1 = __hip_atomic_fetch_add(lcnt + r_e1, 1u, __ATOMIC_RELAXED, __HIP_MEMORY_SCOPE_WORKGROUP); s2 = __hip_atomic_fetch_add(lcnt + r_e2, 1u, __ATOMIC_RELAXED, __HIP_MEMORY_SCOPE_WORKGROUP); }
        __syncthreads();
        if (F.tid < 8) lcnt[8 + F.tid] = __hip_atomic_fetch_add(moe_cnt + 64 * F.tid, lcnt[F.tid], RLX_AGENT);
        __syncthreads();
        if (have) { list[(size_t)r_e1 * T + lcnt[8 + r_e1] + s1] = make_int2(r_tok, __float_as_int(r_w1));
                    list[(size_t)r_e2 * T + lcnt[8 + r_e2] + s2] = make_int2(r_tok | 0x40000000, __float_as_int(r_w2)); }
    }
}

namespace ret {
constexpr int NG = 8, CG = SEQ / 64 / NG  , VS = 128;
constexpr int QSB = 528, KSB = 512, VSB = 288, PSB = 144, OSB = 272;
constexpr int L_Q = 0, L_K = 64 * QSB, L_V = L_K + 64 * KSB, L_P = L_V + 64 * VSB, L_O = L_P + 64 * PSB, L_END = L_O + 64 * OSB;
static_assert(L_END <= RING_BYTES, "scan LDS");
__device__ __forceinline__ s16x4 trr(const LAS unsigned char* p) { return __builtin_bit_cast(s16x4, __builtin_amdgcn_ds_read_tr16_b64_v4i16((LAS attn_body::v4i16_t*)p)); }
__device__ __forceinline__ int hsw(int m) { return ((m & 3) << 3) | ((m >> 2) & 1); }
#define RSB() __builtin_amdgcn_sched_barrier(0)
template <bool OUT>
__device__ __forceinline__ void scan_unit(Frame& F, int u, bf16* proj, float* Lbuf) {
    const int vs = u & 3, grp = (u >> 2) & 7, h = (u >> 5) & 3, b = u >> 7;
    if (!OUT && grp == NG - 1) return;
    const int tid = F.tid, lane = F.lane, w = F.wave, c = lane & 15, g = lane >> 4;
    LAS unsigned char* L = F.lds + RING_OFF;
    const float l2g0 = __builtin_amdgcn_logf(1.0f - __builtin_amdgcn_exp2f(-5.0f - (float)h));
    f32x4 st[16];
#pragma unroll
    for (int t = 0; t < 16; ++t) st[t] = (f32x4){0.f, 0.f, 0.f, 0.f};
    if (OUT) {
        for (int gp = 0; gp < grp; ++gp) {
            const float wgt = __builtin_amdgcn_exp2f(l2g0 * 2048.0f * (float)(grp - 1 - gp));
            const int up = (u & ~(7 << 2)) | (gp << 2);
            const f32x4* lp = (const f32x4*)Lbuf + ((size_t)(up * 8 + w) * 16) * 64 + lane;
#pragma unroll
            for (int t = 0; t < 16; ++t) st[t] += lp[t * 64] * wgt;
        }
    }
    const size_t row0 = (size_t)b * SEQ + (size_t)grp * (CG * 64);
    const __amdgpu_buffer_rsrc_t rs = __builtin_amdgcn_make_buffer_rsrc((void*)(proj + row0 * PROJW), 0, CG * 64 * PROJW * 2, 0x00020000);
    const int qcol = h * RQK * 2, kcol = (D + h * RQK) * 2, vcol = (2 * D + h * RV + vs * VS) * 2;
    v4u pq[4], pk[4], pvv[2];
    int qoff[4], voff[2];
#pragma unroll
    for (int i = 0; i < 4; ++i) { const int p = tid + 512 * i, r = p >> 5, cp = p & 31; qoff[i] = (r * PROJW + cp * 8) * 2; }
#pragma unroll
    for (int i = 0; i < 2; ++i) { const int p = tid + 512 * i, r = p >> 4, cp = p & 15; voff[i] = (r * PROJW + cp * 8) * 2; }
#define LOADCH(cc) do { const int cb_ = (cc) * 64 * PROJW * 2; \
        _Pragma("unroll") for (int i = 0; i < 4; ++i) { if (OUT) pq[i] = __builtin_bit_cast(v4u, __builtin_amdgcn_raw_buffer_load_b128(rs, qoff[i], cb_ + qcol, 0)); pk[i] = __builtin_bit_cast(v4u, __builtin_amdgcn_raw_buffer_load_b128(rs, qoff[i], cb_ + kcol, 0)); } \
        _Pragma("unroll") for (int i = 0; i < 2; ++i) pvv[i] = __builtin_bit_cast(v4u, __builtin_amdgcn_raw_buffer_load_b128(rs, voff[i], cb_ + vcol, 0)); } while (0)
    LOADCH(0);
    int kbase[2][4];
#pragma unroll
    for (int f0 = 0; f0 < 2; ++f0)
#pragma unroll
        for (int f1 = 0; f1 < 4; ++f1) kbase[f0][f1] = (4 * g + (c >> 2)) * KSB + 8 * ((f0 ^ (g & 1)) + 2 * (c & 3) + 8 * (f1 ^ (c >> 2)));
    for (int cc = 0; cc < CG; ++cc) {
        float l2g = l2g0; asm volatile("" : "+v"(l2g));
#pragma unroll
        for (int i = 0; i < 4; ++i) { const int p = tid + 512 * i, r = p >> 5, cp = p & 31;
            if (OUT) *(LAS v4u*)(L + L_Q + r * QSB + cp * 16) = pq[i];
            const int hh = hsw(r);
            *(LAS v2u*)(L + L_K + r * KSB + 8 * ((2 * cp) ^ hh)) = (v2u){pk[i].x, pk[i].y};
            *(LAS v2u*)(L + L_K + r * KSB + 8 * ((2 * cp + 1) ^ hh)) = (v2u){pk[i].z, pk[i].w}; }
#pragma unroll
        for (int i = 0; i < 2; ++i) { const int p = tid + 512 * i, r = p >> 4, cp = p & 15; const float kd = __builtin_amdgcn_exp2f(l2g * (float)(63 - r));
            v4u o;
#pragma unroll
            for (int jj = 0; jj < 4; ++jj) o[jj] = cvt_pk_bf16(bf_lo(pvv[i][jj]) * kd, bf_hi(pvv[i][jj]) * kd);
            *(LAS v4u*)(L + L_V + r * VSB + cp * 16) = o; }
        __syncthreads();
        if (cc + 1 < CG) LOADCH(cc + 1);
        if (OUT) {
            const int mt = w >> 1, mrow = 16 * mt + c;
            f32x4 pacc[2] = {(f32x4){0.f, 0.f, 0.f, 0.f}, (f32x4){0.f, 0.f, 0.f, 0.f}};
#pragma unroll
            for (int kh = 0; kh < 2; ++kh) {
                bf16x8 ka[4], qb[2][4];
#pragma unroll
                for (int k4 = 0; k4 < 4; ++k4) { const int ks = 4 * kh + k4;
                    const int ub = 2 * g + 8 * (k4 ^ (c & 3)) + 32 * kh, b0 = (c >> 2) & 1;
                    const v2u a0 = *(const LAS v2u*)(L + L_K + mrow * KSB + 8 * (ub + b0)), a1 = *(const LAS v2u*)(L + L_K + mrow * KSB + 8 * (ub + 1 - b0));
                    ka[k4] = __builtin_bit_cast(bf16x8, (v4u){a0.x, a0.y, a1.x, a1.y});
#pragma unroll
                    for (int ti = 0; ti < 2; ++ti) qb[ti][k4] = *(const LAS bf16x8*)(L + L_Q + (16 * (2 * (w & 1) + ti) + c) * QSB + (32 * ks + 8 * g) * 2); }
                RSB();
#pragma unroll
                for (int k4 = 0; k4 < 4; ++k4)
#pragma unroll
                    for (int ti = 0; ti < 2; ++ti) pacc[ti] = __builtin_amdgcn_mfma_f32_16x16x32_bf16(ka[k4], qb[ti][k4], pacc[ti], 0, 0, 0);
            }
#pragma unroll
            for (int ti = 0; ti < 2; ++ti) { const int n = 16 * (2 * (w & 1) + ti) + c; float pvl[4];
#pragma unroll
                for (int i = 0; i < 4; ++i) { const int m = 16 * mt + 4 * g + i; const float e = (m <= n) ? -64.0f : (float)(2 * (m - n) - 64); pvl[i] = pacc[ti][i] * __builtin_amdgcn_exp2f(l2g * e); }
                v2u pw; pw.x = cvt_pk_bf16(pvl[0], pvl[1]); pw.y = cvt_pk_bf16(pvl[2], pvl[3]);
                *(LAS v2u*)(L + L_P + n * PSB + (32 * (mt >> 1) + 8 * g + 4 * (mt & 1)) * 2) = pw; }
            __syncthreads();
        }
        bf16x8 bv[2];
#pragma unroll
        for (int ks = 0; ks < 2; ++ks) { const LAS unsigned char* vp = L + L_V + (32 * ks + 4 * g + (c >> 2)) * VSB + (16 * w + 4 * (c & 3)) * 2;
            const s16x4 lo = trr(vp), hi = trr(vp + 16 * VSB); bv[ks] = (bf16x8){lo[0], lo[1], lo[2], lo[3], hi[0], hi[1], hi[2], hi[3]}; }
        if (OUT) {
            f32x4 ao[4];
#pragma unroll
            for (int nt_ = 0; nt_ < 4; ++nt_) ao[nt_] = (f32x4){0.f, 0.f, 0.f, 0.f};
            { bf16x8 pa[2][4];
#pragma unroll
              for (int ks = 0; ks < 2; ++ks)
#pragma unroll
                for (int nt_ = 0; nt_ < 4; ++nt_) pa[ks][nt_] = *(const LAS bf16x8*)(L + L_P + (16 * nt_ + c) * PSB + (32 * ks + 8 * g) * 2);
              RSB();
#pragma unroll
              for (int ks = 0; ks < 2; ++ks)
#pragma unroll
                for (int nt_ = 0; nt_ < 4; ++nt_) ao[nt_] = __builtin_amdgcn_mfma_f32_16x16x32_bf16(pa[ks][nt_], bv[ks], ao[nt_], 0, 0, 0); }
#pragma unroll
            for (int kp = 0; kp < 4; ++kp) { bf16x8 qa[2][4];
#pragma unroll
                for (int k2 = 0; k2 < 2; ++k2)
#pragma unroll
                    for (int nt_ = 0; nt_ < 4; ++nt_) qa[k2][nt_] = *(const LAS bf16x8*)(L + L_Q + (16 * nt_ + c) * QSB + (32 * (2 * kp + k2) + 8 * g) * 2);
                RSB();
#pragma unroll
                for (int k2 = 0; k2 < 2; ++k2) { const int ks = 2 * kp + k2;
                    v4u sb; sb.x = cvt_pk_bf16(st[2 * ks][0], st[2 * ks][1]); sb.y = cvt_pk_bf16(st[2 * ks][2], st[2 * ks][3]); sb.z = cvt_pk_bf16(st[2 * ks + 1][0], st[2 * ks + 1][1]); sb.w = cvt_pk_bf16(st[2 * ks + 1][2], st[2 * ks + 1][3]);
                    const bf16x8 sfrag = __builtin_bit_cast(bf16x8, sb);
#pragma unroll
                    for (int nt_ = 0; nt_ < 4; ++nt_) ao[nt_] = __builtin_amdgcn_mfma_f32_16x16x32_bf16(qa[k2][nt_], sfrag, ao[nt_], 0, 0, 0); } }
#pragma unroll
            for (int nt_ = 0; nt_ < 4; ++nt_)
#pragma unroll
                for (int i = 0; i < 4; ++i) { const int n = 16 * nt_ + 4 * g + i; const float ov = ao[nt_][i] * __builtin_amdgcn_exp2f(l2g * (float)(n + 1));
                    *(LAS bf16*)(L + L_O + n * OSB + (16 * w + c) * 2) = (bf16)(cvt_pk_bf16(ov, 0.f) & 0xffffu); }
        }
        const float cdec = __builtin_amdgcn_exp2f(l2g * 64.0f);
#pragma unroll
        for (int tb = 0; tb < 16; tb += 4) { s16x4 klo[4][2], khi[4][2];
#pragma unroll
            for (int tt = 0; tt < 4; ++tt)
#pragma unroll
                for (int ks = 0; ks < 2; ++ks) { const int t = tb + tt;
                    const LAS unsigned char* kp = L + L_K + kbase[t & 1][(t >> 1) & 3] + 256 * (t >> 3) + ks * 32 * KSB;
                    klo[tt][ks] = trr(kp); khi[tt][ks] = trr(kp + 16 * KSB); }
            RSB();
#pragma unroll
            for (int tt = 0; tt < 4; ++tt) { f32x4 a = st[tb + tt] * cdec;
#pragma unroll
                for (int ks = 0; ks < 2; ++ks) { const bf16x8 kf = (bf16x8){klo[tt][ks][0], klo[tt][ks][1], klo[tt][ks][2], klo[tt][ks][3], khi[tt][ks][0], khi[tt][ks][1], khi[tt][ks][2], khi[tt][ks][3]};
                    a = __builtin_amdgcn_mfma_f32_16x16x32_bf16(kf, bv[ks], a, 0, 0, 0); }
                st[tb + tt] = a; } }
        __syncthreads();
        if (OUT) {
#pragma unroll
            for (int i = 0; i < 2; ++i) { const int p = tid + 512 * i, r = p >> 4, cp = p & 15;
                __builtin_amdgcn_raw_buffer_store_b128(__builtin_bit_cast(__attribute__((ext_vector_type(4))) unsigned, *(const LAS v4u*)(L + L_O + r * OSB + cp * 16)), rs, voff[i], cc * 64 * PROJW * 2 + vcol, 0); }
        }
    }
#undef LOADCH
#undef RSB
    if (!OUT) { f32x4* lp = (f32x4*)Lbuf + ((size_t)(u * 8 + w) * 16) * 64 + lane;
#pragma unroll
        for (int t = 0; t < 16; ++t) lp[t * 64] = st[t]; }
}
}

__device__ __forceinline__ int lane_id_opaque() { int l; asm volatile("v_mbcnt_lo_u32_b32 %0, -1, 0\n\tv_mbcnt_hi_u32_b32 %0, -1, %0" : "=v"(l)); return l; }
#ifdef PROBE_LO
#define PROBE_T0(k) do { if ((k) == PROBE_LO && blockIdx.x == 0 && F.tid == 0) { const unsigned long long t_ = __builtin_amdgcn_s_memrealtime(); F.MISC[16] = (unsigned)t_; F.MISC[17] = (unsigned)(t_ >> 32); } } while (0)
#define PROBE_T1(k) do { if ((k) + 1 == PROBE_HI && blockIdx.x == 0 && F.tid == 0) { const unsigned long long t_ = __builtin_amdgcn_s_memrealtime(); F.MISC[18] = (unsigned)t_; F.MISC[19] = (unsigned)(t_ >> 32); } } while (0)
#else
#define PROBE_T0(k) do {} while (0)
#define PROBE_T1(k) do {} while (0)
#endif
#define PHASE(k, sync, ...) do { if (lo <= (k) && (k) < hi) { F.lane = lane_id_opaque(); F.tid = F.wave * 64 + F.lane; PROBE_T0(k); __VA_ARGS__ if ((sync) && (k) + 1 < hi) xcd_barrier(bar, F.tid); PROBE_T1(k); } } while (0)
#define WSP(T_, off) ((T_*)(KWS + (off)))
#define MODP(l) (WSP(float, WS_MOD) + (l) * MOD_L)

__device__ __forceinline__ void moe_table(Frame& F, LAS int* TB, gu32* mcnt) {
    __syncthreads();
    if (F.tid < 8) TB[16 + F.tid] = (int)__hip_atomic_load(mcnt + 64 * F.tid, RLX_AGENT);
    __syncthreads();
    if (F.tid == 0) { int acc = 0; for (int e = 0; e < 8; ++e) { TB[e] = acc; acc += (TB[16 + e] + 255) >> 8; } TB[8] = acc; }
    __syncthreads();
}

template <int L, int P>
__device__ __forceinline__ void ffn_part(Frame& F, const XcdBarrier& bar, const int lo, const int hi) {
    constexpr int I = L >> 1;
    if constexpr ((L & 1) == 0) {
        PHASE(P, true, { norm_phase<0>(F, KH, KIN(4) + (L * 2 + 1) * D, MODP(L) + 3 * D, MODP(L) + 4 * D, 6 * D, WSP(bf16, WS_XN), nullptr, nullptr, nullptr, nullptr, nullptr, nullptr, nullptr, nullptr, nullptr, nullptr, true); });
        PHASE(P + 1, true, { pg8::DenseOrder S{WSP(bf16, WS_XN), WSP(bf16, W_FUP) + (size_t)I * DFF * D, D / 2, D / 2, T / 256, 2 * DFF / 256, F.G, (int)blockIdx.x};
              pg8::EpiSwigluT<true> E{WSP(bf16, WS_HID), DFF, 1.0f / (QS_X * QS_WUP), QS_H};
              pg8::gemm_phase<pg8::EpiSwigluT<true>, pg8::DenseOrder, false, true>(F.lds + RING_OFF, S, E, F.tid); });
        PHASE(P + 2, true, { pg8::DenseOrder S{WSP(bf16, WS_HID), WSP(bf16, W_FDN) + (size_t)I * DFF * D / 2, DFF / 2, DFF / 2, T / 256, D / 256, F.G, (int)blockIdx.x};
              pg8::EpiResidT<true> E{KH, KH, MODP(L) + 5 * D, 6 * D, 1.0f / (QS_H * QS_WDN_F), true};
              pg8::gemm_phase<pg8::EpiResidT<true>, pg8::DenseOrder, false, true>(F.lds + RING_OFF, S, E, F.tid); });
    } else {
        PHASE(P, true, { norm_phase<1>(F, KH, KIN(4) + (L * 2 + 1) * D, MODP(L) + 3 * D, MODP(L) + 4 * D, 6 * D, WSP(bf16, WS_XN), nullptr, KIN(18) + (size_t)I * D * NE, KIN(19) + I * NE,
                                       (gu32*)WSP(unsigned, WS_CTL) + CW_MOE + I * 16 * 64, WSP(int2, WS_LIST), nullptr, nullptr, nullptr, nullptr, nullptr, true); });
        PHASE(P + 1, true, { LAS int* TB = (LAS int*)(F.lds + TB_OFF); moe_table(F, TB, (gu32*)WSP(unsigned, WS_CTL) + CW_MOE + I * 16 * 64);
              pg8::MoeOrder S{WSP(bf16, WS_XN), WSP(bf16, W_MUP) + (size_t)I * 8 * DFE * D, D / 2, D / 2, 2 * DFE / 256, F.G, (int)blockIdx.x, (size_t)DFE * D, WSP(int2, WS_LIST), TB, true};
              pg8::EpiSwigluT<true> E{WSP(bf16, WS_HID), DFE, 1.0f / (QS_X * QS_WUP), QS_H};
              pg8::gemm_phase<pg8::EpiSwigluT<true>, pg8::MoeOrder, true, true>(F.lds + RING_OFF, S, E, F.tid); });
        PHASE(P + 2, true, { LAS int* TB = (LAS int*)(F.lds + TB_OFF); moe_table(F, TB, (gu32*)WSP(unsigned, WS_CTL) + CW_MOE + I * 16 * 64);
              pg8::MoeOrder S{WSP(bf16, WS_HID), WSP(bf16, W_MDN) + (size_t)I * 8 * DFE * D / 2, DFE / 2, DFE / 2, D / 256, F.G, (int)blockIdx.x, (size_t)DFE * D / 2, WSP(int2, WS_LIST), TB, false};
              pg8::EpiMoeDown E{KH, WSP(bf16, WS_XN), MODP(L) + 5 * D, 6 * D, WSP(int2, WS_LIST), TB, 1.0f / (QS_H * QS_WDN_M)};
              pg8::gemm_phase<pg8::EpiMoeDown, pg8::MoeOrder, false, true>(F.lds + RING_OFF, S, E, F.tid); });
    }
}

template <int L, int P>
__device__ __forceinline__ void ret_layer(Frame& F, const XcdBarrier& bar, const int lo, const int hi) {
    PHASE(P, true, { norm_phase<0, (L != 0)>(F, L == 0 ? (const void*)KIN(0) : (const void*)KH, KIN(4) + (L * 2 + 0) * D, MODP(L) + 0 * D, MODP(L) + 1 * D, 6 * D, WSP(bf16, WS_XN8), nullptr, nullptr, nullptr, nullptr, nullptr, nullptr, nullptr, nullptr,
                                   nullptr, nullptr, true); });
    PHASE(P + 1, true, { pg8::DenseOrder S{WSP(bf16, WS_XN8), (const bf16*)(KWS + W_RIN + (size_t)L * 12 * MiB), D / 2, D / 2, T / 256, 6 * D / 256, F.G, (int)blockIdx.x};
          pg8::EpiRetIn E{WSP(bf16, WS_PROJ), WSP(f32x2, WS_ROPE), 1.0f / (QS_X * QS_WUP)};
          pg8::gemm_phase<pg8::EpiRetIn, pg8::DenseOrder, false, true>(F.lds + RING_OFF, S, E, F.tid); });
    PHASE(P + 2, true, { for (int u = F.vcu; u < 256; u += F.G) ret::scan_unit<false>(F, u, WSP(bf16, WS_PROJ), WSP(float, WS_LST)); });
    PHASE(P + 3, true, { for (int u = F.vcu; u < 256; u += F.G) ret::scan_unit<true>(F, u, WSP(bf16, WS_PROJ), WSP(float, WS_LST)); });
    PHASE(P + 4, true, {
          const int gw = F.vcu * NWAVES + F.wave, NGW = F.G * NWAVES; bf16* PROJ = WSP(bf16, WS_PROJ);
          for (int it = gw; it < T * RH; it += NGW) { const int row = it >> 2, hh = it & 3;
              bf16* op = PROJ + (size_t)row * PROJW + 2 * D + hh * RV + F.lane * 8; const bf16* gp = op + 2 * D;
              const v4u ov = *(const v4u*)op, gv = *(const v4u*)gp; float o[8], gg[8];
_Pragma("unroll")
              for (int j = 0; j < 4; ++j) { o[2 * j] = bf_lo(ov[j]); o[2 * j + 1] = bf_hi(ov[j]); gg[2 * j] = bf_lo(gv[j]); gg[2 * j + 1] = bf_hi(gv[j]); }
              float s = 0.f;
_Pragma("unroll")
              for (int j = 0; j < 8; ++j) s += o[j];
              const float mu = wave_sum(s) * (1.0f / RV); float q = 0.f;
_Pragma("unroll")
              for (int j = 0; j < 8; ++j) { o[j] -= mu; q += o[j] * o[j]; }
              const float rstd = 1.0f / sqrtf(wave_sum(q) * (1.0f / RV) + EPS);
              v4u w;
_Pragma("unroll")
              for (int j = 0; j < 4; ++j) w[j] = cvt_pk_bf16(o[2 * j] * rstd * fast_silu(gg[2 * j]), o[2 * j + 1] * rstd * fast_silu(gg[2 * j + 1]));
              *(v4u*)op = w; } });
    PHASE(P + 5, true, { pg8::DenseOrder S{WSP(bf16, WS_PROJ) + 2 * D, WSP(bf16, W_RO) + (size_t)L * 2 * D * D, PROJW, 2 * D, T / 256, D / 256, F.G, (int)blockIdx.x};
          pg8::EpiResidT<(L != 0)> E{L == 0 ? (const void*)KIN(0) : (const void*)KH, KH, MODP(L) + 2 * D, 6 * D};
          pg8::gemm_phase<pg8::EpiResidT<(L != 0)>, pg8::DenseOrder, false>(F.lds + RING_OFF, S, E, F.tid); });
    ffn_part<L, P + 6>(F, bar, lo, hi);
}

__device__ __forceinline__ void late_convert(Frame& F, int j) {
    int r = (int)blockIdx.x + 256 * j;
    if (r >= 3 * 8 * 112) return;
    LAS float* tile = (LAS float*)(F.lds + RING_OFF);
    if (!conv_group_t(r, KIN(20) + (size_t)8 * D * DFE, 8, D, DFE, WSP(unsigned char, W_MUP) + (size_t)8 * 2 * DFE * D, (size_t)2 * DFE * D, 1, QS_WUP, tile, F.tid))
    if (!conv_group_t(r, KIN(21) + (size_t)8 * D * DFE, 8, D, DFE, WSP(unsigned char, W_MUP) + (size_t)8 * 2 * DFE * D, (size_t)2 * DFE * D, 2, QS_WUP, tile, F.tid))
        conv_group_t(r, KIN(22) + (size_t)8 * DFE * D, 8, DFE, D, WSP(unsigned char, W_MDN) + (size_t)8 * DFE * D, (size_t)DFE * D, 0, QS_WDN_M, tile, F.tid);
    __syncthreads();
}

constexpr size_t WS_KVN = WS_BIG + 128 * MiB;
template <int L, int P>
__device__ __forceinline__ void fox_layer(Frame& F, const XcdBarrier& bar, const int lo, const int hi, unsigned char* ldsg) {
    constexpr int J = L - 2;
    if constexpr (L == 2) {
        PHASE(P, true, { norm_phase<2>(F, KH, KIN(9), WSP(float, WS_MOD) + MOD_KV, WSP(float, WS_MOD) + MOD_KV + D, 2 * D, WSP(bf16, WS_KVN), nullptr, nullptr, nullptr, nullptr, nullptr, KIN(11), KIN(12), WSP(float, WS_LOGF),
                                       WSP(bf16, WS_XN), KH, false, KIN(4) + (L * 2 + 0) * D, MODP(L) + 0 * D, MODP(L) + 1 * D, 6 * D, WSP(bf16, WS_XN)); });
    } else {
        PHASE(P, true, { norm_phase<0>(F, KH, KIN(4) + (L * 2 + 0) * D, MODP(L) + 0 * D, MODP(L) + 1 * D, 6 * D, WSP(bf16, WS_XN), nullptr, nullptr, nullptr, nullptr, nullptr, nullptr, nullptr, nullptr); });
    }
    PHASE(P + 1, true, {
        if constexpr (L == 2) {
            if (blockIdx.x < 32) {
                const int bb = blockIdx.x >> 4, hh = blockIdx.x & 15; const float* lf = WSP(float, WS_LOGF) + (size_t)bb * SEQ * FH + hh; float* fo = WSP(float, WS_FL2) + (size_t)blockIdx.x * SEQ;
                LAS double* sc = (LAS double*)(F.lds + RING_OFF);
                float vals[32]; double s = 0.0;
_Pragma("unroll")
                for (int i = 0; i < 32; ++i) vals[i] = lf[(size_t)(F.tid * 32 + i) * FH];
_Pragma("unroll")
                for (int i = 0; i < 32; ++i) s += (double)vals[i];
                sc[F.tid] = s; __syncthreads();
                for (int off = 1; off < 512; off <<= 1) { double t = (F.tid >= off) ? sc[F.tid - off] : 0.0; __syncthreads(); sc[F.tid] += t; __syncthreads(); }
                double run = sc[F.tid] - s;
_Pragma("unroll")
                for (int i = 0; i < 32; ++i) { run += (double)vals[i]; fo[F.tid * 32 + i] = (float)run; }
                __syncthreads();
            }
            pg8::DenseOrder S{WSP(bf16, WS_KVN), WSP(bf16, W_KV), D, D, T / 256, 2 * D / 256, F.G, (int)blockIdx.x};
            pg8::EpiBf16 E{WSP(bf16, WS_K), D, D, (size_t)(WS_V - WS_K) / 2, 1.0f, WSP(unsigned, WS_CTL) + CW_NMAX};
            pg8::gemm_phase<pg8::EpiBf16, pg8::DenseOrder, false>(F.lds + RING_OFF, S, E, F.tid);
        }
        { pg8::DenseOrder S{WSP(bf16, WS_XN), WSP(bf16, W_QG) + (size_t)J * 2 * D * D, D, D, T / 256, 2 * D / 256, F.G, (int)blockIdx.x};
          pg8::EpiBf16 E{WSP(bf16, WS_Q), D, D, (size_t)(WS_G - WS_Q) / 2, QC2, WSP(unsigned, WS_CTL) + CW_NMAX + 64 * (1 + J)};
          pg8::gemm_phase<pg8::EpiBf16, pg8::DenseOrder, false>(F.lds + RING_OFF, S, E, F.tid); } });
    PHASE(P + 2, true, { const int vcu = F.vcu, s = vcu & 7, bh = vcu >> 3;
          if (F.G == 256) {
            for (int i = 0; i < 8; ++i) { const int base = 16 * (i >> 1); const int qb = (i & 1) ? base + 15 - s : base + s;
                attn_body::attn_unit<8>(bh / FH, bh % FH, qb, WSP(const attn_body::hbf16, WS_Q), WSP(const attn_body::hbf16, WS_K), WSP(const attn_body::hbf16, WS_V), WSP(const attn_body::hbf16, WS_G),
                                        WSP(const float, WS_FL2), WSP(const unsigned, WS_CTL) + CW_NMAX, J, WSP(attn_body::hbf16, WS_Q), (char*)ldsg + RING_OFF, F.tid);
                if constexpr (L == 2) { late_convert(F, i); if (i < 3) late_convert(F, 8 + i); } }
          } });
    PHASE(P + 3, true, { pg8::DenseOrder S{WSP(bf16, WS_Q), WSP(bf16, W_FO) + (size_t)J * D * D, D, D, T / 256, D / 256, F.G, (int)blockIdx.x};
          pg8::EpiResidT<true> E{KH, KH, MODP(L) + 2 * D, 6 * D};
          pg8::gemm_phase<pg8::EpiResidT<true>, pg8::DenseOrder, false>(F.lds + RING_OFF, S, E, F.tid); });
    ffn_part<L, P + 4>(F, bar, lo, hi);
}

__global__ void __launch_bounds__(NWAVES * 64, 2) yoco_fwd(Args args) {
    extern __shared__ __attribute__((aligned(16))) unsigned char lds[];
    Frame F;
    F.lds = (LAS unsigned char*)lds;
    F.MISC = (volatile LAS unsigned*)(F.lds + MISC_OFF);
    F.tid = threadIdx.x; F.lane = F.tid & 63; F.wave = __builtin_amdgcn_readfirstlane(F.tid >> 6);
    F.G = gridDim.x; { const int bx = blockIdx.x; F.vcu = (F.G % 8 == 0) ? (bx % 8) * (F.G / 8) + bx / 8 : bx; }
    F.ctl = (gu32*)(KWS + WS_CTL);
    for (int u = F.tid; u < (LDS_BYTES - LDSCTL_OFF) / 4; u += NWAVES * 64) ((LAS unsigned*)(F.lds + LDSCTL_OFF))[u] = 0u;
    __syncthreads();
    const XcdBarrier bar = xcd_barrier_post((unsigned*)(F.ctl + CW_BAR) + args.li * XCD_BAR_WORDS, F.MISC + 8);
    const int lo = args.ph_lo, hi = args.ph_hi;

    PHASE(0, true, {
    {
        LAS float* ca = (LAS float*)(F.lds + RING_OFF);
        LAS float* red = ca + 2048;
        { const float* cin = KIN(1); for (int i = F.tid; i < 2 * D; i += NWAVES * 64) ca[i] = fast_silu(cin[i]); }
        __syncthreads();
        constexpr int NCOLB = (4 * 6 * D + 2 * D + 2 * D) / 128;
        float* MOD = WSP(float, WS_MOD);
        for (int cb = blockIdx.x; cb < NCOLB; cb += F.G) {
            const int gc = cb * 128 + (F.tid & 127), kq = F.tid >> 7;
            const float* W; const float* bias; int ldw, n; float* outp; int ostride;
            if (gc < 4 * 6 * D) { const int l = gc / (6 * D); n = gc % (6 * D); W = KIN(2) + (size_t)l * D * 6 * D; ldw = 6 * D; bias = KIN(3) + l * 6 * D; outp = MOD + l * MOD_L; ostride = 6 * D; }
            else if (gc < 4 * 6 * D + 2 * D) { n = gc - 4 * 6 * D; W = KIN(7); ldw = 2 * D; bias = KIN(8); outp = MOD + MOD_KV; ostride = 2 * D; }
            else { n = gc - 4 * 6 * D - 2 * D; W = KIN(23); ldw = 2 * D; bias = KIN(24); outp = MOD + MOD_FIN; ostride = 2 * D; }
            float a0 = 0.f, a1 = 0.f; const float* wp = W + (size_t)(256 * kq) * ldw + n;
_Pragma("unroll 32")
            for (int k = 0; k < 256; ++k) { const float wv = wp[(size_t)k * ldw]; a0 += ca[256 * kq + k] * wv; a1 += ca[D + 256 * kq + k] * wv; }
            red[(kq * 2 + 0) * 128 + (F.tid & 127)] = a0; red[(kq * 2 + 1) * 128 + (F.tid & 127)] = a1;
            __syncthreads();
            if (F.tid < 256) { const int bb = F.tid >> 7, cl = F.tid & 127;
                const float s = (red[(0 * 2 + bb) * 128 + cl] + red[(1 * 2 + bb) * 128 + cl]) + (red[(2 * 2 + bb) * 128 + cl] + red[(3 * 2 + bb) * 128 + cl]);
                outp[(size_t)bb * ostride + n] = s + bias[n]; }
            __syncthreads();
        }
    }
    {
        f32x2* rope = WSP(f32x2, WS_ROPE);
        for (int i = blockIdx.x * (NWAVES * 64) + F.tid; i < SEQ * 128; i += F.G * NWAVES * 64) { const int pos = i >> 7, j = i & 127;
            const float inv = __builtin_amdgcn_exp2f(-(float)j * (13.287712379549449f / 128.0f));
            const float ang = (float)pos * inv;
            double tr = (double)ang * 0.15915494309189535; tr -= __builtin_rint(tr); const float tf = (float)tr;
            rope[i] = (f32x2){__builtin_amdgcn_cosf(tf), __builtin_amdgcn_sinf(tf)}; }
    }
    {
        __syncthreads();
        LAS float* tile = (LAS float*)(F.lds + RING_OFF);
        constexpr int NIT = 2 * 8 * 24 + 2 * 16 * 4 + 8 * 8 + 2 * 8 * 8 + 2 * 8 * 4 + 2 * 2 * 8 * 11 + 2 * 22 * 4 + 2 * 8 * 8 * 14 + 8 * 28 * 4;
        for (int it = F.vcu; it < NIT; it += F.G) { int r = it;
            if (conv_group_t(r, KIN(5), 2, D, 6 * D, WSP(unsigned char, W_RIN), (size_t)12 * MiB, 0, QS_WUP, tile, F.tid)) continue;
            if (conv_group_t(r, KIN(6), 2, 2 * D, D, WSP(unsigned char, W_RO), (size_t)2 * D * D * 2, 0, 0.f, tile, F.tid)) continue;
            if (conv_group_t(r, KIN(10), 1, D, 2 * D, WSP(unsigned char, W_KV), 0, 0, 0.f, tile, F.tid)) continue;
            if (conv_group_t(r, KIN(13), 2, D, 2 * D, WSP(unsigned char, W_QG), (size_t)2 * D * D * 2, 0, 0.f, tile, F.tid)) continue;
            if (conv_group_t(r, KIN(14), 2, D, D, WSP(unsigned char, W_FO), (size_t)D * D * 2, 0, 0.f, tile, F.tid)) continue;
            if (conv_group_t(r, KIN(15), 2, D, DFF, WSP(unsigned char, W_FUP), (size_t)2 * DFF * D, 1, QS_WUP, tile, F.tid)) continue;
            if (conv_group_t(r, KIN(16), 2, D, DFF, WSP(unsigned char, W_FUP), (size_t)2 * DFF * D, 2, QS_WUP, tile, F.tid)) continue;
            if (conv_group_t(r, KIN(17), 2, DFF, D, WSP(unsigned char, W_FDN), (size_t)DFF * D, 0, QS_WDN_F, tile, F.tid)) continue;
            if (conv_group_t(r, KIN(20), 8, D, DFE, WSP(unsigned char, W_MUP), (size_t)2 * DFE * D, 1, QS_WUP, tile, F.tid)) continue;
            if (conv_group_t(r, KIN(21), 8, D, DFE, WSP(unsigned char, W_MUP), (size_t)2 * DFE * D, 2, QS_WUP, tile, F.tid)) continue;
            conv_group_t(r, KIN(22), 8, DFE, D, WSP(unsigned char, W_MDN), (size_t)DFE * D, 0, QS_WDN_M, tile, F.tid);
        }
    }
    });
    ret_layer<0, 1>(F, bar, lo, hi);
    ret_layer<1, 10>(F, bar, lo, hi);
    fox_layer<2, 19>(F, bar, lo, hi, lds);
    fox_layer<3, 26>(F, bar, lo, hi, lds);
    PHASE(33, false, { norm_phase<3>(F, KH, KIN(25), WSP(float, WS_MOD) + MOD_FIN, WSP(float, WS_MOD) + MOD_FIN + D, 2 * D, nullptr, KOUT, nullptr, nullptr, nullptr, nullptr, nullptr, nullptr, nullptr, WSP(bf16, WS_XN), nullptr); });
#ifdef PROBE_LO
    if (blockIdx.x == 0 && F.tid == 0) { const unsigned long long t0 = ((unsigned long long)F.MISC[17] << 32) | F.MISC[16], t1 = ((unsigned long long)F.MISC[19] << 32) | F.MISC[18];
        const unsigned long long span = (t1 - t0) * PROBE_K, te = __builtin_amdgcn_s_memrealtime();
        while (__builtin_amdgcn_s_memrealtime() - te < span) __builtin_amdgcn_s_sleep(8); }
#endif
}

extern "C" void kernel_launch(void* const* d_in, const int* in_sizes, int n_in, void* d_out, int out_size, void* d_ws, size_t ws_size, hipStream_t stream) {
    static int grid = 0;
    if (grid == 0) {
        if (n_in != 26 || in_sizes[0] != T * D || out_size != T * D || ws_size < WS_END) { fprintf(stderr, "kernel_launch: unexpected shapes / workspace (n_in %d, ws %zu, need %zu)\n", n_in, ws_size, (size_t)WS_END); grid = -1; return; }
        int dev = 0, cus = 0;
        if (hipGetDevice(&dev) != hipSuccess || hipDeviceGetAttribute(&cus, hipDeviceAttributeMultiprocessorCount, dev) != hipSuccess) { grid = -1; return; }
        if (hipFuncSetAttribute((const void*)yoco_fwd, hipFuncAttributeMaxDynamicSharedMemorySize, LDS_BYTES) != hipSuccess) { fprintf(stderr, "kernel_launch: hipFuncSetAttribute failed\n"); grid = -1; return; }
        int per_cu = 0;
        if (hipOccupancyMaxActiveBlocksPerMultiprocessor(&per_cu, (const void*)yoco_fwd, NWAVES * 64, LDS_BYTES) != hipSuccess || per_cu < 1) { fprintf(stderr, "kernel_launch: occupancy query says %d\n", per_cu); }
        (void)hipGetLastError();
        grid = cus;
    }
    if (grid < 0) return;
    (void)hipMemsetAsync((char*)d_ws + WS_CTL, 0, CTL_ZERO_BYTES, stream);
    Args a{};
    for (int i = 0; i < 26; ++i) a.in[i] = (const float*)d_in[i];
    a.out = (float*)d_out; a.ws = (unsigned char*)d_ws;
    constexpr int NPH = 34;
#if MK_N_LAUNCHES == 1
    a.ph_lo = 0; a.ph_hi = NPH; a.li = 0; a.pad = 0;
    hipLaunchKernelGGL(yoco_fwd, dim3(grid), dim3(NWAVES * 64), LDS_BYTES, stream, a);
#else
    for (int p = 0; p < NPH; ++p) { a.ph_lo = p; a.ph_hi = p + 1; a.li = 0; a.pad = 0;
        hipLaunchKernelGGL(yoco_fwd, dim3(grid), dim3(NWAVES * 64), LDS_BYTES, stream, a); }
#endif
}
```
